# Optimizing an MI355X kernel written in HIP

```python
import jax, jax.numpy as jnp
from jax import lax
import numpy as np

D_MODEL = 1024
BATCH = 8
SEQ = 4096
DEPTH = 4

GRID_W = 64
CTX_LEN = 256

HEAD_DIM = 64
N_Q_HEADS = 8
N_KV_HEADS = 2
GQA_GROUP = N_Q_HEADS // N_KV_HEADS
WINDOW = 128
ATT_BLOCK = 128
ROPE_THETA = 10000.0
Q_W = N_Q_HEADS * HEAD_DIM
KV_W = N_KV_HEADS * HEAD_DIM

CHUNK = 128
SGU_GROUPS = 4
SGU_WIDTH = 512
SGU_GROUP_W = SGU_WIDTH // SGU_GROUPS

FNET_GROUPS = 4
FNET_WIDTH = 512
FNET_GROUP_W = FNET_WIDTH // FNET_GROUPS

BRANCH_W = 512
N_BRANCH = 3
IN_W = Q_W + 2 * KV_W + 2 * SGU_WIDTH + FNET_WIDTH
IN_SPLITS = (Q_W, Q_W + KV_W, Q_W + 2 * KV_W, Q_W + 2 * KV_W + SGU_WIDTH, Q_W + 2 * KV_W + 2 * SGU_WIDTH)

D_FF = 2752
N_MOD = 9
ALPHA = (2 * DEPTH) ** 0.25
BETA = (8 * DEPTH) ** -0.25
LN_EPS = 1e-5
NEG_INF = -1e30

kernel_name = 'hybrid_diffusion_gated_mixers'


def layer_norm(x, g, b):
    xf = x.astype(jnp.float32)
    mu = jnp.mean(xf, axis=-1, keepdims=True)
    var = jnp.mean(jnp.square(xf - mu), axis=-1, keepdims=True)
    return ((xf - mu) * lax.rsqrt(var + LN_EPS)).astype(x.dtype) * g + b


def modulate(x, shift, scale):
    return x * (1 + scale) + shift


def swiglu(h, w_up, w_down):
    gate, up = jnp.split(h @ w_up, 2, axis=-1)
    return (jax.nn.silu(gate) * up) @ w_down


def axial_rope_tables(n_tokens, dtype):
    rows = n_tokens // GRID_W
    row = jnp.broadcast_to(jnp.arange(rows)[:, None], (rows, GRID_W)).reshape(-1).astype(jnp.float32)
    col = jnp.broadcast_to(jnp.arange(GRID_W)[None, :], (rows, GRID_W)).reshape(-1).astype(jnp.float32)
    axis_dim = HEAD_DIM // 2
    inv_freq = ROPE_THETA ** (-jnp.arange(0, axis_dim, 2, dtype=jnp.float32) / axis_dim)
    ang_r = row[:, None] * inv_freq[None, :]
    ang_c = col[:, None] * inv_freq[None, :]
    return (jnp.cos(ang_r).astype(dtype), jnp.sin(ang_r).astype(dtype),
            jnp.cos(ang_c).astype(dtype), jnp.sin(ang_c).astype(dtype))


def _rotate(x, cos, sin):
    x1, x2 = jnp.split(x, 2, axis=-1)
    cos, sin = cos[:, None, :], sin[:, None, :]
    return jnp.concatenate([x1 * cos - x2 * sin, x1 * sin + x2 * cos], axis=-1)


def apply_axial_rope(x, tables):
    cos_r, sin_r, cos_c, sin_c = tables
    xr, xc = jnp.split(x, 2, axis=-1)
    return jnp.concatenate([_rotate(xr, cos_r, sin_r), _rotate(xc, cos_c, sin_c)], axis=-1)


def windowed_gqa_with_context(q_lat, k_lat, v_lat, k_ctx, v_ctx, sink):
    b, s = q_lat.shape[:2]
    n_ctx = k_ctx.shape[1]
    nb = s // ATT_BLOCK
    band_len = 3 * ATT_BLOCK
    scale = HEAD_DIM ** -0.5
    qb = q_lat.reshape(b, nb, ATT_BLOCK, N_KV_HEADS, GQA_GROUP, HEAD_DIM)

    def band(t):
        tp = jnp.pad(t, ((0, 0), (ATT_BLOCK, ATT_BLOCK), (0, 0), (0, 0)))
        tp = tp.reshape(b, nb + 2, ATT_BLOCK, N_KV_HEADS, HEAD_DIM)
        return jnp.concatenate([tp[:, :-2], tp[:, 1:-1], tp[:, 2:]], axis=2)

    kb, vb = band(k_lat), band(v_lat)
    q_pos = jnp.arange(s).reshape(nb, ATT_BLOCK)
    k_pos = (jnp.arange(nb)[:, None] - 1) * ATT_BLOCK + jnp.arange(band_len)[None, :]
    valid = ((jnp.abs(q_pos[:, :, None] - k_pos[:, None, :]) <= WINDOW)
             & (k_pos[:, None, :] >= 0) & (k_pos[:, None, :] < s))
    s_band = jnp.einsum('bnqkgd,bnjkd->bnkgqj', qb, kb).astype(jnp.float32) * scale
    s_band = jnp.where(valid[None, :, None, None], s_band, NEG_INF)
    s_ctx = jnp.einsum('bnqkgd,bjkd->bnkgqj', qb, k_ctx).astype(jnp.float32) * scale
    s_sink = jnp.broadcast_to(sink.astype(jnp.float32).reshape(1, 1, N_KV_HEADS, GQA_GROUP, 1, 1),
                              s_band.shape[:-1] + (1,))
    p = jax.nn.softmax(jnp.concatenate([s_band, s_ctx, s_sink], axis=-1), axis=-1).astype(v_lat.dtype)
    o = (jnp.einsum('bnkgqj,bnjkd->bnqkgd', p[..., :band_len], vb)
         + jnp.einsum('bnkgqj,bjkd->bnqkgd', p[..., band_len:band_len + n_ctx], v_ctx))
    return o.reshape(b, s, Q_W)


def context_gqa_with_sink(q_ctx, k_ctx, v_ctx, sink):
    b, n_ctx = q_ctx.shape[:2]
    qg = q_ctx.reshape(b, n_ctx, N_KV_HEADS, GQA_GROUP, HEAD_DIM)
    sc = jnp.einsum('bqkgd,bjkd->bkgqj', qg, k_ctx).astype(jnp.float32) * HEAD_DIM ** -0.5
    s_sink = jnp.broadcast_to(sink.astype(jnp.float32).reshape(1, N_KV_HEADS, GQA_GROUP, 1, 1),
                              sc.shape[:-1] + (1,))
    p = jax.nn.softmax(jnp.concatenate([sc, s_sink], axis=-1), axis=-1)[..., :n_ctx].astype(v_ctx.dtype)
    return jnp.einsum('bkgqj,bjkd->bqkgd', p, v_ctx).reshape(b, n_ctx, Q_W)


def chunked_sgu(u, v, w_s, b_s, g, bn):
    b, n = u.shape[:2]
    u = jax.nn.gelu(u)
    v = layer_norm(jax.nn.gelu(v), g, bn)
    vb = v.reshape(b, n // CHUNK, CHUNK, SGU_GROUPS, SGU_GROUP_W)
    mixed = jnp.einsum('gpq,bnqgc->bnpgc', w_s, vb) + b_s.T[None, None, :, :, None]
    return u * mixed.reshape(b, n, SGU_WIDTH)


def fourier_mix(f):
    b, n = f.shape[:2]
    fg = f.reshape(b, n, FNET_GROUPS, FNET_GROUP_W).astype(jnp.float32)
    y = jnp.fft.fftn(fg, axes=(1, 3), norm='ortho').real
    return y.astype(f.dtype).reshape(b, n, FNET_WIDTH)


def gated_merge(h, branches, w_gate, w_branch, w_out):
    merged = jax.nn.sigmoid(h @ w_gate[0]) * (branches[0] @ w_branch[0])
    for r in range(1, N_BRANCH):
        merged = merged + jax.nn.sigmoid(h @ w_gate[r]) * (branches[r] @ w_branch[r])
    return merged @ w_out


def mixer_layer(h_lat, h_ctx, w_in, attn_sink, sgu_w, sgu_b, sgu_ln_g, sgu_ln_b, w_gate, w_branch, w_out, need_ctx):
    b, s = h_lat.shape[:2]
    n_ctx = h_ctx.shape[1]
    q_l, k_l, v_l, u_l, z_l, f_l = jnp.split(h_lat @ w_in, IN_SPLITS, axis=-1)
    tables = axial_rope_tables(s, h_lat.dtype)
    q_l = apply_axial_rope(q_l.reshape(b, s, N_Q_HEADS, HEAD_DIM), tables)
    k_l = apply_axial_rope(k_l.reshape(b, s, N_KV_HEADS, HEAD_DIM), tables)
    v_l = v_l.reshape(b, s, N_KV_HEADS, HEAD_DIM)
    if need_ctx:
        q_c, k_c, v_c, u_c, z_c, f_c = jnp.split(h_ctx @ w_in, IN_SPLITS, axis=-1)
    else:
        k_c, v_c = jnp.split(h_ctx @ w_in[:, Q_W:Q_W + 2 * KV_W], 2, axis=-1)
    k_c = k_c.reshape(b, n_ctx, N_KV_HEADS, HEAD_DIM)
    v_c = v_c.reshape(b, n_ctx, N_KV_HEADS, HEAD_DIM)
    branches_lat = (windowed_gqa_with_context(q_l, k_l, v_l, k_c, v_c, attn_sink),
                    chunked_sgu(u_l, z_l, sgu_w, sgu_b, sgu_ln_g, sgu_ln_b),
                    fourier_mix(f_l))
    y_lat = gated_merge(h_lat, branches_lat, w_gate, w_branch, w_out)
    y_ctx = None
    if need_ctx:
        branches_ctx = (context_gqa_with_sink(q_c, k_c, v_c, attn_sink),
                        chunked_sgu(u_c, z_c, sgu_w, sgu_b, sgu_ln_g, sgu_ln_b),
                        fourier_mix(f_c))
        y_ctx = gated_merge(h_ctx, branches_ctx, w_gate, w_branch, w_out)
    return y_lat, y_ctx


def ffn_sublayer(x, mods, j, w_up, w_down, g, b):
    sub = swiglu(modulate(x, mods[3 * j], mods[3 * j + 1]), w_up, w_down)
    return layer_norm(ALPHA * x + 0.5 * mods[3 * j + 2] * sub, g, b)


def setup_inputs(seed: int = 0) -> dict:
    key = jax.random.key(seed)
    ks = jax.random.split(key, 19)
    nrm = lambda k, shape, s: jax.random.normal(k, shape, jnp.float32) * s
    return {
        'x': nrm(ks[0], (BATCH, SEQ, D_MODEL), 1.0),
        'c': nrm(ks[1], (BATCH, D_MODEL), 1.0),
        'ctx': nrm(ks[2], (BATCH, CTX_LEN, D_MODEL), 1.0),
        'c_ctx': nrm(ks[3], (D_MODEL,), 1.0),
        'w_mod': nrm(ks[4], (DEPTH, D_MODEL, N_MOD * D_MODEL), D_MODEL ** -0.5),
        'b_mod': nrm(ks[5], (DEPTH, N_MOD * D_MODEL), 0.02),
        'w_ffn_up': nrm(ks[6], (DEPTH, 2, D_MODEL, 2 * D_FF), D_MODEL ** -0.5),
        'w_ffn_down': nrm(ks[7], (DEPTH, 2, D_FF, D_MODEL), BETA * D_FF ** -0.5),
        'ln_g': 1.0 + nrm(ks[8], (DEPTH, 3, D_MODEL), 0.02),
        'ln_b': nrm(ks[9], (DEPTH, 3, D_MODEL), 0.02),
        'w_in': nrm(ks[10], (DEPTH, D_MODEL, IN_W), D_MODEL ** -0.5),
        'attn_sink': nrm(ks[11], (DEPTH, N_Q_HEADS), 0.5),
        'sgu_w': nrm(ks[12], (DEPTH, SGU_GROUPS, CHUNK, CHUNK), CHUNK ** -0.5),
        'sgu_b': 1.0 + nrm(ks[13], (DEPTH, SGU_GROUPS, CHUNK), 0.02),
        'sgu_ln_g': 1.0 + nrm(ks[14], (DEPTH, SGU_WIDTH), 0.02),
        'sgu_ln_b': nrm(ks[15], (DEPTH, SGU_WIDTH), 0.02),
        'w_gate': nrm(ks[16], (DEPTH, N_BRANCH, D_MODEL, D_MODEL), D_MODEL ** -0.5),
        'w_branch': nrm(ks[17], (DEPTH, N_BRANCH, BRANCH_W, D_MODEL), BRANCH_W ** -0.5),
        'w_out': nrm(ks[18], (DEPTH, D_MODEL, D_MODEL), BETA * D_MODEL ** -0.5),
    }


def reference(x, c, ctx, c_ctx, w_mod, b_mod, w_ffn_up, w_ffn_down, ln_g, ln_b, w_in, attn_sink,
              sgu_w, sgu_b, sgu_ln_g, sgu_ln_b, w_gate, w_branch, w_out):
    x_lat, x_ctx = x, ctx
    for i in range(DEPTH):
        last = i == DEPTH - 1
        m_lat = jnp.split((jax.nn.silu(c) @ w_mod[i] + b_mod[i])[:, None, :], N_MOD, axis=-1)
        m_ctx = jnp.split(jax.nn.silu(c_ctx) @ w_mod[i] + b_mod[i], N_MOD, axis=-1)
        x_lat = ffn_sublayer(x_lat, m_lat, 0, w_ffn_up[i, 0], w_ffn_down[i, 0], ln_g[i, 0], ln_b[i, 0])
        x_ctx = ffn_sublayer(x_ctx, m_ctx, 0, w_ffn_up[i, 0], w_ffn_down[i, 0], ln_g[i, 0], ln_b[i, 0])
        y_lat, y_ctx = mixer_layer(modulate(x_lat, m_lat[3], m_lat[4]), modulate(x_ctx, m_ctx[3], m_ctx[4]),
                                   w_in[i], attn_sink[i], sgu_w[i], sgu_b[i], sgu_ln_g[i], sgu_ln_b[i],
                                   w_gate[i], w_branch[i], w_out[i], not last)
        x_lat = layer_norm(ALPHA * x_lat + m_lat[5] * y_lat, ln_g[i, 1], ln_b[i, 1])
        x_lat = ffn_sublayer(x_lat, m_lat, 2, w_ffn_up[i, 1], w_ffn_down[i, 1], ln_g[i, 2], ln_b[i, 2])
        if not last:
            x_ctx = layer_norm(ALPHA * x_ctx + m_ctx[5] * y_ctx, ln_g[i, 1], ln_b[i, 1])
            x_ctx = ffn_sublayer(x_ctx, m_ctx, 2, w_ffn_up[i, 1], w_ffn_down[i, 1], ln_g[i, 2], ln_b[i, 2])
    return x_lat
```

```cpp
#include <hip/hip_runtime.h>
#include <hip/hip_cooperative_groups.h>
#include <cstdio>
namespace cg = cooperative_groups;

#define LAS __attribute__((address_space(3)))
#define DI __device__ __forceinline__
typedef unsigned short bf16_t;
typedef short bf16x8 __attribute__((ext_vector_type(8)));
typedef float f32x2 __attribute__((ext_vector_type(2)));
typedef float f32x4 __attribute__((ext_vector_type(4)));
typedef float f32x16 __attribute__((ext_vector_type(16)));
typedef unsigned u32x2 __attribute__((ext_vector_type(2)));
typedef unsigned u32x4 __attribute__((ext_vector_type(4)));
typedef __bf16 bfv2 __attribute__((ext_vector_type(2)));

constexpr int D = 1024, NB = 8, SEQ = 4096, DEPTH = 4, CTXL = 256;
constexpr int TL = NB * SEQ, TC = NB * CTXL, T = TL + TC;
constexpr int DFF = 2752, DFFP = 2816, NUP = 5632;
constexpr int HBS = 2560;
constexpr float ALPHA = 1.681792830507429f;
constexpr float LN_EPS = 1e-5f;
constexpr int LDS_BYTES = 144 * 1024;

constexpr size_t OFF_MODS = 0;
constexpr size_t SZ_MODS = 4ull * 9 * 9216 * 4;
constexpr size_t OFF_ROPE = OFF_MODS + SZ_MODS;
constexpr size_t SZ_ROPE = 2ull * 64 * 16 * 4;
constexpr size_t OFF_DFT = OFF_ROPE + SZ_ROPE;
constexpr size_t SZ_DFT = 4096ull * 8192 * 2;
constexpr size_t OFF_DFTC = OFF_DFT + SZ_DFT;
constexpr size_t SZ_DFTC = 256ull * 512 * 2;
constexpr size_t OFF_W = OFF_DFTC + SZ_DFTC;
constexpr size_t W_UP0 = 0, W_DN0 = W_UP0 + 5632ull * 1024, W_UP1 = W_DN0 + 1024ull * 2816, W_DN1 = W_UP1 + 5632ull * 1024,
                 W_IN = W_DN1 + 1024ull * 2816, W_F = W_IN + 1792ull * 1024, W_CAT = W_F + 1024ull * 1024,
                 W_OUT = W_CAT + 3ull * 1024 * 1536, W_END = W_OUT + 1024ull * 1024;
constexpr size_t SZ_W = W_END * 2;
constexpr size_t OFF_X = OFF_W + SZ_W;
constexpr size_t SZ_X = (size_t)T * 1024 * 4;
constexpr size_t OFF_HB = OFF_X + SZ_X;
constexpr size_t SZ_HB = (size_t)T * HBS * 2;
constexpr size_t OFF_R = OFF_HB + SZ_HB;
constexpr size_t R_Q = 0;
constexpr size_t R_U = R_Q + (size_t)T * 512 * 2;
constexpr size_t R_Z = R_U + (size_t)T * 512 * 2;
constexpr size_t R_K = R_Z + (size_t)T * 512 * 2;
constexpr size_t R_VT = R_K + (size_t)T * 128 * 2;
constexpr size_t R_VTC = R_VT + 8ull * 128 * 4096 * 2;
constexpr size_t R_FT = R_VTC + 8ull * 128 * 256 * 2;
constexpr size_t R_FTC = R_FT + 8ull * 512 * 8192 * 2;
constexpr size_t R_END = R_FTC + 8ull * 512 * 512 * 2;
constexpr size_t SZ_R = (size_t)T * DFFP * 2;
static_assert(R_END == SZ_R, "region R");
constexpr size_t R_MERGED = R_Q;
constexpr size_t R_SCR = R_Z;
constexpr size_t WS_END = OFF_R + SZ_R;
static_assert(WS_END <= 721420288ull, "workspace");
static_assert(256ull * 131072 <= (size_t)T * 512 * 2, "scr");

struct Params { const float* in[19]; float* out; unsigned char* ws; };
enum { I_X = 0, I_C, I_CTX, I_CCTX, I_WMOD, I_BMOD, I_WUP, I_WDN, I_LNG, I_LNB, I_WIN, I_SINK, I_SGUW, I_SGUB, I_SGULG, I_SGULB, I_WGATE, I_WBR, I_WOUT };

DI unsigned pk2(float a, float b) { f32x2 v = {a, b}; bfv2 r = __builtin_convertvector(v, bfv2); return __builtin_bit_cast(unsigned, r); }
DI bf16_t f2bf(float a) { return (bf16_t)(pk2(a, 0.f) & 0xffffu); }
DI float bf2f(unsigned b) { return __uint_as_float(b << 16); }
DI float bflo(unsigned w) { return __uint_as_float(w << 16); }
DI float bfhi(unsigned w) { return __uint_as_float(w & 0xffff0000u); }
DI float sigmoidf_(float x) { return 1.0f / (1.0f + __expf(-x)); }
DI float siluf_(float x) { return x / (1.0f + __expf(-x)); }
DI float geluf_(float x) { const float y = 1.5957691216057308f * (x + 0.044715f * x * x * x); return x / (1.0f + __expf(-y)); }
DI int otid() { int t = threadIdx.x; asm volatile("" : "+v"(t)); return t; }
DI int obid() { int b = blockIdx.x; asm volatile("" : "+s"(b)); return b; }
DI unsigned char* ows(const Params& P) { unsigned char* w = P.ws; asm volatile("" : "+s"(w)); return w; }
DI const float* oin(const Params& P, int i) { const float* p = P.in[i]; asm volatile("" : "+s"(p)); return p; }
DI float wave_sum(float v) {
#pragma unroll
    for (int o = 32; o >= 1; o >>= 1) v += __shfl_xor(v, o);
    return v;
}

constexpr int BM = 256, BK = 64, HALF = 128, HTB = HALF * BK * 2, NXCD = 8, WGM = 8;
DI int lds_byte(int r, int c) { const int st = (r >> 4) * 2 + (c >> 5), rr = r & 15, cc = c & 31, ob = rr * 64 + cc * 2; return st * 1024 + (ob ^ (((ob >> 9) & 1) << 5)); }
DI void stage_rc(int b, int& R, int& C) { const int st = b / 1024, sb = b % 1024, swz = sb ^ (((sb >> 9) & 1) << 5); R = (st >> 1) * 16 + swz / 64; C = (st & 1) * 32 + (swz % 64) / 2; }

struct Unit { int pm, pn, aux; };

struct SchedTile {
    const char* Ab; const char* Bb; size_t tA, tB; int nM, nN, nwg, G, c;
    DI void init(const void* A, size_t tA_, const void* B, size_t tB_, int nM_, int nN_) { Ab = (const char*)A; Bb = (const char*)B; tA = tA_; tB = tB_; nM = nM_; nN = nN_; nwg = nM * nN; G = gridDim.x; c = obid(); }
    DI bool next(int i, Unit& u) const {
        const long L = (long)i * G + c; if (L >= nwg) return false;
        int wgid = (int)L; { const int q = nwg / NXCD, r = nwg % NXCD, xcd = wgid % NXCD, off = wgid / NXCD; wgid = (xcd < r ? xcd * (q + 1) : r * (q + 1) + (xcd - r) * q) + off; }
        const int nig = WGM * nN, gid = wgid / nig, fm = gid * WGM, gsz = (nM - fm) < WGM ? (nM - fm) : WGM;
        u.pm = fm + ((wgid % nig) % gsz); u.pn = (wgid % nig) / gsz; u.aux = 0; return true;
    }
    DI const char* A(const Unit& u) const { return Ab + (size_t)u.pm * tA; }
    DI const char* B(const Unit& u) const { return Bb + (size_t)u.pn * tB; }
};

struct SchedBr {
    const char* HBp; const char* Wc; int G, c;
    DI bool next(int i, Unit& u) const { const int ti = (i / 9) * G + c; if (ti >= 544) return false; u.pm = ti >> 2; u.pn = ti & 3; u.aux = i % 9; return true; }
    DI const char* A(const Unit& u) const { const int pass = u.aux % 3, r = u.aux / 3; const int off = pass == 0 ? 0 : (pass == 1 ? 512 : 1024 + r * 512); return HBp + ((size_t)u.pm * 256 * HBS + off) * 2; }
    DI const char* B(const Unit& u) const { const int pass = u.aux % 3, r = u.aux / 3; const int off = pass == 0 ? 512 : (pass == 1 ? 1024 : 0); return Wc + ((size_t)(r * 1024 + u.pn * 256) * 1536 + off) * 2; }
};

template <int K, int lda, int ldb, class Epi, class Sched>
DI void gemm_phase(LAS unsigned char* lds, const Sched& S, const Epi& E) {
    const int tid = otid(), wid = __builtin_amdgcn_readfirstlane(tid >> 6), lane = tid & 63, wr = wid >> 2, wc = wid & 3, fr = lane & 15, fq = lane >> 4;
    constexpr int nt = K / BK;
    unsigned voffA[2], voffB[2];
#pragma unroll
    for (int i = 0; i < 2; ++i) { int R, C; stage_rc(tid * 16 + i * 8192, R, C); voffA[i] = (unsigned)(R * lda + C) * 2u; voffB[i] = (unsigned)(R * ldb + C) * 2u; }
    constexpr size_t kstep = (size_t)(BK * 2);
    constexpr size_t hstepA = (size_t)HALF * lda * 2, hstepB = (size_t)HALF * ldb * 2;
    const unsigned ldsw = (unsigned)wid * 1024u;
    const int aoff = lds_byte(wr * 64 + fr, fq * 8), boff = lds_byte(wc * 32 + fr, fq * 8);
#define PG8_SA(b, h) (((b) * 2 + (h)) * HTB)
#define PG8_SB(b, h) ((4 + (b) * 2 + (h)) * HTB)
#define PG8_STAGE(bufoff, gbase, voff) do { _Pragma("unroll") for (int _i = 0; _i < 2; ++_i) \
        __builtin_amdgcn_global_load_lds((const unsigned*)((const char*)(gbase) + (voff)[_i]), (LAS unsigned*)(lds + (bufoff) + ldsw + _i * 8192), 16, 0, 0); } while (0)
#define PG8_LDA(dst, b, h) do { _Pragma("unroll") for (int m = 0; m < 4; ++m) _Pragma("unroll") for (int k = 0; k < 2; ++k) dst[m][k] = *(const LAS bf16x8*)(lds + PG8_SA(b, h) + aoff + m * 2048 + k * 1024); } while (0)
#define PG8_LDB(dst, b, h) do { _Pragma("unroll") for (int n = 0; n < 2; ++n) _Pragma("unroll") for (int k = 0; k < 2; ++k) dst[n][k] = *(const LAS bf16x8*)(lds + PG8_SB(b, h) + boff + n * 2048 + k * 1024); } while (0)
#define PG8_MMA(ai, bj, At, Bt) do { __builtin_amdgcn_s_setprio(1); _Pragma("unroll") for (int m = 0; m < 4; ++m) _Pragma("unroll") for (int n = 0; n < 2; ++n) _Pragma("unroll") for (int k = 0; k < 2; ++k) \
        acc[ai][bj][m][n] = __builtin_amdgcn_mfma_f32_16x16x32_bf16(Bt[n][k], At[m][k], acc[ai][bj][m][n], 0, 0, 0); __builtin_amdgcn_s_setprio(0); } while (0)
#define PG8_WAIT_V(n) asm volatile("s_waitcnt vmcnt(" #n ")" ::: "memory")
#define PG8_WAIT_L(n) asm volatile("s_waitcnt lgkmcnt(" #n ")" ::: "memory")
#define PG8_BAR __builtin_amdgcn_s_barrier()
#define PG8_SCHED __builtin_amdgcn_sched_barrier(0)
    Unit cur, nxt; int ui = 0;
    if (!S.next(0, cur)) return;
    f32x4 acc[2][2][4][2];
#pragma unroll
    for (int a = 0; a < 2; ++a)
#pragma unroll
        for (int b = 0; b < 2; ++b)
#pragma unroll
            for (int m = 0; m < 4; ++m)
#pragma unroll
                for (int n = 0; n < 2; ++n) acc[a][b][m][n] = (f32x4){0.f, 0.f, 0.f, 0.f};
    bf16x8 At[4][2], B0[2][2], B1[2][2];
    const char* cA = S.A(cur); const char* cB = S.B(cur);
    PG8_STAGE(PG8_SB(0, 0), cB, voffB); PG8_STAGE(PG8_SA(0, 0), cA, voffA); PG8_STAGE(PG8_SB(0, 1), cB + hstepB, voffB); PG8_STAGE(PG8_SA(0, 1), cA + hstepA, voffA);
    if (wr == 1) PG8_BAR;
    PG8_WAIT_V(4); PG8_BAR;
    PG8_STAGE(PG8_SB(1, 0), cB + kstep, voffB); PG8_STAGE(PG8_SA(1, 0), cA + kstep, voffA); PG8_STAGE(PG8_SB(1, 1), cB + hstepB + kstep, voffB);
    PG8_WAIT_V(6); PG8_BAR;
    for (;;) {
        const bool has_next = S.next(ui + 1, nxt);
        const char* nA = has_next ? S.A(nxt) : cA; const char* nB = has_next ? S.B(nxt) : cB;
        for (int t = 0; t < nt; t += 2) {
            const bool last = (t == nt - 2);
            const char* a1 = cA + (size_t)(t + 1) * kstep;
            const char* a2 = last ? nA : cA + (size_t)(t + 2) * kstep; const char* b2 = last ? nB : cB + (size_t)(t + 2) * kstep;
            const char* a3 = a2 + kstep; const char* b3 = b2 + kstep;
            PG8_LDB(B0, 0, 0); PG8_SCHED; PG8_LDA(At, 0, 0); PG8_STAGE(PG8_SA(1, 1), a1 + hstepA, voffA);
            PG8_WAIT_L(8); PG8_BAR; PG8_WAIT_L(0); PG8_MMA(0, 0, At, B0); PG8_BAR; PG8_SCHED;
            PG8_LDB(B1, 0, 1); PG8_STAGE(PG8_SB(0, 0), b2, voffB);
            PG8_BAR; PG8_WAIT_L(0); PG8_MMA(0, 1, At, B1); PG8_BAR;
            PG8_LDA(At, 0, 1); PG8_STAGE(PG8_SA(0, 0), a2, voffA);
            PG8_BAR; PG8_WAIT_L(0); PG8_MMA(1, 0, At, B0); PG8_BAR; PG8_SCHED;
            PG8_STAGE(PG8_SB(0, 1), b2 + hstepB, voffB);
            PG8_WAIT_V(6); PG8_BAR; PG8_MMA(1, 1, At, B1); PG8_BAR;
            PG8_LDB(B0, 1, 0); PG8_SCHED; PG8_LDA(At, 1, 0); PG8_STAGE(PG8_SA(0, 1), a2 + hstepA, voffA);
            PG8_WAIT_L(8); PG8_BAR; PG8_WAIT_L(0); PG8_MMA(0, 0, At, B0); PG8_BAR; PG8_SCHED;
            PG8_LDB(B1, 1, 1); PG8_STAGE(PG8_SB(1, 0), b3, voffB);
            PG8_BAR; PG8_WAIT_L(0); PG8_MMA(0, 1, At, B1); PG8_BAR;
            PG8_LDA(At, 1, 1); PG8_STAGE(PG8_SA(1, 0), a3, voffA);
            PG8_BAR; PG8_WAIT_L(0); PG8_MMA(1, 0, At, B0); PG8_BAR; PG8_SCHED;
            PG8_STAGE(PG8_SB(1, 1), b3 + hstepB, voffB);
            PG8_WAIT_V(6); PG8_BAR; PG8_MMA(1, 1, At, B1); PG8_BAR;
        }
        const bool zero = E(acc, cur, wr, wc, fr, fq);
        if (!has_next) break;
        if (zero) {
#pragma unroll
            for (int a = 0; a < 2; ++a)
#pragma unroll
                for (int b = 0; b < 2; ++b)
#pragma unroll
                    for (int m = 0; m < 4; ++m)
#pragma unroll
                        for (int n = 0; n < 2; ++n) acc[a][b][m][n] = (f32x4){0.f, 0.f, 0.f, 0.f};
        }
        cur = nxt; cA = nA; cB = nB; ++ui;
    }
    PG8_WAIT_V(0);
    if (wr == 0) PG8_BAR;
    PG8_BAR;
#undef PG8_SA
#undef PG8_SB
#undef PG8_STAGE
#undef PG8_LDA
#undef PG8_LDB
#undef PG8_MMA
#undef PG8_WAIT_V
#undef PG8_WAIT_L
#undef PG8_BAR
#undef PG8_SCHED
}

typedef f32x4 AccT[2][2][4][2];

struct EpiUp {
    bf16_t* act;
    DI bool operator()(const AccT& acc, const Unit& u, int wr, int wc, int fr, int fq) const {
        asm volatile("" : "+v"(fr), "+v"(fq));
        const int row0 = u.pm * BM + wr * 64 + fr, c0 = u.pn * 128 + wc * 16 + 4 * fq;
#pragma unroll
        for (int ai = 0; ai < 2; ++ai)
#pragma unroll
            for (int m = 0; m < 4; ++m) { bf16_t* rowp = act + (size_t)(row0 + ai * HALF + m * 16) * DFFP + c0;
#pragma unroll
                for (int bj = 0; bj < 2; ++bj) { const f32x4 g = acc[ai][bj][m][0], up = acc[ai][bj][m][1];
                    u32x2 w; w.x = pk2(siluf_(g[0]) * up[0], siluf_(g[1]) * up[1]); w.y = pk2(siluf_(g[2]) * up[2], siluf_(g[3]) * up[3]);
                    *(u32x2*)(rowp + bj * 64) = w; } }
        return true;
    }
};

struct EpiRes {
    float* X; const float* gm; float s;
    DI bool operator()(const AccT& acc, const Unit& u, int wr, int wc, int fr, int fq) const {
        asm volatile("" : "+v"(fr), "+v"(fq));
        const int row0 = u.pm * BM + wr * 64 + fr, col0 = u.pn * BM + wc * 32 + 4 * fq;
        const int rb = (u.pm * BM < TL) ? ((u.pm * BM) >> 12) : 8;
        const float* gp = gm + (size_t)rb * 9216 + col0;
        f32x4 gv[2][2];
#pragma unroll
        for (int bj = 0; bj < 2; ++bj)
#pragma unroll
            for (int n = 0; n < 2; ++n) gv[bj][n] = *(const f32x4*)(gp + bj * HALF + n * 16) * s;
#pragma unroll
        for (int ai = 0; ai < 2; ++ai)
#pragma unroll
            for (int m = 0; m < 4; ++m) { float* rowp = X + (size_t)(row0 + ai * HALF + m * 16) * D + col0;
#pragma unroll
                for (int bj = 0; bj < 2; ++bj)
#pragma unroll
                    for (int n = 0; n < 2; ++n) { f32x4* px = (f32x4*)(rowp + bj * HALF + n * 16); const f32x4 x = *px; *px = x * ALPHA + gv[bj][n] * acc[ai][bj][m][n]; } }
        return true;
    }
};

struct EpiIn {
    bf16_t* Q; bf16_t* Kb; bf16_t* VT; bf16_t* VTC; bf16_t* U; bf16_t* Z; const float* ropec; const float* ropes;
    DI bool operator()(const AccT& acc, const Unit& u, int wr, int wc, int fr, int fq) const {
        asm volatile("" : "+v"(fr), "+v"(fq));
        const int row0 = u.pm * BM + wr * 64 + fr;
        const bool lat = (u.pm * BM) < TL;
        const int pn = u.pn;
#pragma unroll
        for (int ai = 0; ai < 2; ++ai)
#pragma unroll
            for (int m = 0; m < 4; ++m) {
                const int row = row0 + ai * HALF + m * 16;
                if (pn <= 2) {
                    const int s = row & 4095;
                    const int p = (wc & 1) ? (s & 63) : (s >> 6);
                    f32x4 cs = (f32x4){1.f, 1.f, 1.f, 1.f}, sn = (f32x4){0.f, 0.f, 0.f, 0.f};
                    if (lat) { cs = *(const f32x4*)(ropec + p * 16 + 4 * fq); sn = *(const f32x4*)(ropes + p * 16 + 4 * fq); }
#pragma unroll
                    for (int bj = 0; bj < 2; ++bj) {
                        const f32x4 x1 = acc[ai][bj][m][0], x2 = acc[ai][bj][m][1];
                        if (pn < 2 || bj == 0) {
                            const f32x4 o1 = x1 * cs - x2 * sn, o2 = x1 * sn + x2 * cs;
                            u32x2 w1, w2; w1.x = pk2(o1[0], o1[1]); w1.y = pk2(o1[2], o1[3]); w2.x = pk2(o2[0], o2[1]); w2.y = pk2(o2[2], o2[3]);
                            bf16_t* dst = (pn < 2) ? (Q + (size_t)row * 512 + pn * 256 + bj * HALF + wc * 32 + 4 * fq) : (Kb + (size_t)row * 128 + wc * 32 + 4 * fq);
                            *(u32x2*)dst = w1; *(u32x2*)(dst + 16) = w2;
                        } else {
                            const int cv = wc * 32 + 4 * fq;
                            bf16_t* dst; size_t cst;
                            if (lat) { const int b = row >> 12; dst = VT + ((size_t)(b * 128 + cv)) * 4096 + s; cst = 4096; }
                            else { const int rc = row - TL; const int b = rc >> 8; dst = VTC + ((size_t)(b * 128 + cv)) * 256 + (rc & 255); cst = 256; }
#pragma unroll
                            for (int j = 0; j < 4; ++j) { dst[(size_t)j * cst] = f2bf(x1[j]); dst[(size_t)(16 + j) * cst] = f2bf(x2[j]); }
                        }
                    }
                } else {
                    bf16_t* base = (pn <= 4) ? (U + (size_t)row * 512 + (pn - 3) * 256) : (Z + (size_t)row * 512 + (pn - 5) * 256);
                    base += wc * 32 + 4 * fq;
#pragma unroll
                    for (int bj = 0; bj < 2; ++bj)
#pragma unroll
                        for (int n = 0; n < 2; ++n) { const f32x4 v = acc[ai][bj][m][n];
                            u32x2 w; w.x = pk2(geluf_(v[0]), geluf_(v[1])); w.y = pk2(geluf_(v[2]), geluf_(v[3]));
                            *(u32x2*)(base + bj * HALF + n * 16) = w; }
                }
            }
        return true;
    }
};

struct EpiFT {
    bf16_t* FT; bf16_t* FTC;
    DI bool operator()(const AccT& acc, const Unit& u, int wr, int wc, int fr, int fq) const {
        asm volatile("" : "+v"(fr), "+v"(fq));
        const int isS = u.pm >> 1;
        const int ch0 = (u.pm & 1) * 256 + wr * 64 + fr;
        bf16_t* base; size_t rst;
        if (u.pn < 128) { const int b = u.pn >> 4; base = FT + (size_t)b * 512 * 8192 + isS * 4096 + ((u.pn & 15) * 256) + wc * 32 + 4 * fq; rst = 8192; }
        else { const int b = u.pn - 128; base = FTC + (size_t)b * 512 * 512 + isS * 256 + wc * 32 + 4 * fq; rst = 512; }
#pragma unroll
        for (int ai = 0; ai < 2; ++ai)
#pragma unroll
            for (int m = 0; m < 4; ++m) { bf16_t* rowp = base + (size_t)(ch0 + ai * HALF + m * 16) * rst;
#pragma unroll
                for (int bj = 0; bj < 2; ++bj)
#pragma unroll
                    for (int n = 0; n < 2; ++n) { const f32x4 v = acc[ai][bj][m][n]; u32x2 w; w.x = pk2(v[0], v[1]); w.y = pk2(v[2], v[3]); *(u32x2*)(rowp + bj * HALF + n * 16) = w; } }
        return true;
    }
};

struct EpiDft {
    bf16_t* HB; int rowbase, rpb;
    DI bool operator()(const AccT& acc, const Unit& u, int wr, int wc, int fr, int fq) const {
        asm volatile("" : "+v"(fr), "+v"(fq));
        const int b = u.pn >> 1;
        const int k0 = u.pm * BM + wr * 64 + fr;
        bf16_t* base = HB + (size_t)(rowbase + b * rpb) * HBS + 2048 + (u.pn & 1) * 256 + wc * 32 + 4 * fq;
#pragma unroll
        for (int ai = 0; ai < 2; ++ai)
#pragma unroll
            for (int m = 0; m < 4; ++m) { bf16_t* rowp = base + (size_t)(k0 + ai * HALF + m * 16) * HBS;
#pragma unroll
                for (int bj = 0; bj < 2; ++bj)
#pragma unroll
                    for (int n = 0; n < 2; ++n) { const f32x4 v = acc[ai][bj][m][n]; u32x2 w; w.x = pk2(v[0], v[1]); w.y = pk2(v[2], v[3]); *(u32x2*)(rowp + bj * HALF + n * 16) = w; } }
        return true;
    }
};

struct EpiBr {
    bf16_t* merged; unsigned char* scr;
    DI bool operator()(const AccT& acc, const Unit& u, int wr, int wc, int fr, int fq) const {
        asm volatile("" : "+v"(fr), "+v"(fq));
        const int pass = u.aux % 3, r = u.aux / 3;
        if (pass == 0) return false;
        const int tid = (wr * 4 + wc) * 64 + fq * 16 + fr;
        if (pass == 1) {
#pragma unroll
            for (int ai = 0; ai < 2; ++ai)
#pragma unroll
                for (int bj = 0; bj < 2; ++bj)
#pragma unroll
                    for (int m = 0; m < 4; ++m) { const f32x4 a = acc[ai][bj][m][0], b = acc[ai][bj][m][1];
                        u32x4 w; w.x = pk2(sigmoidf_(a[0]), sigmoidf_(a[1])); w.y = pk2(sigmoidf_(a[2]), sigmoidf_(a[3])); w.z = pk2(sigmoidf_(b[0]), sigmoidf_(b[1])); w.w = pk2(sigmoidf_(b[2]), sigmoidf_(b[3]));
                        *(u32x4*)(scr + ((size_t)(((ai * 2 + bj) * 4 + m) * 512 + tid)) * 16) = w; }
            return true;
        }
        const int row0 = u.pm * BM + wr * 64 + fr, col0 = u.pn * BM + wc * 32 + 4 * fq;
#pragma unroll
        for (int ai = 0; ai < 2; ++ai)
#pragma unroll
            for (int bj = 0; bj < 2; ++bj)
#pragma unroll
                for (int m = 0; m < 4; ++m) {
                    const u32x4 g = *(const u32x4*)(scr + ((size_t)(((ai * 2 + bj) * 4 + m) * 512 + tid)) * 16);
                    const f32x4 a = acc[ai][bj][m][0], b = acc[ai][bj][m][1];
                    f32x4 va = (f32x4){bflo(g.x) * a[0], bfhi(g.x) * a[1], bflo(g.y) * a[2], bfhi(g.y) * a[3]};
                    f32x4 vb = (f32x4){bflo(g.z) * b[0], bfhi(g.z) * b[1], bflo(g.w) * b[2], bfhi(g.w) * b[3]};
                    bf16_t* dst = merged + (size_t)(row0 + ai * HALF + m * 16) * D + col0 + bj * HALF;
                    if (r != 0) { const u32x2 o0 = *(const u32x2*)dst, o1 = *(const u32x2*)(dst + 16);
                        va += (f32x4){bflo(o0.x), bfhi(o0.x), bflo(o0.y), bfhi(o0.y)}; vb += (f32x4){bflo(o1.x), bfhi(o1.x), bflo(o1.y), bfhi(o1.y)}; }
                    u32x2 w0, w1; w0.x = pk2(va[0], va[1]); w0.y = pk2(va[2], va[3]); w1.x = pk2(vb[0], vb[1]); w1.y = pk2(vb[2], vb[3]);
                    *(u32x2*)dst = w0; *(u32x2*)(dst + 16) = w1;
                }
        return true;
    }
};

DI void phase_mods(const Params& P, unsigned char* shm) {
    float* s = (float*)shm;
    float* red = s + 9 * 1024;
    const int tid = otid();
    const float* c = oin(P, I_C); const float* cc = oin(P, I_CCTX);
    for (int idx = tid; idx < 9 * 1024; idx += 512) { const int rb = idx >> 10, k = idx & 1023; const float v = rb < 8 ? c[rb * 1024 + k] : cc[k]; s[idx] = siluf_(v); }
    __syncthreads();
    float* mods = (float*)(ows(P) + OFF_MODS);
    const float* wmod = oin(P, I_WMOD); const float* bmod = oin(P, I_BMOD);
    for (int u = obid(); u < 288; u += gridDim.x) {
        const int l = u / 72, n0 = (u % 72) * 128, cgp = tid & 31, ks = tid >> 5;
        f32x4 acc[9];
#pragma unroll
        for (int rb = 0; rb < 9; ++rb) acc[rb] = (f32x4){0.f, 0.f, 0.f, 0.f};
        const float* wp = wmod + ((size_t)l * 1024 + ks * 64) * 9216 + n0 + cgp * 4;
        for (int kk = 0; kk < 64; ++kk) { const f32x4 w = *(const f32x4*)(wp + (size_t)kk * 9216);
#pragma unroll
            for (int rb = 0; rb < 9; ++rb) acc[rb] += w * s[rb * 1024 + ks * 64 + kk]; }
#pragma unroll
        for (int rb = 0; rb < 9; ++rb) *(f32x4*)(red + ((ks * 9 + rb) * 128 + cgp * 4)) = acc[rb];
        __syncthreads();
        for (int idx = tid; idx < 1152; idx += 512) { const int rb = idx >> 7, c2 = idx & 127; float sum = bmod[l * 9216 + n0 + c2];
            for (int k2 = 0; k2 < 16; ++k2) sum += red[(k2 * 9 + rb) * 128 + c2];
            mods[((size_t)l * 9 + rb) * 9216 + n0 + c2] = sum; }
        __syncthreads();
    }
}

DI void phase_tables(const Params& P, unsigned char* shm) {
    const int tid = otid();
    float* tab = (float*)shm;
    for (int j = tid; j < 4096; j += 512) tab[j] = cospif((float)j * (1.0f / 2048.0f)) * (1.0f / 64.0f);
    __syncthreads();
    if (obid() == 0) {
        float* rc = (float*)(ows(P) + OFF_ROPE); float* rs = rc + 1024;
        for (int idx = tid; idx < 1024; idx += 512) { const int p = idx >> 4, f = idx & 15; const float inv = powf(10000.0f, -(float)f / 16.0f); const float ang = (float)p * inv; rc[idx] = cosf(ang); rs[idx] = sinf(ang); }
    }
    bf16_t* dft = (bf16_t*)(ows(P) + OFF_DFT);
    const long gid = (long)obid() * 512 + tid, gstride = (long)gridDim.x * 512;
    for (long it = gid; it < 4096l * 1024; it += gstride) {
        const int k = (int)(it >> 10), n0 = ((int)it & 1023) * 8; const bool isS = n0 >= 4096; const int nn = n0 & 4095;
        float v[8];
#pragma unroll
        for (int j = 0; j < 8; ++j) { const int idx = (k * (nn + j)) & 4095; v[j] = isS ? -tab[(idx + 3072) & 4095] : tab[idx]; }
        u32x4 w; w.x = pk2(v[0], v[1]); w.y = pk2(v[2], v[3]); w.z = pk2(v[4], v[5]); w.w = pk2(v[6], v[7]);
        *(u32x4*)(dft + (size_t)k * 8192 + n0) = w;
    }
    bf16_t* dftc = (bf16_t*)(ows(P) + OFF_DFTC);
    for (long it = gid; it < 256l * 64; it += gstride) {
        const int k = (int)(it >> 6), n0 = ((int)it & 63) * 8; const bool isS = n0 >= 256; const int nn = n0 & 255;
        float v[8];
#pragma unroll
        for (int j = 0; j < 8; ++j) { const int idx = ((k * (nn + j)) & 255) * 16; v[j] = (isS ? -tab[(idx + 3072) & 4095] : tab[idx]) * 4.0f; }
        u32x4 w; w.x = pk2(v[0], v[1]); w.y = pk2(v[2], v[3]); w.z = pk2(v[4], v[5]); w.w = pk2(v[6], v[7]);
        *(u32x4*)(dftc + (size_t)k * 512 + n0) = w;
    }
    __syncthreads();
}

DI void wconv_tile(const float* src, int lds_, int Ksrc, int mode, bf16_t* dst, int ldd, int coff, int kt, int ntile, float* tile) {
    const int tid = otid();
    const int k0 = kt * 64, n0 = ntile * 64;
    { const int nn = tid & 63, np = n0 + nn; int col = np;
      if (mode == 1) { const int t = np >> 8, w = np & 255, grp = w >> 5, isup = (w >> 4) & 1, i = w & 15; const int ff = t * 128 + grp * 16 + i; col = ff < DFF ? ff + isup * DFF : -1; }
#pragma unroll
      for (int i = 0; i < 8; ++i) { const int kk = (tid >> 6) + i * 8, k = k0 + kk; float v = 0.f; if (col >= 0 && k < Ksrc) v = src[(size_t)k * lds_ + col]; tile[kk * 65 + nn] = v; } }
    __syncthreads();
    { const int nn2 = tid >> 3, kq = (tid & 7) * 8; float v[8];
#pragma unroll
      for (int j = 0; j < 8; ++j) v[j] = tile[(kq + j) * 65 + nn2];
      u32x4 w; w.x = pk2(v[0], v[1]); w.y = pk2(v[2], v[3]); w.z = pk2(v[4], v[5]); w.w = pk2(v[6], v[7]);
      *(u32x4*)(dst + (size_t)(n0 + nn2) * ldd + coff + k0 + kq) = w; }
    __syncthreads();
}

DI void phase_wconv(const Params& P, int l, unsigned char* shm) {
    float* tile = (float*)shm;
    bf16_t* W = (bf16_t*)(ows(P) + OFF_W);
    const int tid = otid();
    constexpr int N_UP = 16 * 88, N_DN = 44 * 16, N_IN = 16 * 28, N_CB = 8 * 16, N_CG = 16 * 16, N_OUT = 16 * 16, N_WF = 128;
    constexpr int TOT = 2 * N_UP + 2 * N_DN + N_IN + 3 * N_CB + 3 * N_CG + N_OUT + N_WF;
    for (int u = obid(); u < TOT; u += gridDim.x) {
        int v = u;
        if (v < 2 * N_UP) { const int f = v / N_UP; v %= N_UP; wconv_tile(oin(P, I_WUP) + ((size_t)(l * 2 + f)) * 1024 * 5504, 5504, 1024, 1, W + (f ? W_UP1 : W_UP0), 1024, 0, v % 16, v / 16, tile); continue; }
        v -= 2 * N_UP;
        if (v < 2 * N_DN) { const int f = v / N_DN; v %= N_DN; wconv_tile(oin(P, I_WDN) + ((size_t)(l * 2 + f)) * 2752 * 1024, 1024, 2752, 0, W + (f ? W_DN1 : W_DN0), 2816, 0, v % 44, v / 44, tile); continue; }
        v -= 2 * N_DN;
        if (v < N_IN) { wconv_tile(oin(P, I_WIN) + (size_t)l * 1024 * 2304, 2304, 1024, 0, W + W_IN, 1024, 0, v % 16, v / 16, tile); continue; }
        v -= N_IN;
        if (v < 3 * N_CB) { const int r = v / N_CB; v %= N_CB; wconv_tile(oin(P, I_WBR) + ((size_t)(l * 3 + r)) * 512 * 1024, 1024, 512, 0, W + W_CAT + (size_t)r * 1024 * 1536, 1536, 0, v % 8, v / 8, tile); continue; }
        v -= 3 * N_CB;
        if (v < 3 * N_CG) { const int r = v / N_CG; v %= N_CG; wconv_tile(oin(P, I_WGATE) + ((size_t)(l * 3 + r)) * 1024 * 1024, 1024, 1024, 0, W + W_CAT + (size_t)r * 1024 * 1536, 1536, 512, v % 16, v / 16, tile); continue; }
        v -= 3 * N_CG;
        if (v < N_OUT) { wconv_tile(oin(P, I_WOUT) + (size_t)l * 1024 * 1024, 1024, 1024, 0, W + W_OUT, 1024, 0, v % 16, v / 16, tile); continue; }
        v -= N_OUT;
        {
            float* rows = tile; float* tab = rows + 4096;
            const float* src = oin(P, I_WIN) + (size_t)l * 1024 * 2304 + (size_t)(v * 8) * 2304 + 1792;
            for (int idx = tid; idx < 4096; idx += 512) rows[idx] = src[(size_t)(idx >> 9) * 2304 + (idx & 511)];
            if (tid < 128) tab[tid] = cospif((float)tid * (1.0f / 64.0f));
            __syncthreads();
            const int g = tid >> 7, m = tid & 127;
            float ac[8], as[8];
#pragma unroll
            for (int kk = 0; kk < 8; ++kk) { ac[kk] = 0.f; as[kk] = 0.f; }
            for (int c2 = 0; c2 < 128; ++c2) { const int idx = (m * c2) & 127; const float cv = tab[idx], sv = tab[(idx + 96) & 127];
#pragma unroll
                for (int kk = 0; kk < 8; ++kk) { const float w = rows[kk * 512 + g * 128 + c2]; ac[kk] += w * cv; as[kk] += w * sv; } }
            const float sc = 0.08838834764831845f;
            u32x4 wc_, ws_; wc_.x = pk2(ac[0] * sc, ac[1] * sc); wc_.y = pk2(ac[2] * sc, ac[3] * sc); wc_.z = pk2(ac[4] * sc, ac[5] * sc); wc_.w = pk2(ac[6] * sc, ac[7] * sc);
            ws_.x = pk2(as[0] * sc, as[1] * sc); ws_.y = pk2(as[2] * sc, as[3] * sc); ws_.z = pk2(as[4] * sc, as[5] * sc); ws_.w = pk2(as[6] * sc, as[7] * sc);
            *(u32x4*)(W + W_F + (size_t)tid * 1024 + v * 8) = wc_;
            *(u32x4*)(W + W_F + (size_t)(512 + tid) * 1024 + v * 8) = ws_;
            __syncthreads();
        }
    }
}

DI void phase_norm(const Params& P, const float* g, const float* bt, const float* mod, int jm, float* outp) {
    const int tid = otid(), wid = tid >> 6, lane = tid & 63;
    float* X = (float*)(ows(P) + OFF_X); bf16_t* HB = (bf16_t*)(ows(P) + OFF_HB);
    const int rend = outp ? TL : T;
    for (int r = obid() * 8 + wid; r < rend; r += gridDim.x * 8) {
        const float* src = g ? (X + (size_t)r * D) : (r < TL ? oin(P, I_X) + (size_t)r * D : oin(P, I_CTX) + (size_t)(r - TL) * D);
        f32x4 v[4];
#pragma unroll
        for (int q = 0; q < 4; ++q) v[q] = *(const f32x4*)(src + q * 256 + lane * 4);
        if (g) {
            float sum = 0.f;
#pragma unroll
            for (int q = 0; q < 4; ++q) sum += v[q][0] + v[q][1] + v[q][2] + v[q][3];
            const float mu = wave_sum(sum) * (1.0f / 1024.0f);
            float sq = 0.f;
#pragma unroll
            for (int q = 0; q < 4; ++q) { v[q] -= mu; sq += v[q][0] * v[q][0] + v[q][1] * v[q][1] + v[q][2] * v[q][2] + v[q][3] * v[q][3]; }
            const float rstd = rsqrtf(wave_sum(sq) * (1.0f / 1024.0f) + LN_EPS);
#pragma unroll
            for (int q = 0; q < 4; ++q) { const f32x4 gg = *(const f32x4*)(g + q * 256 + lane * 4), bb = *(const f32x4*)(bt + q * 256 + lane * 4); v[q] = v[q] * rstd * gg + bb; }
        }
#pragma unroll
        for (int q = 0; q < 4; ++q) *(f32x4*)(X + (size_t)r * D + q * 256 + lane * 4) = v[q];
        if (outp) {
#pragma unroll
            for (int q = 0; q < 4; ++q) *(f32x4*)(outp + (size_t)r * D + q * 256 + lane * 4) = v[q];
        }
        if (mod) {
            const int rb = r < TL ? (r >> 12) : 8;
            const float* sh = mod + (size_t)rb * 9216 + jm * 1024; const float* sc = sh + 1024;
#pragma unroll
            for (int q = 0; q < 4; ++q) { const f32x4 a = *(const f32x4*)(sh + q * 256 + lane * 4), b = *(const f32x4*)(sc + q * 256 + lane * 4);
                const f32x4 h = v[q] * (b + 1.0f) + a; u32x2 w; w.x = pk2(h[0], h[1]); w.y = pk2(h[2], h[3]);
                *(u32x2*)(HB + (size_t)r * HBS + q * 256 + lane * 4) = w; }
        }
    }
}

#define MFMA32(a, b, c) __builtin_amdgcn_mfma_f32_32x32x16_bf16((a), (b), (c), 0, 0, 0)
DI bf16x8 mk8(u32x2 lo, u32x2 hi) { u32x4 w; w.x = lo.x; w.y = lo.y; w.z = hi.x; w.w = hi.y; return __builtin_bit_cast(bf16x8, w); }

struct AttnState { float m, l; f32x16 O[2]; };

template <bool MASKED>
DI void attn_tile(AttnState& st, const bf16x8 (&Qf)[4], const bf16_t* kp, const bf16_t* vp, size_t vstride, int hh, int qpos, int klo) {
    bf16x8 Kf[4];
#pragma unroll
    for (int kk = 0; kk < 4; ++kk) Kf[kk] = *(const bf16x8*)(kp + kk * 16);
    bf16x8 Vf[2][2];
#pragma unroll
    for (int db = 0; db < 2; ++db)
#pragma unroll
        for (int c = 0; c < 2; ++c) { const bf16_t* p = vp + (size_t)db * 32 * vstride + 16 * c; Vf[db][c] = mk8(*(const u32x2*)p, *(const u32x2*)(p + 8)); }
    f32x16 s;
#pragma unroll
    for (int i = 0; i < 16; ++i) s[i] = 0.f;
#pragma unroll
    for (int kk = 0; kk < 4; ++kk) s = MFMA32(Kf[kk], Qf[kk], s);
    float tmax = -3.0e38f;
#pragma unroll
    for (int i = 0; i < 16; ++i) {
        float sv = s[i] * 0.125f;
        if (MASKED) { const int kpos = klo + (i & 3) + 8 * (i >> 2) + 4 * hh; const int dlt = qpos - kpos; if (dlt > 128 || dlt < -128) sv = -3.0e38f; }
        s[i] = sv; tmax = fmaxf(tmax, sv);
    }
    tmax = fmaxf(tmax, __shfl_xor(tmax, 32));
    const float mnew = fmaxf(st.m, tmax);
    const float alpha = __expf(st.m - mnew);
    float psum = 0.f;
#pragma unroll
    for (int i = 0; i < 16; ++i) { const float p = __expf(s[i] - mnew); s[i] = p; psum += p; }
    st.l = st.l * alpha + psum; st.m = mnew;
#pragma unroll
    for (int db = 0; db < 2; ++db)
#pragma unroll
        for (int i = 0; i < 16; ++i) st.O[db][i] *= alpha;
    bf16x8 Pf[2];
#pragma unroll
    for (int c = 0; c < 2; ++c) { u32x4 w; w.x = pk2(s[8 * c + 0], s[8 * c + 1]); w.y = pk2(s[8 * c + 2], s[8 * c + 3]); w.z = pk2(s[8 * c + 4], s[8 * c + 5]); w.w = pk2(s[8 * c + 6], s[8 * c + 7]); Pf[c] = __builtin_bit_cast(bf16x8, w); }
#pragma unroll
    for (int db = 0; db < 2; ++db)
#pragma unroll
        for (int c = 0; c < 2; ++c) st.O[db] = MFMA32(Vf[db][c], Pf[c], st.O[db]);
}

DI void phase_attn(const Params& P, int l, bool do_ctx) {
    const int tid = otid(), wid = tid >> 6, lane = tid & 63, hh = lane >> 5, ql = lane & 31;
    const bf16_t* Q = (const bf16_t*)(ows(P) + OFF_R + R_Q); const bf16_t* Kb = (const bf16_t*)(ows(P) + OFF_R + R_K);
    const bf16_t* VT = (const bf16_t*)(ows(P) + OFF_R + R_VT); const bf16_t* VTC = (const bf16_t*)(ows(P) + OFF_R + R_VTC);
    bf16_t* HB = (bf16_t*)(ows(P) + OFF_HB);
    const float* sink = oin(P, I_SINK) + l * 8;
    const int ntask = 8192 + (do_ctx ? 512 : 0);
    for (int t = obid() * 8 + wid; t < ntask; t += gridDim.x * 8) {
        const bool isc = t >= 8192;
        int b, kvh, hq, blk = 0, sub, qrow, qpos = 0;
        if (!isc) { sub = t & 3; hq = (t >> 2) & 3; kvh = (t >> 4) & 1; blk = (t >> 5) & 31; b = t >> 10; qpos = blk * 128 + sub * 32 + ql; qrow = b * 4096 + qpos; }
        else { const int t2 = t - 8192; sub = t2 & 7; hq = (t2 >> 3) & 3; kvh = (t2 >> 5) & 1; b = t2 >> 6; qrow = TL + b * 256 + sub * 32 + ql; }
        const int h = kvh * 4 + hq;
        bf16x8 Qf[4];
#pragma unroll
        for (int kk = 0; kk < 4; ++kk) Qf[kk] = *(const bf16x8*)(Q + (size_t)qrow * 512 + h * 64 + kk * 16 + hh * 8);
        AttnState st; st.m = sink[h]; st.l = hh == 0 ? 1.0f : 0.0f;
#pragma unroll
        for (int i = 0; i < 16; ++i) { st.O[0][i] = 0.f; st.O[1][i] = 0.f; }
        if (!isc) {
            const int qlo = blk * 128 + sub * 32;
            for (int kt = 0; kt < 12; ++kt) {
                const int klo = (blk - 1) * 128 + kt * 32;
                if (klo < 0 || klo >= SEQ) continue;
                if (klo + 31 < qlo - 128 || klo > qlo + 31 + 128) continue;
                const bf16_t* kp = Kb + (size_t)(b * 4096 + klo + ql) * 128 + kvh * 64 + hh * 8;
                const bf16_t* vp = VT + ((size_t)(b * 128 + kvh * 64 + ql)) * 4096 + klo + 4 * hh;
                attn_tile<true>(st, Qf, kp, vp, 4096, hh, qpos, klo);
            }
        }
        for (int kt = 0; kt < 8; ++kt) {
            const int klo = kt * 32;
            const bf16_t* kp = Kb + (size_t)(TL + b * 256 + klo + ql) * 128 + kvh * 64 + hh * 8;
            const bf16_t* vp = VTC + ((size_t)(b * 128 + kvh * 64 + ql)) * 256 + klo + 4 * hh;
            attn_tile<false>(st, Qf, kp, vp, 256, hh, 0, klo);
        }
        const float ltot = st.l + __shfl_xor(st.l, 32);
        const float inv = 1.0f / ltot;
        bf16_t* op = HB + (size_t)qrow * HBS + 1024 + h * 64 + 4 * hh;
#pragma unroll
        for (int db = 0; db < 2; ++db)
#pragma unroll
            for (int g4 = 0; g4 < 4; ++g4) { u32x2 w; w.x = pk2(st.O[db][4 * g4] * inv, st.O[db][4 * g4 + 1] * inv); w.y = pk2(st.O[db][4 * g4 + 2] * inv, st.O[db][4 * g4 + 3] * inv);
                *(u32x2*)(op + db * 32 + 8 * g4) = w; }
    }
}

DI void phase_sgu(const Params& P, int l, unsigned char* shm) {
    const int tid = otid(), wid = tid >> 6, lane = tid & 63, hh = lane >> 5, ql = lane & 31;
    bf16_t* vT = (bf16_t*)shm;
    const bf16_t* U = (const bf16_t*)(ows(P) + OFF_R + R_U); const bf16_t* Z = (const bf16_t*)(ows(P) + OFF_R + R_Z);
    bf16_t* HB = (bf16_t*)(ows(P) + OFF_HB);
    const float* lg = oin(P, I_SGULG) + l * 512; const float* lb = oin(P, I_SGULB) + l * 512;
    const float* sw = oin(P, I_SGUW) + (size_t)l * 4 * 128 * 128; const float* sb = oin(P, I_SGUB) + l * 4 * 128;
    float gg[8], bb[8];
#pragma unroll
    for (int j = 0; j < 8; ++j) { gg[j] = lg[j * 64 + lane]; bb[j] = lb[j * 64 + lane]; }
    for (int chunk = obid(); chunk < 272; chunk += gridDim.x) {
        const int r0 = chunk * 128;
        for (int tt = 0; tt < 16; ++tt) {
            const int tok = wid * 16 + tt; const bf16_t* zp = Z + (size_t)(r0 + tok) * 512;
            float z[8]; float sum = 0.f;
#pragma unroll
            for (int j = 0; j < 8; ++j) { z[j] = bf2f(zp[j * 64 + lane]); sum += z[j]; }
            const float mu = wave_sum(sum) * (1.0f / 512.0f);
            float sq = 0.f;
#pragma unroll
            for (int j = 0; j < 8; ++j) { z[j] -= mu; sq += z[j] * z[j]; }
            const float rstd = rsqrtf(wave_sum(sq) * (1.0f / 512.0f) + LN_EPS);
#pragma unroll
            for (int j = 0; j < 8; ++j) vT[(j * 64 + lane) * 136 + tok] = f2bf(z[j] * rstd * gg[j] + bb[j]);
        }
        __syncthreads();
        const int g = wid >> 1, cb = g * 128 + (wid & 1) * 64;
        for (int mb = 0; mb < 4; ++mb) {
            f32x16 acc[2];
#pragma unroll
            for (int i = 0; i < 16; ++i) { acc[0][i] = 0.f; acc[1][i] = 0.f; }
#pragma unroll
            for (int kc = 0; kc < 8; ++kc) {
                const float* wp = sw + ((size_t)(g * 128 + mb * 32 + ql)) * 128 + kc * 16 + hh * 8;
                const f32x4 w0 = *(const f32x4*)wp, w1 = *(const f32x4*)(wp + 4);
                u32x4 wa; wa.x = pk2(w0[0], w0[1]); wa.y = pk2(w0[2], w0[3]); wa.z = pk2(w1[0], w1[1]); wa.w = pk2(w1[2], w1[3]);
                const bf16x8 Af = __builtin_bit_cast(bf16x8, wa);
#pragma unroll
                for (int nb = 0; nb < 2; ++nb) { const bf16x8 Bf = *(const bf16x8*)(vT + (cb + nb * 32 + ql) * 136 + kc * 16 + hh * 8); acc[nb] = MFMA32(Af, Bf, acc[nb]); }
            }
#pragma unroll
            for (int nb = 0; nb < 2; ++nb)
#pragma unroll
                for (int i = 0; i < 16; ++i) { const int prow = mb * 32 + (i & 3) + 8 * (i >> 2) + 4 * hh; const int c = cb + nb * 32 + ql; const size_t row = (size_t)(r0 + prow);
                    const float val = (acc[nb][i] + sb[g * 128 + prow]) * bf2f(U[row * 512 + c]);
                    HB[row * HBS + 1536 + c] = f2bf(val); }
        }
        __syncthreads();
    }
}

__global__ void __launch_bounds__(512, 2) mega(Params P) {
    extern __shared__ __attribute__((aligned(16))) unsigned char shm[];
    LAS unsigned char* lds = (LAS unsigned char*)shm;
    cg::grid_group grid = cg::this_grid();

    phase_mods(P, shm);
    phase_tables(P, shm);
    phase_wconv(P, 0, shm);
    grid.sync();
    phase_norm(P, nullptr, nullptr, (const float*)(ows(P) + OFF_MODS), 0, nullptr);
    grid.sync();

    for (int st = 0; st < 2 * DEPTH; ++st) {
        const int l = st >> 1, f = st & 1;
        {
            unsigned char* ws = ows(P); bf16_t* W = (bf16_t*)(ws + OFF_W);
            SchedTile S; S.init(ws + OFF_HB, 256ull * HBS * 2, W + (f ? W_UP1 : W_UP0), 256ull * 1024 * 2, T / 256, NUP / 256);
            EpiUp E; E.act = (bf16_t*)(ws + OFF_R);
            gemm_phase<1024, HBS, 1024>(lds, S, E);
        }
        grid.sync();
        {
            unsigned char* ws = ows(P); bf16_t* W = (bf16_t*)(ws + OFF_W);
            SchedTile S; S.init(ws + OFF_R, 256ull * DFFP * 2, W + (f ? W_DN1 : W_DN0), 256ull * DFFP * 2, T / 256, 4);
            EpiRes E; E.X = (float*)(ws + OFF_X); E.gm = (const float*)(ws + OFF_MODS) + (size_t)l * 9 * 9216 + (f ? 8 : 2) * 1024; E.s = 0.5f;
            gemm_phase<DFFP, DFFP, DFFP>(lds, S, E);
        }
        grid.sync();
        if (f == 0) {
            phase_norm(P, oin(P, I_LNG) + (l * 3 + 0) * 1024, oin(P, I_LNB) + (l * 3 + 0) * 1024, (const float*)(ows(P) + OFF_MODS) + (size_t)l * 9 * 9216, 3, nullptr);
            grid.sync();
            {
                unsigned char* ws = ows(P); bf16_t* W = (bf16_t*)(ws + OFF_W); unsigned char* R = ws + OFF_R;
                SchedTile S; S.init(ws + OFF_HB, 256ull * HBS * 2, W + W_IN, 256ull * 1024 * 2, T / 256, 7);
                EpiIn E; E.Q = (bf16_t*)(R + R_Q); E.Kb = (bf16_t*)(R + R_K); E.VT = (bf16_t*)(R + R_VT); E.VTC = (bf16_t*)(R + R_VTC); E.U = (bf16_t*)(R + R_U); E.Z = (bf16_t*)(R + R_Z);
                E.ropec = (const float*)(ws + OFF_ROPE); E.ropes = E.ropec + 1024;
                gemm_phase<1024, HBS, 1024>(lds, S, E);
            }
            {
                unsigned char* ws = ows(P); bf16_t* W = (bf16_t*)(ws + OFF_W); unsigned char* R = ws + OFF_R;
                SchedTile S; S.init(W + W_F, 256ull * 1024 * 2, ws + OFF_HB, 256ull * HBS * 2, 4, T / 256);
                EpiFT E; E.FT = (bf16_t*)(R + R_FT); E.FTC = (bf16_t*)(R + R_FTC);
                gemm_phase<1024, 1024, HBS>(lds, S, E);
            }
            grid.sync();
            {
                unsigned char* ws = ows(P); unsigned char* R = ws + OFF_R;
                SchedTile S; S.init(ws + OFF_DFT, 256ull * 8192 * 2, R + R_FT, 256ull * 8192 * 2, 16, 16);
                EpiDft E; E.HB = (bf16_t*)(ws + OFF_HB); E.rowbase = 0; E.rpb = 4096;
                gemm_phase<8192, 8192, 8192>(lds, S, E);
            }
            if (l < DEPTH - 1) {
                unsigned char* ws = ows(P); unsigned char* R = ws + OFF_R;
                SchedTile S; S.init(ws + OFF_DFTC, 0, R + R_FTC, 256ull * 512 * 2, 1, 16);
                EpiDft E; E.HB = (bf16_t*)(ws + OFF_HB); E.rowbase = TL; E.rpb = 256;
                gemm_phase<512, 512, 512>(lds, S, E);
            }
            phase_attn(P, l, l < DEPTH - 1);
            phase_sgu(P, l, shm);
            grid.sync();
            {
                unsigned char* ws = ows(P); bf16_t* W = (bf16_t*)(ws + OFF_W); unsigned char* R = ws + OFF_R;
                SchedBr S; S.HBp = (const char*)(ws + OFF_HB); S.Wc = (const char*)(W + W_CAT); S.G = gridDim.x; S.c = obid();
                EpiBr E; E.merged = (bf16_t*)(R + R_MERGED); E.scr = R + R_SCR + (size_t)obid() * 131072;
                gemm_phase<512, HBS, 1536>(lds, S, E);
            }
            grid.sync();
            {
                unsigned char* ws = ows(P); bf16_t* W = (bf16_t*)(ws + OFF_W); unsigned char* R = ws + OFF_R;
                SchedTile S; S.init(R + R_MERGED, 256ull * 1024 * 2, W + W_OUT, 256ull * 1024 * 2, T / 256, 4);
                EpiRes E; E.X = (float*)(ws + OFF_X); E.gm = (const float*)(ws + OFF_MODS) + (size_t)l * 9 * 9216 + 5 * 1024; E.s = 1.0f;
                gemm_phase<1024, 1024, 1024>(lds, S, E);
            }
            grid.sync();
            phase_norm(P, oin(P, I_LNG) + (l * 3 + 1) * 1024, oin(P, I_LNB) + (l * 3 + 1) * 1024, (const float*)(ows(P) + OFF_MODS) + (size_t)l * 9 * 9216, 6, nullptr);
            grid.sync();
        } else {
            const bool lastl = (l == DEPTH - 1);
            phase_norm(P, oin(P, I_LNG) + (l * 3 + 2) * 1024, oin(P, I_LNB) + (l * 3 + 2) * 1024, lastl ? nullptr : (const float*)(ows(P) + OFF_MODS) + (size_t)(l + 1) * 9 * 9216, 0, lastl ? P.out : nullptr);
            if (!lastl) { phase_wconv(P, l + 1, shm); grid.sync(); }
        }
    }
}

extern "C" void kernel_launch(void* const* d_in, const int* in_sizes, int n_in, void* d_out, int out_size, void* d_ws, size_t ws_size, hipStream_t stream) {
    static int grid_blocks = 0;
    if (!grid_blocks) {
        int dev = 0, cus = 0, per_cu = 0;
        hipGetDevice(&dev);
        hipDeviceGetAttribute(&cus, hipDeviceAttributeMultiprocessorCount, dev);
        if (hipFuncSetAttribute((const void*)mega, hipFuncAttributeMaxDynamicSharedMemorySize, LDS_BYTES) != hipSuccess) fprintf(stderr, "hipFuncSetAttribute failed\n");
        hipOccupancyMaxActiveBlocksPerMultiprocessor(&per_cu, (const void*)mega, 512, LDS_BYTES);
        if (per_cu < 1) { fprintf(stderr, "occupancy query gave %d\n", per_cu); per_cu = 1; }
        (void)hipGetLastError();
        grid_blocks = cus * per_cu;
        if (grid_blocks > 256) grid_blocks = 256;
        if (ws_size < WS_END) fprintf(stderr, "workspace too small: %zu < %zu\n", ws_size, (size_t)WS_END);
    }
    Params p{};
    for (int i = 0; i < 19; ++i) p.in[i] = (const float*)d_in[i];
    p.out = (float*)d_out; p.ws = (unsigned char*)d_ws;
    void* args[] = {&p};
    hipError_t e = hipLaunchCooperativeKernel((const void*)mega, dim3(grid_blocks), dim3(512), args, LDS_BYTES, stream);
    if (e != hipSuccess) fprintf(stderr, "cooperative launch failed: %s (grid %d)\n", hipGetErrorString(e), grid_blocks);
}
```

```cpp
#include <hip/hip_runtime.h>
#include <hip/hip_cooperative_groups.h>
#include <cstdio>
namespace cg = cooperative_groups;
#define REP_UP 1
#define REP_IN 1
#define REP_DFT 1
#define REP_ATT 1
#define REP_SGU 1
#define REP_BR 1
#define REP_WCONV 1
#define EXTRA_SYNCS 0

#define LAS __attribute__((address_space(3)))
#define DI __device__ __forceinline__
typedef unsigned short bf16_t;
typedef short bf16x8 __attribute__((ext_vector_type(8)));
typedef float f32x2 __attribute__((ext_vector_type(2)));
typedef float f32x4 __attribute__((ext_vector_type(4)));
typedef float f32x16 __attribute__((ext_vector_type(16)));
typedef unsigned u32x2 __attribute__((ext_vector_type(2)));
typedef unsigned u32x4 __attribute__((ext_vector_type(4)));
typedef __bf16 bfv2 __attribute__((ext_vector_type(2)));

constexpr int D = 1024, NB = 8, SEQ = 4096, DEPTH = 4, CTXL = 256;
constexpr int TL = NB * SEQ, TC = NB * CTXL, T = TL + TC;
constexpr int DFF = 2752, DFFP = 2816, NUP = 5632;
constexpr int HBS = 2560;
constexpr float ALPHA = 1.681792830507429f;
constexpr float LN_EPS = 1e-5f;
constexpr int LDS_BYTES = 144 * 1024;

constexpr size_t OFF_MODS = 0;
constexpr size_t SZ_MODS = 4ull * 9 * 9216 * 4;
constexpr size_t OFF_ROPE = OFF_MODS + SZ_MODS;
constexpr size_t SZ_ROPE = 2ull * 64 * 16 * 4;
constexpr size_t OFF_DFT = OFF_ROPE + SZ_ROPE;
constexpr size_t SZ_DFT = 4096ull * 8192 * 2;
constexpr size_t OFF_DFTC = OFF_DFT + SZ_DFT;
constexpr size_t SZ_DFTC = 256ull * 512 * 2;
constexpr size_t OFF_W = OFF_DFTC + SZ_DFTC;
constexpr size_t W_UP0 = 0, W_DN0 = W_UP0 + 5632ull * 1024, W_UP1 = W_DN0 + 1024ull * 2816, W_DN1 = W_UP1 + 5632ull * 1024,
                 W_IN = W_DN1 + 1024ull * 2816, W_F = W_IN + 1792ull * 1024, W_CAT = W_F + 1024ull * 1024,
                 W_OUT = W_CAT + 3ull * 1024 * 1536, W_END = W_OUT + 1024ull * 1024;
constexpr size_t SZ_W = W_END * 2;
constexpr size_t OFF_X = OFF_W + SZ_W;
constexpr size_t SZ_X = (size_t)T * 1024 * 4;
constexpr size_t OFF_HB = OFF_X + SZ_X;
constexpr size_t SZ_HB = (size_t)T * HBS * 2;
constexpr size_t OFF_R = OFF_HB + SZ_HB;
constexpr size_t R_Q = 0;
constexpr size_t R_U = R_Q + (size_t)T * 512 * 2;
constexpr size_t R_Z = R_U + (size_t)T * 512 * 2;
constexpr size_t R_K = R_Z + (size_t)T * 512 * 2;
constexpr size_t R_VT = R_K + (size_t)T * 128 * 2;
constexpr size_t R_VTC = R_VT + 8ull * 128 * 4096 * 2;
constexpr size_t R_FT = R_VTC + 8ull * 128 * 256 * 2;
constexpr size_t R_FTC = R_FT + 8ull * 512 * 8192 * 2;
constexpr size_t R_END = R_FTC + 8ull * 512 * 512 * 2;
constexpr size_t SZ_R = (size_t)T * DFFP * 2;
static_assert(R_END == SZ_R, "region R");
constexpr size_t R_MERGED = R_Q;
constexpr size_t R_SCR = R_Z;
constexpr size_t OFF_BAR = OFF_R + SZ_R;
constexpr size_t SZ_BAR = 16384;
constexpr size_t WS_END = OFF_BAR + SZ_BAR;
static_assert(WS_END <= 721420288ull, "workspace");
static_assert(256ull * 131072 <= (size_t)T * 512 * 2, "scr");

struct Params { const float* in[19]; float* out; unsigned char* ws; };
enum { I_X = 0, I_C, I_CTX, I_CCTX, I_WMOD, I_BMOD, I_WUP, I_WDN, I_LNG, I_LNB, I_WIN, I_SINK, I_SGUW, I_SGUB, I_SGULG, I_SGULB, I_WGATE, I_WBR, I_WOUT };

DI unsigned pk2(float a, float b) { f32x2 v = {a, b}; bfv2 r = __builtin_convertvector(v, bfv2); return __builtin_bit_cast(unsigned, r); }
DI bf16_t f2bf(float a) { return (bf16_t)(pk2(a, 0.f) & 0xffffu); }
DI float bf2f(unsigned b) { return __uint_as_float(b << 16); }
DI float bflo(unsigned w) { return __uint_as_float(w << 16); }
DI float bfhi(unsigned w) { return __uint_as_float(w & 0xffff0000u); }
DI float sigmoidf_(float x) { return 1.0f / (1.0f + __expf(-x)); }
DI float siluf_(float x) { return x / (1.0f + __expf(-x)); }
DI float geluf_(float x) { const float y = 1.5957691216057308f * (x + 0.044715f * x * x * x); return x / (1.0f + __expf(-y)); }
DI int otid() { int t = threadIdx.x; asm volatile("" : "+v"(t)); return t; }
DI int obid() { int b = blockIdx.x; asm volatile("" : "+s"(b)); return b; }
DI unsigned char* ows(const Params& P) { unsigned char* w = P.ws; asm volatile("" : "+s"(w)); return w; }
DI const float* oin(const Params& P, int i) { const float* p = P.in[i]; asm volatile("" : "+s"(p)); return p; }
DI float wave_sum(float v) {
#pragma unroll
    for (int o = 32; o >= 1; o >>= 1) v += __shfl_xor(v, o);
    return v;
}

constexpr int BM = 256, BK = 64, HALF = 128, HTB = HALF * BK * 2, NXCD = 8, WGM = 8;
DI int lds_byte(int r, int c) { const int st = (r >> 4) * 2 + (c >> 5), rr = r & 15, cc = c & 31, ob = rr * 64 + cc * 2; return st * 1024 + (ob ^ (((ob >> 9) & 1) << 5)); }
DI void stage_rc(int b, int& R, int& C) { const int st = b / 1024, sb = b % 1024, swz = sb ^ (((sb >> 9) & 1) << 5); R = (st >> 1) * 16 + swz / 64; C = (st & 1) * 32 + (swz % 64) / 2; }

struct Unit { int pm, pn, aux; };

struct SchedTile {
    const char* Ab; const char* Bb; size_t tA, tB; int nM, nN, nwg, G, c;
    DI void init(const void* A, size_t tA_, const void* B, size_t tB_, int nM_, int nN_) { Ab = (const char*)A; Bb = (const char*)B; tA = tA_; tB = tB_; nM = nM_; nN = nN_; nwg = nM * nN; G = gridDim.x; c = obid(); }
    DI bool next(int i, Unit& u) const {
        const long L = (long)i * G + c; if (L >= nwg) return false;
        int wgid = (int)L; { const int q = nwg / NXCD, r = nwg % NXCD, xcd = wgid % NXCD, off = wgid / NXCD; wgid = (xcd < r ? xcd * (q + 1) : r * (q + 1) + (xcd - r) * q) + off; }
        const int nig = WGM * nN, gid = wgid / nig, fm = gid * WGM, gsz = (nM - fm) < WGM ? (nM - fm) : WGM;
        u.pm = fm + ((wgid % nig) % gsz); u.pn = (wgid % nig) / gsz; u.aux = 0; return true;
    }
    DI const char* A(const Unit& u) const { return Ab + (size_t)u.pm * tA; }
    DI const char* B(const Unit& u) const { return Bb + (size_t)u.pn * tB; }
};

struct SchedBr {
    const char* HBp; const char* Wc; int G, c;
    DI bool next(int i, Unit& u) const { const int ti = (i / 9) * G + c; if (ti >= 544) return false; u.pm = ti >> 2; u.pn = ti & 3; u.aux = i % 9; return true; }
    DI const char* A(const Unit& u) const { const int pass = u.aux % 3, r = u.aux / 3; const int off = pass == 0 ? 0 : (pass == 1 ? 512 : 1024 + r * 512); return HBp + ((size_t)u.pm * 256 * HBS + off) * 2; }
    DI const char* B(const Unit& u) const { const int pass = u.aux % 3, r = u.aux / 3; const int off = pass == 0 ? 512 : (pass == 1 ? 1024 : 0); return Wc + ((size_t)(r * 1024 + u.pn * 256) * 1536 + off) * 2; }
};

template <int K, int lda, int ldb, class Epi, class Sched>
DI void gemm_phase(LAS unsigned char* lds, const Sched& S, const Epi& E) {
    const int tid = otid(), wid = __builtin_amdgcn_readfirstlane(tid >> 6), lane = tid & 63, wr = wid >> 2, wc = wid & 3, fr = lane & 15, fq = lane >> 4;
    constexpr int nt = K / BK;
    unsigned voffA[2], voffB[2];
#pragma unroll
    for (int i = 0; i < 2; ++i) { int R, C; stage_rc(tid * 16 + i * 8192, R, C); voffA[i] = (unsigned)(R * lda + C) * 2u; voffB[i] = (unsigned)(R * ldb + C) * 2u; }
    constexpr size_t kstep = (size_t)(BK * 2);
    constexpr size_t hstepA = (size_t)HALF * lda * 2, hstepB = (size_t)HALF * ldb * 2;
    const unsigned ldsw = (unsigned)wid * 1024u;
    const int aoff = lds_byte(wr * 64 + fr, fq * 8), boff = lds_byte(wc * 32 + fr, fq * 8);
#define PG8_SA(b, h) (((b) * 2 + (h)) * HTB)
#define PG8_SB(b, h) ((4 + (b) * 2 + (h)) * HTB)
#define PG8_STAGE(bufoff, gbase, voff) do { _Pragma("unroll") for (int _i = 0; _i < 2; ++_i) \
        __builtin_amdgcn_global_load_lds((const unsigned*)((const char*)(gbase) + (voff)[_i]), (LAS unsigned*)(lds + (bufoff) + ldsw + _i * 8192), 16, 0, 0); } while (0)
#define PG8_LDA(dst, b, h) do { _Pragma("unroll") for (int m = 0; m < 4; ++m) _Pragma("unroll") for (int k = 0; k < 2; ++k) dst[m][k] = *(const LAS bf16x8*)(lds + PG8_SA(b, h) + aoff + m * 2048 + k * 1024); } while (0)
#define PG8_LDB(dst, b, h) do { _Pragma("unroll") for (int n = 0; n < 2; ++n) _Pragma("unroll") for (int k = 0; k < 2; ++k) dst[n][k] = *(const LAS bf16x8*)(lds + PG8_SB(b, h) + boff + n * 2048 + k * 1024); } while (0)
#define PG8_MMA(ai, bj, At, Bt) do { __builtin_amdgcn_s_setprio(1); _Pragma("unroll") for (int m = 0; m < 4; ++m) _Pragma("unroll") for (int n = 0; n < 2; ++n) _Pragma("unroll") for (int k = 0; k < 2; ++k) \
        acc[ai][bj][m][n] = __builtin_amdgcn_mfma_f32_16x16x32_bf16(Bt[n][k], At[m][k], acc[ai][bj][m][n], 0, 0, 0); __builtin_amdgcn_s_setprio(0); } while (0)
#define PG8_WAIT_V(n) asm volatile("s_waitcnt vmcnt(" #n ")" ::: "memory")
#define PG8_WAIT_L(n) asm volatile("s_waitcnt lgkmcnt(" #n ")" ::: "memory")
#define PG8_BAR __builtin_amdgcn_s_barrier()
#define PG8_SCHED __builtin_amdgcn_sched_barrier(0)
    Unit cur, nxt; int ui = 0;
    if (!S.next(0, cur)) return;
    f32x4 acc[2][2][4][2];
#pragma unroll
    for (int a = 0; a < 2; ++a)
#pragma unroll
        for (int b = 0; b < 2; ++b)
#pragma unroll
            for (int m = 0; m < 4; ++m)
#pragma unroll
                for (int n = 0; n < 2; ++n) acc[a][b][m][n] = (f32x4){0.f, 0.f, 0.f, 0.f};
    bf16x8 At[4][2], B0[2][2], B1[2][2];
    const char* cA = S.A(cur); const char* cB = S.B(cur);
    PG8_STAGE(PG8_SB(0, 0), cB, voffB); PG8_STAGE(PG8_SA(0, 0), cA, voffA); PG8_STAGE(PG8_SB(0, 1), cB + hstepB, voffB); PG8_STAGE(PG8_SA(0, 1), cA + hstepA, voffA);
    if (wr == 1) PG8_BAR;
    PG8_WAIT_V(4); PG8_BAR;
    PG8_STAGE(PG8_SB(1, 0), cB + kstep, voffB); PG8_STAGE(PG8_SA(1, 0), cA + kstep, voffA); PG8_STAGE(PG8_SB(1, 1), cB + hstepB + kstep, voffB);
    PG8_WAIT_V(6); PG8_BAR;
    for (;;) {
        const bool has_next = S.next(ui + 1, nxt);
        const char* nA = has_next ? S.A(nxt) : cA; const char* nB = has_next ? S.B(nxt) : cB;
        for (int t = 0; t < nt; t += 2) {
            const bool last = (t == nt - 2);
            const char* a1 = cA + (size_t)(t + 1) * kstep;
            const char* a2 = last ? nA : cA + (size_t)(t + 2) * kstep; const char* b2 = last ? nB : cB + (size_t)(t + 2) * kstep;
            const char* a3 = a2 + kstep; const char* b3 = b2 + kstep;
            PG8_LDB(B0, 0, 0); PG8_SCHED; PG8_LDA(At, 0, 0); PG8_STAGE(PG8_SA(1, 1), a1 + hstepA, voffA);
            PG8_WAIT_L(8); PG8_BAR; PG8_WAIT_L(0); PG8_MMA(0, 0, At, B0); PG8_BAR; PG8_SCHED;
            PG8_LDB(B1, 0, 1); PG8_STAGE(PG8_SB(0, 0), b2, voffB);
            PG8_BAR; PG8_WAIT_L(0); PG8_MMA(0, 1, At, B1); PG8_BAR;
            PG8_LDA(At, 0, 1); PG8_STAGE(PG8_SA(0, 0), a2, voffA);
            PG8_BAR; PG8_WAIT_L(0); PG8_MMA(1, 0, At, B0); PG8_BAR; PG8_SCHED;
            PG8_STAGE(PG8_SB(0, 1), b2 + hstepB, voffB);
            PG8_WAIT_V(6); PG8_BAR; PG8_MMA(1, 1, At, B1); PG8_BAR;
            PG8_LDB(B0, 1, 0); PG8_SCHED; PG8_LDA(At, 1, 0); PG8_STAGE(PG8_SA(0, 1), a2 + hstepA, voffA);
            PG8_WAIT_L(8); PG8_BAR; PG8_WAIT_L(0); PG8_MMA(0, 0, At, B0); PG8_BAR; PG8_SCHED;
            PG8_LDB(B1, 1, 1); PG8_STAGE(PG8_SB(1, 0), b3, voffB);
            PG8_BAR; PG8_WAIT_L(0); PG8_MMA(0, 1, At, B1); PG8_BAR;
            PG8_LDA(At, 1, 1); PG8_STAGE(PG8_SA(1, 0), a3, voffA);
            PG8_BAR; PG8_WAIT_L(0); PG8_MMA(1, 0, At, B0); PG8_BAR; PG8_SCHED;
            PG8_STAGE(PG8_SB(1, 1), b3 + hstepB, voffB);
            PG8_WAIT_V(6); PG8_BAR; PG8_MMA(1, 1, At, B1); PG8_BAR;
        }
        const bool zero = E(acc, cur, wr, wc, fr, fq);
        if (!has_next) break;
        if (zero) {
#pragma unroll
            for (int a = 0; a < 2; ++a)
#pragma unroll
                for (int b = 0; b < 2; ++b)
#pragma unroll
                    for (int m = 0; m < 4; ++m)
#pragma unroll
                        for (int n = 0; n < 2; ++n) acc[a][b][m][n] = (f32x4){0.f, 0.f, 0.f, 0.f};
        }
        cur = nxt; cA = nA; cB = nB; ++ui;
    }
    PG8_WAIT_V(0);
    if (wr == 0) PG8_BAR;
    PG8_BAR;
#undef PG8_SA
#undef PG8_SB
#undef PG8_STAGE
#undef PG8_LDA
#undef PG8_LDB
#undef PG8_MMA
#undef PG8_WAIT_V
#undef PG8_WAIT_L
#undef PG8_BAR
#undef PG8_SCHED
}

typedef f32x4 AccT[2][2][4][2];

struct EpiUp {
    bf16_t* act;
    DI bool operator()(const AccT& acc, const Unit& u, int wr, int wc, int fr, int fq) const {
        asm volatile("" : "+v"(fr), "+v"(fq));
        const int row0 = u.pm * BM + wr * 64 + fr, c0 = u.pn * 128 + wc * 16 + 4 * fq;
#pragma unroll
        for (int ai = 0; ai < 2; ++ai)
#pragma unroll
            for (int m = 0; m < 4; ++m) { bf16_t* rowp = act + (size_t)(row0 + ai * HALF + m * 16) * DFFP + c0;
#pragma unroll
                for (int bj = 0; bj < 2; ++bj) { const f32x4 g = acc[ai][bj][m][0], up = acc[ai][bj][m][1];
                    u32x2 w; w.x = pk2(siluf_(g[0]) * up[0], siluf_(g[1]) * up[1]); w.y = pk2(siluf_(g[2]) * up[2], siluf_(g[3]) * up[3]);
                    *(u32x2*)(rowp + bj * 64) = w; } }
        return true;
    }
};

struct EpiRes {
    float* X; const float* gm; float s;
    DI bool operator()(const AccT& acc, const Unit& u, int wr, int wc, int fr, int fq) const {
        asm volatile("" : "+v"(fr), "+v"(fq));
        const int row0 = u.pm * BM + wr * 64 + fr, col0 = u.pn * BM + wc * 32 + 4 * fq;
        const int rb = (u.pm * BM < TL) ? ((u.pm * BM) >> 12) : 8;
        const float* gp = gm + (size_t)rb * 9216 + col0;
        f32x4 gv[2][2];
#pragma unroll
        for (int bj = 0; bj < 2; ++bj)
#pragma unroll
            for (int n = 0; n < 2; ++n) gv[bj][n] = *(const f32x4*)(gp + bj * HALF + n * 16) * s;
#pragma unroll
        for (int ai = 0; ai < 2; ++ai)
#pragma unroll
            for (int m = 0; m < 4; ++m) { float* rowp = X + (size_t)(row0 + ai * HALF + m * 16) * D + col0;
#pragma unroll
                for (int bj = 0; bj < 2; ++bj)
#pragma unroll
                    for (int n = 0; n < 2; ++n) { f32x4* px = (f32x4*)(rowp + bj * HALF + n * 16); const f32x4 x = *px; *px = x * ALPHA + gv[bj][n] * acc[ai][bj][m][n]; } }
        return true;
    }
};

struct EpiIn {
    bf16_t* Q; bf16_t* Kb; bf16_t* VT; bf16_t* VTC; bf16_t* U; bf16_t* Z; const float* ropec; const float* ropes;
    DI bool operator()(const AccT& acc, const Unit& u, int wr, int wc, int fr, int fq) const {
        asm volatile("" : "+v"(fr), "+v"(fq));
        const int row0 = u.pm * BM + wr * 64 + fr;
        const bool lat = (u.pm * BM) < TL;
        const int pn = u.pn;
#pragma unroll
        for (int ai = 0; ai < 2; ++ai)
#pragma unroll
            for (int m = 0; m < 4; ++m) {
                const int row = row0 + ai * HALF + m * 16;
                if (pn <= 2) {
                    const int s = row & 4095;
                    const int p = (wc & 1) ? (s & 63) : (s >> 6);
                    f32x4 cs = (f32x4){1.f, 1.f, 1.f, 1.f}, sn = (f32x4){0.f, 0.f, 0.f, 0.f};
                    if (lat) { cs = *(const f32x4*)(ropec + p * 16 + 4 * fq); sn = *(const f32x4*)(ropes + p * 16 + 4 * fq); }
#pragma unroll
                    for (int bj = 0; bj < 2; ++bj) {
                        const f32x4 x1 = acc[ai][bj][m][0], x2 = acc[ai][bj][m][1];
                        if (pn < 2 || bj == 0) {
                            const f32x4 o1 = x1 * cs - x2 * sn, o2 = x1 * sn + x2 * cs;
                            u32x2 w1, w2; w1.x = pk2(o1[0], o1[1]); w1.y = pk2(o1[2], o1[3]); w2.x = pk2(o2[0], o2[1]); w2.y = pk2(o2[2], o2[3]);
                            bf16_t* dst = (pn < 2) ? (Q + (size_t)row * 512 + pn * 256 + bj * HALF + wc * 32 + 4 * fq) : (Kb + (size_t)row * 128 + wc * 32 + 4 * fq);
                            *(u32x2*)dst = w1; *(u32x2*)(dst + 16) = w2;
                        } else {
                            const int cv = wc * 32 + 4 * fq;
                            bf16_t* dst; size_t cst;
                            if (lat) { const int b = row >> 12; dst = VT + ((size_t)(b * 128 + cv)) * 4096 + s; cst = 4096; }
                            else { const int rc = row - TL; const int b = rc >> 8; dst = VTC + ((size_t)(b * 128 + cv)) * 256 + (rc & 255); cst = 256; }
#pragma unroll
                            for (int j = 0; j < 4; ++j) { dst[(size_t)j * cst] = f2bf(x1[j]); dst[(size_t)(16 + j) * cst] = f2bf(x2[j]); }
                        }
                    }
                } else {
                    bf16_t* base = (pn <= 4) ? (U + (size_t)row * 512 + (pn - 3) * 256) : (Z + (size_t)row * 512 + (pn - 5) * 256);
                    base += wc * 32 + 4 * fq;
#pragma unroll
                    for (int bj = 0; bj < 2; ++bj)
#pragma unroll
                        for (int n = 0; n < 2; ++n) { const f32x4 v = acc[ai][bj][m][n];
                            u32x2 w; w.x = pk2(geluf_(v[0]), geluf_(v[1])); w.y = pk2(geluf_(v[2]), geluf_(v[3]));
                            *(u32x2*)(base + bj * HALF + n * 16) = w; }
                }
            }
        return true;
    }
};

struct EpiFT {
    bf16_t* FT; bf16_t* FTC;
    DI bool operator()(const AccT& acc, const Unit& u, int wr, int wc, int fr, int fq) const {
        asm volatile("" : "+v"(fr), "+v"(fq));
        const int isS = u.pm >> 1;
        const int ch0 = (u.pm & 1) * 256 + wr * 64 + fr;
        bf16_t* base; size_t rst;
        if (u.pn < 128) { const int b = u.pn >> 4; base = FT + (size_t)b * 512 * 8192 + isS * 4096 + ((u.pn & 15) * 256) + wc * 32 + 4 * fq; rst = 8192; }
        else { const int b = u.pn - 128; base = FTC + (size_t)b * 512 * 512 + isS * 256 + wc * 32 + 4 * fq; rst = 512; }
#pragma unroll
        for (int ai = 0; ai < 2; ++ai)
#pragma unroll
            for (int m = 0; m < 4; ++m) { bf16_t* rowp = base + (size_t)(ch0 + ai * HALF + m * 16) * rst;
#pragma unroll
                for (int bj = 0; bj < 2; ++bj)
#pragma unroll
                    for (int n = 0; n < 2; ++n) { const f32x4 v = acc[ai][bj][m][n]; u32x2 w; w.x = pk2(v[0], v[1]); w.y = pk2(v[2], v[3]); *(u32x2*)(rowp + bj * HALF + n * 16) = w; } }
        return true;
    }
};

struct EpiDft {
    bf16_t* HB; int rowbase, rpb;
    DI bool operator()(const AccT& acc, const Unit& u, int wr, int wc, int fr, int fq) const {
        asm volatile("" : "+v"(fr), "+v"(fq));
        const int b = u.pn >> 1;
        const int k0 = u.pm * BM + wr * 64 + fr;
        bf16_t* base = HB + (size_t)(rowbase + b * rpb) * HBS + 2048 + (u.pn & 1) * 256 + wc * 32 + 4 * fq;
#pragma unroll
        for (int ai = 0; ai < 2; ++ai)
#pragma unroll
            for (int m = 0; m < 4; ++m) { bf16_t* rowp = base + (size_t)(k0 + ai * HALF + m * 16) * HBS;
#pragma unroll
                for (int bj = 0; bj < 2; ++bj)
#pragma unroll
                    for (int n = 0; n < 2; ++n) { const f32x4 v = acc[ai][bj][m][n]; u32x2 w; w.x = pk2(v[0], v[1]); w.y = pk2(v[2], v[3]); *(u32x2*)(rowp + bj * HALF + n * 16) = w; } }
        return true;
    }
};

struct EpiBr {
    bf16_t* merged; unsigned char* scr;
    DI bool operator()(const AccT& acc, const Unit& u, int wr, int wc, int fr, int fq) const {
        asm volatile("" : "+v"(fr), "+v"(fq));
        const int pass = u.aux % 3, r = u.aux / 3;
        if (pass == 0) return false;
        const int tid = (wr * 4 + wc) * 64 + fq * 16 + fr;
        if (pass == 1) {
#pragma unroll
            for (int ai = 0; ai < 2; ++ai)
#pragma unroll
                for (int bj = 0; bj < 2; ++bj)
#pragma unroll
                    for (int m = 0; m < 4; ++m) { const f32x4 a = acc[ai][bj][m][0], b = acc[ai][bj][m][1];
                        u32x4 w; w.x = pk2(sigmoidf_(a[0]), sigmoidf_(a[1])); w.y = pk2(sigmoidf_(a[2]), sigmoidf_(a[3])); w.z = pk2(sigmoidf_(b[0]), sigmoidf_(b[1])); w.w = pk2(sigmoidf_(b[2]), sigmoidf_(b[3]));
                        *(u32x4*)(scr + ((size_t)(((ai * 2 + bj) * 4 + m) * 512 + tid)) * 16) = w; }
            return true;
        }
        const int row0 = u.pm * BM + wr * 64 + fr, col0 = u.pn * BM + wc * 32 + 4 * fq;
#pragma unroll
        for (int ai = 0; ai < 2; ++ai)
#pragma unroll
            for (int bj = 0; bj < 2; ++bj)
#pragma unroll
                for (int m = 0; m < 4; ++m) {
                    const u32x4 g = *(const u32x4*)(scr + ((size_t)(((ai * 2 + bj) * 4 + m) * 512 + tid)) * 16);
                    const f32x4 a = acc[ai][bj][m][0], b = acc[ai][bj][m][1];
                    f32x4 va = (f32x4){bflo(g.x) * a[0], bfhi(g.x) * a[1], bflo(g.y) * a[2], bfhi(g.y) * a[3]};
                    f32x4 vb = (f32x4){bflo(g.z) * b[0], bfhi(g.z) * b[1], bflo(g.w) * b[2], bfhi(g.w) * b[3]};
                    bf16_t* dst = merged + (size_t)(row0 + ai * HALF + m * 16) * D + col0 + bj * HALF;
                    if (r != 0) { const u32x2 o0 = *(const u32x2*)dst, o1 = *(const u32x2*)(dst + 16);
                        va += (f32x4){bflo(o0.x), bfhi(o0.x), bflo(o0.y), bfhi(o0.y)}; vb += (f32x4){bflo(o1.x), bfhi(o1.x), bflo(o1.y), bfhi(o1.y)}; }
                    u32x2 w0, w1; w0.x = pk2(va[0], va[1]); w0.y = pk2(va[2], va[3]); w1.x = pk2(vb[0], vb[1]); w1.y = pk2(vb[2], vb[3]);
                    *(u32x2*)dst = w0; *(u32x2*)(dst + 16) = w1;
                }
        return true;
    }
};


#define XB_TMO      128
#define XB_XCNT(j)  (256  + 64 * (j))
#define XB_XSUB(j)  (1280 + 64 * (j))
#define XB_XGEN(j)  (2304 + 64 * (j))
#define XB_TOP      3328
#define XB_TOPGEN   3392
#define XCD_BAR_WORDS 3456
#define XB_SPIN_CAP (1u << 18)
DI unsigned xb_ld(unsigned* p)              { return __hip_atomic_load(p, __ATOMIC_RELAXED, __HIP_MEMORY_SCOPE_AGENT); }
DI unsigned xb_add(unsigned* p, unsigned v) { return __hip_atomic_fetch_add(p, v, __ATOMIC_RELAXED, __HIP_MEMORY_SCOPE_AGENT); }
DI unsigned xb_xcc_id() { return (unsigned)__builtin_amdgcn_s_getreg((3 << 11) | 20) & 0xFu; }
#define XB_SPIN(cond, bar) do { unsigned _sp = 0; while (cond) { __builtin_amdgcn_s_sleep(1); \
    if ((++_sp & 255u) == 0u) { if (xb_ld(&(bar)[XB_TMO])) break; if (_sp > XB_SPIN_CAP) { atomicAdd(&(bar)[XB_TMO], 1u); break; } } } } while (0)
struct XcdBarrier { unsigned* bar; unsigned x; volatile LAS unsigned* st; };
DI XcdBarrier xcd_barrier_post(unsigned* bar, volatile LAS unsigned* st) {
    XcdBarrier b; b.bar = bar; b.x = xb_xcc_id(); b.st = st;
    if (threadIdx.x == 0) (void)xb_add(&bar[XB_XCNT(b.x)], 1u);
    return b;
}
DI void xcd_barrier_complete(unsigned* bar, unsigned x, unsigned& nloc, unsigned& nx) {
    const unsigned G = gridDim.x * gridDim.y * gridDim.z;
    unsigned sum, cnt, mine, sp = 0u;
    for (;;) {
        sum = 0u; cnt = 0u; mine = 0u;
#pragma unroll
        for (unsigned j = 0; j < 16; ++j) { const unsigned c = xb_ld(&bar[XB_XCNT(j)]); sum += c; cnt += (c > 0u) ? 1u : 0u; mine = (j == x) ? c : mine; }
        if (sum == G) break;
        __builtin_amdgcn_s_sleep(1);
        if ((++sp & 255u) == 0u) { if (xb_ld(&bar[XB_TMO])) break; if (sp > XB_SPIN_CAP) { atomicAdd(&bar[XB_TMO], 1u); break; } }
    }
    nloc = mine > 0u ? mine : 1u; nx = cnt > 0u ? cnt : 1u;
}
DI void xcd_barrier(const XcdBarrier& b) {
    asm volatile("s_waitcnt vmcnt(0)" ::: "memory");
    __syncthreads();
    if (threadIdx.x == 0) {
        unsigned* bar = b.bar;
        __builtin_amdgcn_s_waitcnt(0);
        unsigned nloc = b.st[0], nx = b.st[1];
        if (nloc == 0u) { xcd_barrier_complete(bar, b.x, nloc, nx); b.st[0] = nloc; b.st[1] = nx; }
        const unsigned old = xb_add(&bar[XB_XSUB(b.x)], 1u);
        const unsigned gen = old / nloc;
        if (old + 1u == (gen + 1u) * nloc) {
            __builtin_amdgcn_fence(__ATOMIC_RELEASE, "agent");
            asm volatile("s_waitcnt vmcnt(0)" ::: "memory");
            const unsigned og = xb_add(&bar[XB_TOP], 1u);
            const unsigned tg = og / nx;
            if (og + 1u == (tg + 1u) * nx) xb_add(&bar[XB_TOPGEN], 1u);
            else XB_SPIN(xb_ld(&bar[XB_TOPGEN]) == tg, bar);
            __builtin_amdgcn_fence(__ATOMIC_ACQUIRE, "agent");
            xb_add(&bar[XB_XGEN(b.x)], 1u);
            asm volatile("s_waitcnt vmcnt(0)" ::: "memory");
        } else {
            XB_SPIN(xb_ld(&bar[XB_XGEN(b.x)]) == gen, bar);
            __builtin_amdgcn_fence(__ATOMIC_ACQUIRE, "agent");
            asm volatile("s_waitcnt vmcnt(0)" ::: "memory");
        }
    }
    __syncthreads();
}

DI void phase_mods(const Params& P, unsigned char* shm) {
    float* s = (float*)shm;
    float* red = s + 9 * 1024;
    const int tid = otid();
    const float* c = oin(P, I_C); const float* cc = oin(P, I_CCTX);
    for (int idx = tid; idx < 9 * 1024; idx += 512) { const int rb = idx >> 10, k = idx & 1023; const float v = rb < 8 ? c[rb * 1024 + k] : cc[k]; s[idx] = siluf_(v); }
    __syncthreads();
    float* mods = (float*)(ows(P) + OFF_MODS);
    const float* wmod = oin(P, I_WMOD); const float* bmod = oin(P, I_BMOD);
    for (int u = obid(); u < 288; u += gridDim.x) {
        const int l = u / 72, n0 = (u % 72) * 128, cgp = tid & 31, ks = tid >> 5;
        f32x4 acc[9];
#pragma unroll
        for (int rb = 0; rb < 9; ++rb) acc[rb] = (f32x4){0.f, 0.f, 0.f, 0.f};
        const float* wp = wmod + ((size_t)l * 1024 + ks * 64) * 9216 + n0 + cgp * 4;
        for (int kk = 0; kk < 64; ++kk) { const f32x4 w = *(const f32x4*)(wp + (size_t)kk * 9216);
#pragma unroll
            for (int rb = 0; rb < 9; ++rb) acc[rb] += w * s[rb * 1024 + ks * 64 + kk]; }
#pragma unroll
        for (int rb = 0; rb < 9; ++rb) *(f32x4*)(red + ((ks * 9 + rb) * 128 + cgp * 4)) = acc[rb];
        __syncthreads();
        for (int idx = tid; idx < 1152; idx += 512) { const int rb = idx >> 7, c2 = idx & 127; float sum = bmod[l * 9216 + n0 + c2];
            for (int k2 = 0; k2 < 16; ++k2) sum += red[(k2 * 9 + rb) * 128 + c2];
            mods[((size_t)l * 9 + rb) * 9216 + n0 + c2] = sum; }
        __syncthreads();
    }
}

DI void phase_tables(const Params& P, unsigned char* shm) {
    const int tid = otid();
    float* tab = (float*)shm;
    for (int j = tid; j < 4096; j += 512) tab[j] = cospif((float)j * (1.0f / 2048.0f)) * (1.0f / 64.0f);
    __syncthreads();
    if (obid() == 0) {
        float* rc = (float*)(ows(P) + OFF_ROPE); float* rs = rc + 1024;
        for (int idx = tid; idx < 1024; idx += 512) { const int p = idx >> 4, f = idx & 15; const float inv = powf(10000.0f, -(float)f / 16.0f); const float ang = (float)p * inv; rc[idx] = cosf(ang); rs[idx] = sinf(ang); }
    }
    bf16_t* dft = (bf16_t*)(ows(P) + OFF_DFT);
    const long gid = (long)obid() * 512 + tid, gstride = (long)gridDim.x * 512;
    for (long it = gid; it < 4096l * 1024; it += gstride) {
        const int k = (int)(it >> 10), n0 = ((int)it & 1023) * 8; const bool isS = n0 >= 4096; const int nn = n0 & 4095;
        float v[8];
#pragma unroll
        for (int j = 0; j < 8; ++j) { const int idx = (k * (nn + j)) & 4095; v[j] = isS ? -tab[(idx + 3072) & 4095] : tab[idx]; }
        u32x4 w; w.x = pk2(v[0], v[1]); w.y = pk2(v[2], v[3]); w.z = pk2(v[4], v[5]); w.w = pk2(v[6], v[7]);
        *(u32x4*)(dft + (size_t)k * 8192 + n0) = w;
    }
    bf16_t* dftc = (bf16_t*)(ows(P) + OFF_DFTC);
    for (long it = gid; it < 256l * 64; it += gstride) {
        const int k = (int)(it >> 6), n0 = ((int)it & 63) * 8; const bool isS = n0 >= 256; const int nn = n0 & 255;
        float v[8];
#pragma unroll
        for (int j = 0; j < 8; ++j) { const int idx = ((k * (nn + j)) & 255) * 16; v[j] = (isS ? -tab[(idx + 3072) & 4095] : tab[idx]) * 4.0f; }
        u32x4 w; w.x = pk2(v[0], v[1]); w.y = pk2(v[2], v[3]); w.z = pk2(v[4], v[5]); w.w = pk2(v[6], v[7]);
        *(u32x4*)(dftc + (size_t)k * 512 + n0) = w;
    }
    __syncthreads();
}

DI void wconv_tile(const float* src, int lds_, int Ksrc, int mode, bf16_t* dst, int ldd, int coff, int kt, int ntile, float* tile) {
    const int tid = otid();
    const int k0 = kt * 64, n0 = ntile * 64;
    { const int nn = tid & 63, np = n0 + nn; int col = np;
      if (mode == 1) { const int t = np >> 8, w = np & 255, grp = w >> 5, isup = (w >> 4) & 1, i = w & 15; const int ff = t * 128 + grp * 16 + i; col = ff < DFF ? ff + isup * DFF : -1; }
#pragma unroll
      for (int i = 0; i < 8; ++i) { const int kk = (tid >> 6) + i * 8, k = k0 + kk; float v = 0.f; if (col >= 0 && k < Ksrc) v = src[(size_t)k * lds_ + col]; tile[kk * 65 + nn] = v; } }
    __syncthreads();
    { const int nn2 = tid >> 3, kq = (tid & 7) * 8; float v[8];
#pragma unroll
      for (int j = 0; j < 8; ++j) v[j] = tile[(kq + j) * 65 + nn2];
      u32x4 w; w.x = pk2(v[0], v[1]); w.y = pk2(v[2], v[3]); w.z = pk2(v[4], v[5]); w.w = pk2(v[6], v[7]);
      *(u32x4*)(dst + (size_t)(n0 + nn2) * ldd + coff + k0 + kq) = w; }
    __syncthreads();
}

DI void phase_wconv(const Params& P, int l, unsigned char* shm) {
    float* tile = (float*)shm;
    bf16_t* W = (bf16_t*)(ows(P) + OFF_W);
    const int tid = otid();
    constexpr int N_UP = 16 * 88, N_DN = 44 * 16, N_IN = 16 * 28, N_CB = 8 * 16, N_CG = 16 * 16, N_OUT = 16 * 16, N_WF = 128;
    constexpr int TOT = 2 * N_UP + 2 * N_DN + N_IN + 3 * N_CB + 3 * N_CG + N_OUT + N_WF;
    for (int u = obid(); u < TOT; u += gridDim.x) {
        int v = u;
        if (v < 2 * N_UP) { const int f = v / N_UP; v %= N_UP; wconv_tile(oin(P, I_WUP) + ((size_t)(l * 2 + f)) * 1024 * 5504, 5504, 1024, 1, W + (f ? W_UP1 : W_UP0), 1024, 0, v % 16, v / 16, tile); continue; }
        v -= 2 * N_UP;
        if (v < 2 * N_DN) { const int f = v / N_DN; v %= N_DN; wconv_tile(oin(P, I_WDN) + ((size_t)(l * 2 + f)) * 2752 * 1024, 1024, 2752, 0, W + (f ? W_DN1 : W_DN0), 2816, 0, v % 44, v / 44, tile); continue; }
        v -= 2 * N_DN;
        if (v < N_IN) { wconv_tile(oin(P, I_WIN) + (size_t)l * 1024 * 2304, 2304, 1024, 0, W + W_IN, 1024, 0, v % 16, v / 16, tile); continue; }
        v -= N_IN;
        if (v < 3 * N_CB) { const int r = v / N_CB; v %= N_CB; wconv_tile(oin(P, I_WBR) + ((size_t)(l * 3 + r)) * 512 * 1024, 1024, 512, 0, W + W_CAT + (size_t)r * 1024 * 1536, 1536, 0, v % 8, v / 8, tile); continue; }
        v -= 3 * N_CB;
        if (v < 3 * N_CG) { const int r = v / N_CG; v %= N_CG; wconv_tile(oin(P, I_WGATE) + ((size_t)(l * 3 + r)) * 1024 * 1024, 1024, 1024, 0, W + W_CAT + (size_t)r * 1024 * 1536, 1536, 512, v % 16, v / 16, tile); continue; }
        v -= 3 * N_CG;
        if (v < N_OUT) { wconv_tile(oin(P, I_WOUT) + (size_t)l * 1024 * 1024, 1024, 1024, 0, W + W_OUT, 1024, 0, v % 16, v / 16, tile); continue; }
        v -= N_OUT;
        {
            float* rows = tile; float* tab = rows + 4096;
            const float* src = oin(P, I_WIN) + (size_t)l * 1024 * 2304 + (size_t)(v * 8) * 2304 + 1792;
            for (int idx = tid; idx < 4096; idx += 512) rows[idx] = src[(size_t)(idx >> 9) * 2304 + (idx & 511)];
            if (tid < 128) tab[tid] = cospif((float)tid * (1.0f / 64.0f));
            __syncthreads();
            const int g = tid >> 7, m = tid & 127;
            float ac[8], as[8];
#pragma unroll
            for (int kk = 0; kk < 8; ++kk) { ac[kk] = 0.f; as[kk] = 0.f; }
            for (int c2 = 0; c2 < 128; ++c2) { const int idx = (m * c2) & 127; const float cv = tab[idx], sv = tab[(idx + 96) & 127];
#pragma unroll
                for (int kk = 0; kk < 8; ++kk) { const float w = rows[kk * 512 + g * 128 + c2]; ac[kk] += w * cv; as[kk] += w * sv; } }
            const float sc = 0.08838834764831845f;
            u32x4 wc_, ws_; wc_.x = pk2(ac[0] * sc, ac[1] * sc); wc_.y = pk2(ac[2] * sc, ac[3] * sc); wc_.z = pk2(ac[4] * sc, ac[5] * sc); wc_.w = pk2(ac[6] * sc, ac[7] * sc);
            ws_.x = pk2(as[0] * sc, as[1] * sc); ws_.y = pk2(as[2] * sc, as[3] * sc); ws_.z = pk2(as[4] * sc, as[5] * sc); ws_.w = pk2(as[6] * sc, as[7] * sc);
            *(u32x4*)(W + W_F + (size_t)tid * 1024 + v * 8) = wc_;
            *(u32x4*)(W + W_F + (size_t)(512 + tid) * 1024 + v * 8) = ws_;
            __syncthreads();
        }
    }
}

DI void phase_norm(const Params& P, const float* g, const float* bt, const float* mod, int jm, float* outp) {
    const int tid = otid(), wid = tid >> 6, lane = tid & 63;
    float* X = (float*)(ows(P) + OFF_X); bf16_t* HB = (bf16_t*)(ows(P) + OFF_HB);
    const int rend = outp ? TL : T;
    for (int r = obid() * 8 + wid; r < rend; r += gridDim.x * 8) {
        const float* src = g ? (X + (size_t)r * D) : (r < TL ? oin(P, I_X) + (size_t)r * D : oin(P, I_CTX) + (size_t)(r - TL) * D);
        f32x4 v[4];
#pragma unroll
        for (int q = 0; q < 4; ++q) v[q] = *(const f32x4*)(src + q * 256 + lane * 4);
        if (g) {
            float sum = 0.f;
#pragma unroll
            for (int q = 0; q < 4; ++q) sum += v[q][0] + v[q][1] + v[q][2] + v[q][3];
            const float mu = wave_sum(sum) * (1.0f / 1024.0f);
            float sq = 0.f;
#pragma unroll
            for (int q = 0; q < 4; ++q) { v[q] -= mu; sq += v[q][0] * v[q][0] + v[q][1] * v[q][1] + v[q][2] * v[q][2] + v[q][3] * v[q][3]; }
            const float rstd = rsqrtf(wave_sum(sq) * (1.0f / 1024.0f) + LN_EPS);
#pragma unroll
            for (int q = 0; q < 4; ++q) { const f32x4 gg = *(const f32x4*)(g + q * 256 + lane * 4), bb = *(const f32x4*)(bt + q * 256 + lane * 4); v[q] = v[q] * rstd * gg + bb; }
        }
#pragma unroll
        for (int q = 0; q < 4; ++q) *(f32x4*)(X + (size_t)r * D + q * 256 + lane * 4) = v[q];
        if (outp) {
#pragma unroll
            for (int q = 0; q < 4; ++q) *(f32x4*)(outp + (size_t)r * D + q * 256 + lane * 4) = v[q];
        }
        if (mod) {
            const int rb = r < TL ? (r >> 12) : 8;
            const float* sh = mod + (size_t)rb * 9216 + jm * 1024; const float* sc = sh + 1024;
#pragma unroll
            for (int q = 0; q < 4; ++q) { const f32x4 a = *(const f32x4*)(sh + q * 256 + lane * 4), b = *(const f32x4*)(sc + q * 256 + lane * 4);
                const f32x4 h = v[q] * (b + 1.0f) + a; u32x2 w; w.x = pk2(h[0], h[1]); w.y = pk2(h[2], h[3]);
                *(u32x2*)(HB + (size_t)r * HBS + q * 256 + lane * 4) = w; }
        }
    }
}

#define MFMA32(a, b, c) __builtin_amdgcn_mfma_f32_32x32x16_bf16((a), (b), (c), 0, 0, 0)
DI bf16x8 mk8(u32x2 lo, u32x2 hi) { u32x4 w; w.x = lo.x; w.y = lo.y; w.z = hi.x; w.w = hi.y; return __builtin_bit_cast(bf16x8, w); }

struct AttnState { float m, l; f32x16 O[2]; };

template <bool MASKED>
DI void attn_tile(AttnState& st, const bf16x8 (&Qf)[4], const bf16_t* kp, const bf16_t* vp, size_t vstride, int hh, int qpos, int klo) {
    bf16x8 Kf[4];
#pragma unroll
    for (int kk = 0; kk < 4; ++kk) Kf[kk] = *(const bf16x8*)(kp + kk * 16);
    bf16x8 Vf[2][2];
#pragma unroll
    for (int db = 0; db < 2; ++db)
#pragma unroll
        for (int c = 0; c < 2; ++c) { const bf16_t* p = vp + (size_t)db * 32 * vstride + 16 * c; Vf[db][c] = mk8(*(const u32x2*)p, *(const u32x2*)(p + 8)); }
    f32x16 s;
#pragma unroll
    for (int i = 0; i < 16; ++i) s[i] = 0.f;
#pragma unroll
    for (int kk = 0; kk < 4; ++kk) s = MFMA32(Kf[kk], Qf[kk], s);
    float tmax = -3.0e38f;
#pragma unroll
    for (int i = 0; i < 16; ++i) {
        float sv = s[i] * 0.125f;
        if (MASKED) { const int kpos = klo + (i & 3) + 8 * (i >> 2) + 4 * hh; const int dlt = qpos - kpos; if (dlt > 128 || dlt < -128) sv = -3.0e38f; }
        s[i] = sv; tmax = fmaxf(tmax, sv);
    }
    tmax = fmaxf(tmax, __shfl_xor(tmax, 32));
    const float mnew = fmaxf(st.m, tmax);
    const float alpha = __expf(st.m - mnew);
    float psum = 0.f;
#pragma unroll
    for (int i = 0; i < 16; ++i) { const float p = __expf(s[i] - mnew); s[i] = p; psum += p; }
    st.l = st.l * alpha + psum; st.m = mnew;
#pragma unroll
    for (int db = 0; db < 2; ++db)
#pragma unroll
        for (int i = 0; i < 16; ++i) st.O[db][i] *= alpha;
    bf16x8 Pf[2];
#pragma unroll
    for (int c = 0; c < 2; ++c) { u32x4 w; w.x = pk2(s[8 * c + 0], s[8 * c + 1]); w.y = pk2(s[8 * c + 2], s[8 * c + 3]); w.z = pk2(s[8 * c + 4], s[8 * c + 5]); w.w = pk2(s[8 * c + 6], s[8 * c + 7]); Pf[c] = __builtin_bit_cast(bf16x8, w); }
#pragma unroll
    for (int db = 0; db < 2; ++db)
#pragma unroll
        for (int c = 0; c < 2; ++c) st.O[db] = MFMA32(Vf[db][c], Pf[c], st.O[db]);
}

DI void phase_attn(const Params& P, int l, bool do_ctx) {
    const int tid = otid(), wid = tid >> 6, lane = tid & 63, hh = lane >> 5, ql = lane & 31;
    const bf16_t* Q = (const bf16_t*)(ows(P) + OFF_R + R_Q); const bf16_t* Kb = (const bf16_t*)(ows(P) + OFF_R + R_K);
    const bf16_t* VT = (const bf16_t*)(ows(P) + OFF_R + R_VT); const bf16_t* VTC = (const bf16_t*)(ows(P) + OFF_R + R_VTC);
    bf16_t* HB = (bf16_t*)(ows(P) + OFF_HB);
    const float* sink = oin(P, I_SINK) + l * 8;
    const int ntask = 8192 + (do_ctx ? 512 : 0);
    for (int t = obid() * 8 + wid; t < ntask; t += gridDim.x * 8) {
        const bool isc = t >= 8192;
        int b, kvh, hq, blk = 0, sub, qrow, qpos = 0;
        if (!isc) { sub = t & 3; hq = (t >> 2) & 3; kvh = (t >> 4) & 1; blk = (t >> 5) & 31; b = t >> 10; qpos = blk * 128 + sub * 32 + ql; qrow = b * 4096 + qpos; }
        else { const int t2 = t - 8192; sub = t2 & 7; hq = (t2 >> 3) & 3; kvh = (t2 >> 5) & 1; b = t2 >> 6; qrow = TL + b * 256 + sub * 32 + ql; }
        const int h = kvh * 4 + hq;
        bf16x8 Qf[4];
#pragma unroll
        for (int kk = 0; kk < 4; ++kk) Qf[kk] = *(const bf16x8*)(Q + (size_t)qrow * 512 + h * 64 + kk * 16 + hh * 8);
        AttnState st; st.m = sink[h]; st.l = hh == 0 ? 1.0f : 0.0f;
#pragma unroll
        for (int i = 0; i < 16; ++i) { st.O[0][i] = 0.f; st.O[1][i] = 0.f; }
        if (!isc) {
            const int qlo = blk * 128 + sub * 32;
            for (int kt = 0; kt < 12; ++kt) {
                const int klo = (blk - 1) * 128 + kt * 32;
                if (klo < 0 || klo >= SEQ) continue;
                if (klo + 31 < qlo - 128 || klo > qlo + 31 + 128) continue;
                const bf16_t* kp = Kb + (size_t)(b * 4096 + klo + ql) * 128 + kvh * 64 + hh * 8;
                const bf16_t* vp = VT + ((size_t)(b * 128 + kvh * 64 + ql)) * 4096 + klo + 4 * hh;
                attn_tile<true>(st, Qf, kp, vp, 4096, hh, qpos, klo);
            }
        }
        for (int kt = 0; kt < 8; ++kt) {
            const int klo = kt * 32;
            const bf16_t* kp = Kb + (size_t)(TL + b * 256 + klo + ql) * 128 + kvh * 64 + hh * 8;
            const bf16_t* vp = VTC + ((size_t)(b * 128 + kvh * 64 + ql)) * 256 + klo + 4 * hh;
            attn_tile<false>(st, Qf, kp, vp, 256, hh, 0, klo);
        }
        const float ltot = st.l + __shfl_xor(st.l, 32);
        const float inv = 1.0f / ltot;
        bf16_t* op = HB + (size_t)qrow * HBS + 1024 + h * 64 + 4 * hh;
#pragma unroll
        for (int db = 0; db < 2; ++db)
#pragma unroll
            for (int g4 = 0; g4 < 4; ++g4) { u32x2 w; w.x = pk2(st.O[db][4 * g4] * inv, st.O[db][4 * g4 + 1] * inv); w.y = pk2(st.O[db][4 * g4 + 2] * inv, st.O[db][4 * g4 + 3] * inv);
                *(u32x2*)(op + db * 32 + 8 * g4) = w; }
    }
}

DI void phase_sgu(const Params& P, int l, unsigned char* shm) {
    const int tid = otid(), wid = tid >> 6, lane = tid & 63, hh = lane >> 5, ql = lane & 31;
    bf16_t* vT = (bf16_t*)shm;
    const bf16_t* U = (const bf16_t*)(ows(P) + OFF_R + R_U); const bf16_t* Z = (const bf16_t*)(ows(P) + OFF_R + R_Z);
    bf16_t* HB = (bf16_t*)(ows(P) + OFF_HB);
    const float* lg = oin(P, I_SGULG) + l * 512; const float* lb = oin(P, I_SGULB) + l * 512;
    const float* sw = oin(P, I_SGUW) + (size_t)l * 4 * 128 * 128; const float* sb = oin(P, I_SGUB) + l * 4 * 128;
    float gg[8], bb[8];
#pragma unroll
    for (int j = 0; j < 8; ++j) { gg[j] = lg[j * 64 + lane]; bb[j] = lb[j * 64 + lane]; }
    for (int chunk = obid(); chunk < 272; chunk += gridDim.x) {
        const int r0 = chunk * 128;
        for (int tt = 0; tt < 16; ++tt) {
            const int tok = wid * 16 + tt; const bf16_t* zp = Z + (size_t)(r0 + tok) * 512;
            float z[8]; float sum = 0.f;
#pragma unroll
            for (int j = 0; j < 8; ++j) { z[j] = bf2f(zp[j * 64 + lane]); sum += z[j]; }
            const float mu = wave_sum(sum) * (1.0f / 512.0f);
            float sq = 0.f;
#pragma unroll
            for (int j = 0; j < 8; ++j) { z[j] -= mu; sq += z[j] * z[j]; }
            const float rstd = rsqrtf(wave_sum(sq) * (1.0f / 512.0f) + LN_EPS);
#pragma unroll
            for (int j = 0; j < 8; ++j) vT[(j * 64 + lane) * 136 + tok] = f2bf(z[j] * rstd * gg[j] + bb[j]);
        }
        __syncthreads();
        const int g = wid >> 1, cb = g * 128 + (wid & 1) * 64;
        for (int mb = 0; mb < 4; ++mb) {
            f32x16 acc[2];
#pragma unroll
            for (int i = 0; i < 16; ++i) { acc[0][i] = 0.f; acc[1][i] = 0.f; }
#pragma unroll
            for (int kc = 0; kc < 8; ++kc) {
                const float* wp = sw + ((size_t)(g * 128 + mb * 32 + ql)) * 128 + kc * 16 + hh * 8;
                const f32x4 w0 = *(const f32x4*)wp, w1 = *(const f32x4*)(wp + 4);
                u32x4 wa; wa.x = pk2(w0[0], w0[1]); wa.y = pk2(w0[2], w0[3]); wa.z = pk2(w1[0], w1[1]); wa.w = pk2(w1[2], w1[3]);
                const bf16x8 Af = __builtin_bit_cast(bf16x8, wa);
#pragma unroll
                for (int nb = 0; nb < 2; ++nb) { const bf16x8 Bf = *(const bf16x8*)(vT + (cb + nb * 32 + ql) * 136 + kc * 16 + hh * 8); acc[nb] = MFMA32(Af, Bf, acc[nb]); }
            }
#pragma unroll
            for (int nb = 0; nb < 2; ++nb)
#pragma unroll
                for (int i = 0; i < 16; ++i) { const int prow = mb * 32 + (i & 3) + 8 * (i >> 2) + 4 * hh; const int c = cb + nb * 32 + ql; const size_t row = (size_t)(r0 + prow);
                    const float val = (acc[nb][i] + sb[g * 128 + prow]) * bf2f(U[row * 512 + c]);
                    HB[row * HBS + 1536 + c] = f2bf(val); }
        }
        __syncthreads();
    }
}

__global__ void __launch_bounds__(512, 2) mega(Params P) {
    extern __shared__ __attribute__((aligned(16))) unsigned char shm[];
    LAS unsigned char* lds = (LAS unsigned char*)shm;
    cg::grid_group grid = cg::this_grid();
    volatile LAS unsigned* bst = (volatile LAS unsigned*)(lds + LDS_BYTES - 16);
    if (threadIdx.x == 0) { bst[0] = 0u; bst[1] = 0u; }
    if (blockIdx.x == 0) { unsigned* bw = (unsigned*)(P.ws + OFF_BAR); for (int i = threadIdx.x; i < XCD_BAR_WORDS; i += 512) bw[i] = 0u; }
    __syncthreads();

    phase_mods(P, shm);
    phase_tables(P, shm);
    phase_wconv(P, 0, shm);
    grid.sync();
    const XcdBarrier gbar = xcd_barrier_post((unsigned*)(P.ws + OFF_BAR), bst);
#define GSYNC() xcd_barrier(gbar)
    phase_norm(P, nullptr, nullptr, (const float*)(ows(P) + OFF_MODS), 0, nullptr);
    GSYNC();

    for (int st = 0; st < 2 * DEPTH; ++st) {
        const int l = st >> 1, f = st & 1;
        {
            unsigned char* ws = ows(P); bf16_t* W = (bf16_t*)(ws + OFF_W);
            SchedTile S; S.init(ws + OFF_HB, 256ull * HBS * 2, W + (f ? W_UP1 : W_UP0), 256ull * 1024 * 2, T / 256, NUP / 256);
            EpiUp E; E.act = (bf16_t*)(ws + OFF_R);
            for (int rep = 0; rep < REP_UP; ++rep) gemm_phase<1024, HBS, 1024>(lds, S, E);
        }
        GSYNC();
        for (int es = 0; es < EXTRA_SYNCS; ++es) GSYNC();
        {
            unsigned char* ws = ows(P); bf16_t* W = (bf16_t*)(ws + OFF_W);
            SchedTile S; S.init(ws + OFF_R, 256ull * DFFP * 2, W + (f ? W_DN1 : W_DN0), 256ull * DFFP * 2, T / 256, 4);
            EpiRes E; E.X = (float*)(ws + OFF_X); E.gm = (const float*)(ws + OFF_MODS) + (size_t)l * 9 * 9216 + (f ? 8 : 2) * 1024; E.s = 0.5f;
            gemm_phase<DFFP, DFFP, DFFP>(lds, S, E);
        }
        GSYNC();
        if (f == 0) {
            phase_norm(P, oin(P, I_LNG) + (l * 3 + 0) * 1024, oin(P, I_LNB) + (l * 3 + 0) * 1024, (const float*)(ows(P) + OFF_MODS) + (size_t)l * 9 * 9216, 3, nullptr);
            GSYNC();
            {
                unsigned char* ws = ows(P); bf16_t* W = (bf16_t*)(ws + OFF_W); unsigned char* R = ws + OFF_R;
                SchedTile S; S.init(ws + OFF_HB, 256ull * HBS * 2, W + W_IN, 256ull * 1024 * 2, T / 256, 7);
                EpiIn E; E.Q = (bf16_t*)(R + R_Q); E.Kb = (bf16_t*)(R + R_K); E.VT = (bf16_t*)(R + R_VT); E.VTC = (bf16_t*)(R + R_VTC); E.U = (bf16_t*)(R + R_U); E.Z = (bf16_t*)(R + R_Z);
                E.ropec = (const float*)(ws + OFF_ROPE); E.ropes = E.ropec + 1024;
                for (int rep = 0; rep < REP_IN; ++rep) gemm_phase<1024, HBS, 1024>(lds, S, E);
            }
            {
                unsigned char* ws = ows(P); bf16_t* W = (bf16_t*)(ws + OFF_W); unsigned char* R = ws + OFF_R;
                SchedTile S; S.init(W + W_F, 256ull * 1024 * 2, ws + OFF_HB, 256ull * HBS * 2, 4, T / 256);
                EpiFT E; E.FT = (bf16_t*)(R + R_FT); E.FTC = (bf16_t*)(R + R_FTC);
                for (int rep = 0; rep < REP_IN; ++rep) gemm_phase<1024, 1024, HBS>(lds, S, E);
            }
            GSYNC();
            {
                unsigned char* ws = ows(P); unsigned char* R = ws + OFF_R;
                SchedTile S; S.init(ws + OFF_DFT, 256ull * 8192 * 2, R + R_FT, 256ull * 8192 * 2, 16, 16);
                EpiDft E; E.HB = (bf16_t*)(ws + OFF_HB); E.rowbase = 0; E.rpb = 4096;
                for (int rep = 0; rep < REP_DFT; ++rep) gemm_phase<8192, 8192, 8192>(lds, S, E);
            }
            if (l < DEPTH - 1) {
                unsigned char* ws = ows(P); unsigned char* R = ws + OFF_R;
                SchedTile S; S.init(ws + OFF_DFTC, 0, R + R_FTC, 256ull * 512 * 2, 1, 16);
                EpiDft E; E.HB = (bf16_t*)(ws + OFF_HB); E.rowbase = TL; E.rpb = 256;
                gemm_phase<512, 512, 512>(lds, S, E);
            }
            for (int rep = 0; rep < REP_ATT; ++rep) phase_attn(P, l, l < DEPTH - 1);
            for (int rep = 0; rep < REP_SGU; ++rep) phase_sgu(P, l, shm);
            GSYNC();
            {
                unsigned char* ws = ows(P); bf16_t* W = (bf16_t*)(ws + OFF_W); unsigned char* R = ws + OFF_R;
                SchedBr S; S.HBp = (const char*)(ws + OFF_HB); S.Wc = (const char*)(W + W_CAT); S.G = gridDim.x; S.c = obid();
                EpiBr E; E.merged = (bf16_t*)(R + R_MERGED); E.scr = R + R_SCR + (size_t)obid() * 131072;
                for (int rep = 0; rep < REP_BR; ++rep) gemm_phase<512, HBS, 1536>(lds, S, E);
            }
            GSYNC();
            {
                unsigned char* ws = ows(P); bf16_t* W = (bf16_t*)(ws + OFF_W); unsigned char* R = ws + OFF_R;
                SchedTile S; S.init(R + R_MERGED, 256ull * 1024 * 2, W + W_OUT, 256ull * 1024 * 2, T / 256, 4);
                EpiRes E; E.X = (float*)(ws + OFF_X); E.gm = (const float*)(ws + OFF_MODS) + (size_t)l * 9 * 9216 + 5 * 1024; E.s = 1.0f;
                gemm_phase<1024, 1024, 1024>(lds, S, E);
            }
            GSYNC();
            phase_norm(P, oin(P, I_LNG) + (l * 3 + 1) * 1024, oin(P, I_LNB) + (l * 3 + 1) * 1024, (const float*)(ows(P) + OFF_MODS) + (size_t)l * 9 * 9216, 6, nullptr);
            GSYNC();
        } else {
            const bool lastl = (l == DEPTH - 1);
            phase_norm(P, oin(P, I_LNG) + (l * 3 + 2) * 1024, oin(P, I_LNB) + (l * 3 + 2) * 1024, lastl ? nullptr : (const float*)(ows(P) + OFF_MODS) + (size_t)(l + 1) * 9 * 9216, 0, lastl ? P.out : nullptr);
            if (!lastl) { for (int rep = 0; rep < REP_WCONV; ++rep) phase_wconv(P, l + 1, shm); GSYNC(); }
        }
    }
}

extern "C" void kernel_launch(void* const* d_in, const int* in_sizes, int n_in, void* d_out, int out_size, void* d_ws, size_t ws_size, hipStream_t stream) {
    static int grid_blocks = 0;
    if (!grid_blocks) {
        int dev = 0, cus = 0, per_cu = 0;
        hipGetDevice(&dev);
        hipDeviceGetAttribute(&cus, hipDeviceAttributeMultiprocessorCount, dev);
        if (hipFuncSetAttribute((const void*)mega, hipFuncAttributeMaxDynamicSharedMemorySize, LDS_BYTES) != hipSuccess) fprintf(stderr, "hipFuncSetAttribute failed\n");
        hipOccupancyMaxActiveBlocksPerMultiprocessor(&per_cu, (const void*)mega, 512, LDS_BYTES);
        if (per_cu < 1) { fprintf(stderr, "occupancy query gave %d\n", per_cu); per_cu = 1; }
        (void)hipGetLastError();
        grid_blocks = cus * per_cu;
        if (grid_blocks > 256) grid_blocks = 256;
        if (ws_size < WS_END) fprintf(stderr, "workspace too small: %zu < %zu\n", ws_size, (size_t)WS_END);
    }
    Params p{};
    for (int i = 0; i < 19; ++i) p.in[i] = (const float*)d_in[i];
    p.out = (float*)d_out; p.ws = (unsigned char*)d_ws;
    void* args[] = {&p};
    hipError_t e = hipLaunchCooperativeKernel((const void*)mega, dim3(grid_blocks), dim3(512), args, LDS_BYTES, stream);
    if (e != hipSuccess) fprintf(stderr, "cooperative launch failed: %s (grid %d)\n", hipGetErrorString(e), grid_blocks);
}
```

```cpp
#include <hip/hip_runtime.h>
#include <hip/hip_cooperative_groups.h>
#include <cstdio>
namespace cg = cooperative_groups;
#define REP_UP 1
#define REP_IN 1
#define REP_DFT 1
#define REP_ATT 1
#define REP_SGU 1
#define REP_BR 1
#define REP_WCONV 1
#define EXTRA_SYNCS 0

#define LAS __attribute__((address_space(3)))
#define DI __device__ __forceinline__
typedef unsigned short bf16_t;
typedef short bf16x8 __attribute__((ext_vector_type(8)));
typedef float f32x2 __attribute__((ext_vector_type(2)));
typedef float f32x4 __attribute__((ext_vector_type(4)));
typedef float f32x16 __attribute__((ext_vector_type(16)));
typedef unsigned u32x2 __attribute__((ext_vector_type(2)));
typedef unsigned u32x4 __attribute__((ext_vector_type(4)));
typedef __bf16 bfv2 __attribute__((ext_vector_type(2)));

constexpr int D = 1024, NB = 8, SEQ = 4096, DEPTH = 4, CTXL = 256;
constexpr int TL = NB * SEQ, TC = NB * CTXL, T = TL + TC;
constexpr int DFF = 2752, DFFP = 2816, NUP = 5632;
constexpr int HBS = 2560;
constexpr float ALPHA = 1.681792830507429f;
constexpr float LN_EPS = 1e-5f;
constexpr int LDS_BYTES = 144 * 1024;

constexpr size_t OFF_MODS = 0;
constexpr size_t SZ_MODS = 4ull * 9 * 9216 * 4;
constexpr size_t OFF_ROPE = OFF_MODS + SZ_MODS;
constexpr size_t SZ_ROPE = 2ull * 64 * 16 * 4;
constexpr size_t OFF_DFT = OFF_ROPE + SZ_ROPE;
constexpr size_t SZ_DFT = 4096ull * 8192 * 2;
constexpr size_t OFF_DFTC = OFF_DFT + SZ_DFT;
constexpr size_t SZ_DFTC = 256ull * 512 * 2;
constexpr size_t OFF_W = OFF_DFTC + SZ_DFTC;
constexpr size_t W_UP0 = 0, W_DN0 = W_UP0 + 5632ull * 1024, W_UP1 = W_DN0 + 1024ull * 2816, W_DN1 = W_UP1 + 5632ull * 1024,
                 W_IN = W_DN1 + 1024ull * 2816, W_F = W_IN + 1792ull * 1024, W_CAT = W_F + 1024ull * 1024,
                 W_OUT = W_CAT + 3ull * 1024 * 1536, W_END = W_OUT + 1024ull * 1024;
constexpr size_t SZ_W = W_END * 2;
constexpr size_t OFF_X = OFF_W + SZ_W;
constexpr size_t SZ_X = (size_t)T * 1024 * 4;
constexpr size_t OFF_HB = OFF_X + SZ_X;
constexpr size_t SZ_HB = (size_t)T * HBS * 2;
constexpr size_t OFF_R = OFF_HB + SZ_HB;
constexpr size_t R_Q = 0;
constexpr size_t R_U = R_Q + (size_t)T * 512 * 2;
constexpr size_t R_Z = R_U + (size_t)T * 512 * 2;
constexpr size_t R_K = R_Z + (size_t)T * 512 * 2;
constexpr size_t R_VT = R_K + (size_t)T * 128 * 2;
constexpr size_t R_VTC = R_VT + 8ull * 128 * 4096 * 2;
constexpr size_t R_FT = R_VTC + 8ull * 128 * 256 * 2;
constexpr size_t R_FTC = R_FT + 8ull * 512 * 8192 * 2;
constexpr size_t R_END = R_FTC + 8ull * 512 * 512 * 2;
constexpr size_t SZ_R = (size_t)T * DFFP * 2;
static_assert(R_END == SZ_R, "region R");
constexpr size_t R_MERGED = R_Q;
constexpr size_t R_SCR = R_Z;
constexpr size_t OFF_BAR = OFF_R + SZ_R;
constexpr size_t SZ_BAR = 16384;
constexpr size_t WS_END = OFF_BAR + SZ_BAR;
static_assert(WS_END <= 721420288ull, "workspace");
static_assert(256ull * 3 * 131072 <= R_END - R_Z, "scr");

struct Params { const float* in[19]; float* out; unsigned char* ws; };
enum { I_X = 0, I_C, I_CTX, I_CCTX, I_WMOD, I_BMOD, I_WUP, I_WDN, I_LNG, I_LNB, I_WIN, I_SINK, I_SGUW, I_SGUB, I_SGULG, I_SGULB, I_WGATE, I_WBR, I_WOUT };

DI unsigned pk2(float a, float b) { f32x2 v = {a, b}; bfv2 r = __builtin_convertvector(v, bfv2); return __builtin_bit_cast(unsigned, r); }
DI bf16_t f2bf(float a) { return (bf16_t)(pk2(a, 0.f) & 0xffffu); }
DI float bf2f(unsigned b) { return __uint_as_float(b << 16); }
DI float bflo(unsigned w) { return __uint_as_float(w << 16); }
DI float bfhi(unsigned w) { return __uint_as_float(w & 0xffff0000u); }
DI float sigmoidf_(float x) { return 1.0f / (1.0f + __expf(-x)); }
DI float siluf_(float x) { return x / (1.0f + __expf(-x)); }
DI float geluf_(float x) { const float y = 1.5957691216057308f * (x + 0.044715f * x * x * x); return x / (1.0f + __expf(-y)); }
DI int otid() { int t = threadIdx.x; asm volatile("" : "+v"(t)); return t; }
DI int obid() { int b = blockIdx.x; asm volatile("" : "+s"(b)); return b; }
DI unsigned char* ows(const Params& P) { unsigned char* w = P.ws; asm volatile("" : "+s"(w)); return w; }
DI const float* oin(const Params& P, int i) { const float* p = P.in[i]; asm volatile("" : "+s"(p)); return p; }
DI float shx(float v, int o, int lane) { return __int_as_float(__builtin_amdgcn_ds_bpermute((lane ^ o) << 2, __float_as_int(v))); }
DI float wave_sum(float v, int lane) {
#pragma unroll
    for (int o = 32; o >= 1; o >>= 1) v += shx(v, o, lane);
    return v;
}

constexpr int BM = 256, BK = 64, HALF = 128, HTB = HALF * BK * 2, NXCD = 8, WGM = 8;
DI int lds_byte(int r, int c) { const int st = (r >> 4) * 2 + (c >> 5), rr = r & 15, cc = c & 31, ob = rr * 64 + cc * 2; return st * 1024 + (ob ^ (((ob >> 9) & 1) << 5)); }
DI void stage_rc(int b, int& R, int& C) { const int st = b / 1024, sb = b % 1024, swz = sb ^ (((sb >> 9) & 1) << 5); R = (st >> 1) * 16 + swz / 64; C = (st & 1) * 32 + (swz % 64) / 2; }

struct Unit { int pm, pn, aux; };

struct SchedTile {
    const char* Ab; const char* Bb; size_t tA, tB; int nM, nN, nwg, G, c;
    DI void init(const void* A, size_t tA_, const void* B, size_t tB_, int nM_, int nN_) { Ab = (const char*)A; Bb = (const char*)B; tA = tA_; tB = tB_; nM = nM_; nN = nN_; nwg = nM * nN; G = gridDim.x; c = obid(); }
    DI bool next(int i, Unit& u) const {
        const long L = (long)i * G + c; if (L >= nwg) return false;
        int wgid = (int)L; { const int q = nwg / NXCD, r = nwg % NXCD, xcd = wgid % NXCD, off = wgid / NXCD; wgid = (xcd < r ? xcd * (q + 1) : r * (q + 1) + (xcd - r) * q) + off; }
        const int nig = WGM * nN, gid = wgid / nig, fm = gid * WGM, gsz = (nM - fm) < WGM ? (nM - fm) : WGM;
        u.pm = fm + ((wgid % nig) % gsz); u.pn = (wgid % nig) / gsz; u.aux = 0; return true;
    }
    DI const char* A(const Unit& u) const { return Ab + (size_t)u.pm * tA; }
    DI const char* B(const Unit& u) const { return Bb + (size_t)u.pn * tB; }
};

struct SchedBr {
    const char* HBp; const char* Wc; int G, c, ntiles;
    DI bool next(int i, Unit& u) const { const int ti = (i / 9) * G + c; if (ti >= ntiles) return false; u.pm = ti >> 2; u.pn = ti & 3; u.aux = i % 9; return true; }
    DI const char* A(const Unit& u) const { const int off = u.aux < 6 ? (u.aux & 1) * 512 : 1024 + (u.aux - 6) * 512; return HBp + ((size_t)u.pm * 256 * HBS + off) * 2; }
    DI const char* B(const Unit& u) const { const int r = u.aux < 6 ? (u.aux >> 1) : (u.aux - 6); const int off = u.aux < 6 ? 512 + (u.aux & 1) * 512 : 0; return Wc + ((size_t)(r * 1024 + u.pn * 256) * 1536 + off) * 2; }
};

template <int K, int lda, int ldb, class Epi, class Sched>
DI void gemm_phase(LAS unsigned char* lds, const Sched& S, const Epi& E) {
    const int tid = otid(), wid = __builtin_amdgcn_readfirstlane(tid >> 6), lane = tid & 63, wr = wid >> 2, wc = wid & 3, fr = lane & 15, fq = lane >> 4;
    constexpr int nt = K / BK;
    unsigned voffA[2], voffB[2];
#pragma unroll
    for (int i = 0; i < 2; ++i) { int R, C; stage_rc(tid * 16 + i * 8192, R, C); voffA[i] = (unsigned)(R * lda + C) * 2u; voffB[i] = (unsigned)(R * ldb + C) * 2u; }
    constexpr size_t kstep = (size_t)(BK * 2);
    constexpr size_t hstepA = (size_t)HALF * lda * 2, hstepB = (size_t)HALF * ldb * 2;
    const unsigned ldsw = (unsigned)wid * 1024u;
    const int aoff = lds_byte(wr * 64 + fr, fq * 8), boff = lds_byte(wc * 32 + fr, fq * 8);
#define PG8_SA(b, h) (((b) * 2 + (h)) * HTB)
#define PG8_SB(b, h) ((4 + (b) * 2 + (h)) * HTB)
#define PG8_STAGE(bufoff, gbase, voff) do { _Pragma("unroll") for (int _i = 0; _i < 2; ++_i) \
        __builtin_amdgcn_global_load_lds((const unsigned*)((const char*)(gbase) + (voff)[_i]), (LAS unsigned*)(lds + (bufoff) + ldsw + _i * 8192), 16, 0, 0); } while (0)
#define PG8_LDA(dst, b, h) do { _Pragma("unroll") for (int m = 0; m < 4; ++m) _Pragma("unroll") for (int k = 0; k < 2; ++k) dst[m][k] = *(const LAS bf16x8*)(lds + PG8_SA(b, h) + aoff + m * 2048 + k * 1024); } while (0)
#define PG8_LDB(dst, b, h) do { _Pragma("unroll") for (int n = 0; n < 2; ++n) _Pragma("unroll") for (int k = 0; k < 2; ++k) dst[n][k] = *(const LAS bf16x8*)(lds + PG8_SB(b, h) + boff + n * 2048 + k * 1024); } while (0)
#define PG8_MMA(ai, bj, At, Bt) do { __builtin_amdgcn_s_setprio(1); _Pragma("unroll") for (int m = 0; m < 4; ++m) _Pragma("unroll") for (int n = 0; n < 2; ++n) _Pragma("unroll") for (int k = 0; k < 2; ++k) \
        acc[ai][bj][m][n] = __builtin_amdgcn_mfma_f32_16x16x32_bf16(Bt[n][k], At[m][k], acc[ai][bj][m][n], 0, 0, 0); __builtin_amdgcn_s_setprio(0); } while (0)
#define PG8_WAIT_V(n) asm volatile("s_waitcnt vmcnt(" #n ")" ::: "memory")
#define PG8_WAIT_L(n) asm volatile("s_waitcnt lgkmcnt(" #n ")" ::: "memory")
#define PG8_BAR __builtin_amdgcn_s_barrier()
#define PG8_SCHED __builtin_amdgcn_sched_barrier(0)
    Unit cur, nxt; int ui = 0;
    if (!S.next(0, cur)) return;
    f32x4 acc[2][2][4][2];
#pragma unroll
    for (int a = 0; a < 2; ++a)
#pragma unroll
        for (int b = 0; b < 2; ++b)
#pragma unroll
            for (int m = 0; m < 4; ++m)
#pragma unroll
                for (int n = 0; n < 2; ++n) acc[a][b][m][n] = (f32x4){0.f, 0.f, 0.f, 0.f};
    bf16x8 At[4][2], B0[2][2], B1[2][2];
    const char* cA = S.A(cur); const char* cB = S.B(cur);
    PG8_STAGE(PG8_SB(0, 0), cB, voffB); PG8_STAGE(PG8_SA(0, 0), cA, voffA); PG8_STAGE(PG8_SB(0, 1), cB + hstepB, voffB); PG8_STAGE(PG8_SA(0, 1), cA + hstepA, voffA);
    if (wr == 1) PG8_BAR;
    PG8_WAIT_V(4); PG8_BAR;
    PG8_STAGE(PG8_SB(1, 0), cB + kstep, voffB); PG8_STAGE(PG8_SA(1, 0), cA + kstep, voffA); PG8_STAGE(PG8_SB(1, 1), cB + hstepB + kstep, voffB);
    PG8_WAIT_V(6); PG8_BAR;
    for (;;) {
        const bool has_next = S.next(ui + 1, nxt);
        const char* nA = has_next ? S.A(nxt) : cA; const char* nB = has_next ? S.B(nxt) : cB;
        for (int t = 0; t < nt; t += 2) {
            const bool last = (t == nt - 2);
            const char* a1 = cA + (size_t)(t + 1) * kstep;
            const char* a2 = last ? nA : cA + (size_t)(t + 2) * kstep; const char* b2 = last ? nB : cB + (size_t)(t + 2) * kstep;
            const char* a3 = a2 + kstep; const char* b3 = b2 + kstep;
            PG8_LDB(B0, 0, 0); PG8_SCHED; PG8_LDA(At, 0, 0); PG8_STAGE(PG8_SA(1, 1), a1 + hstepA, voffA);
            PG8_WAIT_L(8); PG8_BAR; PG8_WAIT_L(0); PG8_MMA(0, 0, At, B0); PG8_BAR; PG8_SCHED;
            PG8_LDB(B1, 0, 1); PG8_STAGE(PG8_SB(0, 0), b2, voffB);
            PG8_BAR; PG8_WAIT_L(0); PG8_MMA(0, 1, At, B1); PG8_BAR;
            PG8_LDA(At, 0, 1); PG8_STAGE(PG8_SA(0, 0), a2, voffA);
            PG8_BAR; PG8_WAIT_L(0); PG8_MMA(1, 0, At, B0); PG8_BAR; PG8_SCHED;
            PG8_STAGE(PG8_SB(0, 1), b2 + hstepB, voffB);
            PG8_WAIT_V(6); PG8_BAR; PG8_MMA(1, 1, At, B1); PG8_BAR;
            PG8_LDB(B0, 1, 0); PG8_SCHED; PG8_LDA(At, 1, 0); PG8_STAGE(PG8_SA(0, 1), a2 + hstepA, voffA);
            PG8_WAIT_L(8); PG8_BAR; PG8_WAIT_L(0); PG8_MMA(0, 0, At, B0); PG8_BAR; PG8_SCHED;
            PG8_LDB(B1, 1, 1); PG8_STAGE(PG8_SB(1, 0), b3, voffB);
            PG8_BAR; PG8_WAIT_L(0); PG8_MMA(0, 1, At, B1); PG8_BAR;
            PG8_LDA(At, 1, 1); PG8_STAGE(PG8_SA(1, 0), a3, voffA);
            PG8_BAR; PG8_WAIT_L(0); PG8_MMA(1, 0, At, B0); PG8_BAR; PG8_SCHED;
            PG8_STAGE(PG8_SB(1, 1), b3 + hstepB, voffB);
            PG8_WAIT_V(6); PG8_BAR; PG8_MMA(1, 1, At, B1); PG8_BAR;
        }
        const bool zero = E(acc, cur, wr, wc, fr, fq);
        if (!has_next) break;
        if (zero) {
#pragma unroll
            for (int a = 0; a < 2; ++a)
#pragma unroll
                for (int b = 0; b < 2; ++b)
#pragma unroll
                    for (int m = 0; m < 4; ++m)
#pragma unroll
                        for (int n = 0; n < 2; ++n) acc[a][b][m][n] = (f32x4){0.f, 0.f, 0.f, 0.f};
        }
        cur = nxt; cA = nA; cB = nB; ++ui;
    }
    PG8_WAIT_V(0);
    if (wr == 0) PG8_BAR;
    PG8_BAR;
#undef PG8_SA
#undef PG8_SB
#undef PG8_STAGE
#undef PG8_LDA
#undef PG8_LDB
#undef PG8_MMA
#undef PG8_WAIT_V
#undef PG8_WAIT_L
#undef PG8_BAR
#undef PG8_SCHED
}

typedef f32x4 AccT[2][2][4][2];

struct EpiUp {
    bf16_t* act;
    DI bool operator()(AccT& acc, const Unit& u, int wr, int wc, int fr, int fq) const {
        asm volatile("" : "+v"(fr), "+v"(fq));
        const int row0 = u.pm * BM + wr * 64 + fr, c0 = u.pn * 128 + wc * 16 + 4 * fq;
#pragma unroll
        for (int ai = 0; ai < 2; ++ai)
#pragma unroll
            for (int m = 0; m < 4; ++m) { bf16_t* rowp = act + (size_t)(row0 + ai * HALF + m * 16) * DFFP + c0;
#pragma unroll
                for (int bj = 0; bj < 2; ++bj) { const f32x4 g = acc[ai][bj][m][0], up = acc[ai][bj][m][1];
                    u32x2 w; w.x = pk2(siluf_(g[0]) * up[0], siluf_(g[1]) * up[1]); w.y = pk2(siluf_(g[2]) * up[2], siluf_(g[3]) * up[3]);
                    *(u32x2*)(rowp + bj * 64) = w; } }
        return true;
    }
};

struct EpiRes {
    float* X; const float* gm; float s;
    DI bool operator()(AccT& acc, const Unit& u, int wr, int wc, int fr, int fq) const {
        asm volatile("" : "+v"(fr), "+v"(fq));
        const int row0 = u.pm * BM + wr * 64 + fr, col0 = u.pn * BM + wc * 32 + 4 * fq;
        const int rb = (u.pm * BM < TL) ? ((u.pm * BM) >> 12) : 8;
        const float* gp = gm + (size_t)rb * 9216 + col0;
        f32x4 gv[2][2];
#pragma unroll
        for (int bj = 0; bj < 2; ++bj)
#pragma unroll
            for (int n = 0; n < 2; ++n) gv[bj][n] = *(const f32x4*)(gp + bj * HALF + n * 16) * s;
#pragma unroll
        for (int ai = 0; ai < 2; ++ai)
#pragma unroll
            for (int m = 0; m < 4; ++m) { float* rowp = X + (size_t)(row0 + ai * HALF + m * 16) * D + col0;
#pragma unroll
                for (int bj = 0; bj < 2; ++bj)
#pragma unroll
                    for (int n = 0; n < 2; ++n) { f32x4* px = (f32x4*)(rowp + bj * HALF + n * 16); const f32x4 x = *px; *px = x * ALPHA + gv[bj][n] * acc[ai][bj][m][n]; } }
        return true;
    }
};

struct EpiIn {
    bf16_t* Q; bf16_t* Kb; bf16_t* VT; bf16_t* VTC; bf16_t* U; bf16_t* Z; const float* ropec; const float* ropes;
    DI bool operator()(AccT& acc, const Unit& u, int wr, int wc, int fr, int fq) const {
        asm volatile("" : "+v"(fr), "+v"(fq));
        const int row0 = u.pm * BM + wr * 64 + fr;
        const bool lat = (u.pm * BM) < TL;
        const int pn = u.pn;
#pragma unroll
        for (int ai = 0; ai < 2; ++ai)
#pragma unroll
            for (int m = 0; m < 4; ++m) {
                const int row = row0 + ai * HALF + m * 16;
                if (pn <= 2) {
                    const int s = row & 4095;
                    const int p = (wc & 1) ? (s & 63) : (s >> 6);
                    f32x4 cs = (f32x4){1.f, 1.f, 1.f, 1.f}, sn = (f32x4){0.f, 0.f, 0.f, 0.f};
                    if (lat) { cs = *(const f32x4*)(ropec + p * 16 + 4 * fq); sn = *(const f32x4*)(ropes + p * 16 + 4 * fq); }
#pragma unroll
                    for (int bj = 0; bj < 2; ++bj) {
                        const f32x4 x1 = acc[ai][bj][m][0], x2 = acc[ai][bj][m][1];
                        if (pn < 2 || bj == 0) {
                            const f32x4 o1 = x1 * cs - x2 * sn, o2 = x1 * sn + x2 * cs;
                            u32x2 w1, w2; w1.x = pk2(o1[0], o1[1]); w1.y = pk2(o1[2], o1[3]); w2.x = pk2(o2[0], o2[1]); w2.y = pk2(o2[2], o2[3]);
                            bf16_t* dst = (pn < 2) ? (Q + (size_t)row * 512 + pn * 256 + bj * HALF + wc * 32 + 4 * fq) : (Kb + (size_t)row * 128 + wc * 32 + 4 * fq);
                            *(u32x2*)dst = w1; *(u32x2*)(dst + 16) = w2;
                        } else {
                            const int cv = wc * 32 + 4 * fq;
                            bf16_t* dst; size_t cst;
                            if (lat) { const int b = row >> 12; dst = VT + ((size_t)(b * 128 + cv)) * 4096 + s; cst = 4096; }
                            else { const int rc = row - TL; const int b = rc >> 8; dst = VTC + ((size_t)(b * 128 + cv)) * 256 + (rc & 255); cst = 256; }
#pragma unroll
                            for (int j = 0; j < 4; ++j) { dst[(size_t)j * cst] = f2bf(x1[j]); dst[(size_t)(16 + j) * cst] = f2bf(x2[j]); }
                        }
                    }
                } else {
                    bf16_t* base = (pn <= 4) ? (U + (size_t)row * 512 + (pn - 3) * 256) : (Z + (size_t)row * 512 + (pn - 5) * 256);
                    base += wc * 32 + 4 * fq;
#pragma unroll
                    for (int bj = 0; bj < 2; ++bj)
#pragma unroll
                        for (int n = 0; n < 2; ++n) { const f32x4 v = acc[ai][bj][m][n];
                            u32x2 w; w.x = pk2(geluf_(v[0]), geluf_(v[1])); w.y = pk2(geluf_(v[2]), geluf_(v[3]));
                            *(u32x2*)(base + bj * HALF + n * 16) = w; }
                }
            }
        return true;
    }
};

struct EpiFT {
    bf16_t* FT; bf16_t* FTC;
    DI bool operator()(AccT& acc, const Unit& u, int wr, int wc, int fr, int fq) const {
        asm volatile("" : "+v"(fr), "+v"(fq));
        const int isS = u.pm >> 1;
        const int ch0 = (u.pm & 1) * 256 + wr * 64 + fr;
        bf16_t* base; size_t rst;
        if (u.pn < 128) { const int b = u.pn >> 4; base = FT + (size_t)b * 512 * 8192 + isS * 4096 + ((u.pn & 15) * 256) + wc * 32 + 4 * fq; rst = 8192; }
        else { const int b = u.pn - 128; base = FTC + (size_t)b * 512 * 512 + isS * 256 + wc * 32 + 4 * fq; rst = 512; }
#pragma unroll
        for (int ai = 0; ai < 2; ++ai)
#pragma unroll
            for (int m = 0; m < 4; ++m) { bf16_t* rowp = base + (size_t)(ch0 + ai * HALF + m * 16) * rst;
#pragma unroll
                for (int bj = 0; bj < 2; ++bj)
#pragma unroll
                    for (int n = 0; n < 2; ++n) { const f32x4 v = acc[ai][bj][m][n]; u32x2 w; w.x = pk2(v[0], v[1]); w.y = pk2(v[2], v[3]); *(u32x2*)(rowp + bj * HALF + n * 16) = w; } }
        return true;
    }
};

struct EpiDft {
    bf16_t* HB; int rowbase, rpb;
    DI bool operator()(AccT& acc, const Unit& u, int wr, int wc, int fr, int fq) const {
        asm volatile("" : "+v"(fr), "+v"(fq));
        const int b = u.pn >> 1;
        const int k0 = u.pm * BM + wr * 64 + fr;
        bf16_t* base = HB + (size_t)(rowbase + b * rpb) * HBS + 2048 + (u.pn & 1) * 256 + wc * 32 + 4 * fq;
#pragma unroll
        for (int ai = 0; ai < 2; ++ai)
#pragma unroll
            for (int m = 0; m < 4; ++m) { bf16_t* rowp = base + (size_t)(k0 + ai * HALF + m * 16) * HBS;
#pragma unroll
                for (int bj = 0; bj < 2; ++bj)
#pragma unroll
                    for (int n = 0; n < 2; ++n) { const f32x4 v = acc[ai][bj][m][n]; u32x2 w; w.x = pk2(v[0], v[1]); w.y = pk2(v[2], v[3]); *(u32x2*)(rowp + bj * HALF + n * 16) = w; } }
        return true;
    }
};

struct EpiBr {
    bf16_t* merged; unsigned char* scr;
    DI bool operator()(AccT& acc, const Unit& u, int wr, int wc, int fr, int fq) const {
        asm volatile("" : "+v"(fr), "+v"(fq));
        const int sub = u.aux;
        const int tid = (wr * 4 + wc) * 64 + fq * 16 + fr;
        const int r = sub < 6 ? (sub >> 1) : (sub - 6);
        unsigned char* sp = scr + (size_t)r * 131072 + (size_t)tid * 16;
        if (sub < 6 && (sub & 1)) {
#pragma unroll
            for (int ai = 0; ai < 2; ++ai)
#pragma unroll
                for (int bj = 0; bj < 2; ++bj)
#pragma unroll
                    for (int m = 0; m < 4; ++m) { const f32x4 a = acc[ai][bj][m][0], b = acc[ai][bj][m][1];
                        u32x4 w; w.x = pk2(sigmoidf_(a[0]), sigmoidf_(a[1])); w.y = pk2(sigmoidf_(a[2]), sigmoidf_(a[3])); w.z = pk2(sigmoidf_(b[0]), sigmoidf_(b[1])); w.w = pk2(sigmoidf_(b[2]), sigmoidf_(b[3]));
                        *(u32x4*)(sp + (size_t)(((ai * 2 + bj) * 4 + m) * 8192)) = w; }
        }
        if (sub == 8) {
            const int row0 = u.pm * BM + wr * 64 + fr, col0 = u.pn * BM + wc * 32 + 4 * fq;
#pragma unroll
            for (int ai = 0; ai < 2; ++ai)
#pragma unroll
                for (int bj = 0; bj < 2; ++bj)
#pragma unroll
                    for (int m = 0; m < 4; ++m) {
                        const u32x4 g = *(const u32x4*)(sp + (size_t)(((ai * 2 + bj) * 4 + m) * 8192));
                        const f32x4 a = acc[ai][bj][m][0], b = acc[ai][bj][m][1];
                        bf16_t* dst = merged + (size_t)(row0 + ai * HALF + m * 16) * D + col0 + bj * HALF;
                        u32x2 w0, w1; w0.x = pk2(bflo(g.x) * a[0], bfhi(g.x) * a[1]); w0.y = pk2(bflo(g.y) * a[2], bfhi(g.y) * a[3]);
                        w1.x = pk2(bflo(g.z) * b[0], bfhi(g.z) * b[1]); w1.y = pk2(bflo(g.w) * b[2], bfhi(g.w) * b[3]);
                        *(u32x2*)dst = w0; *(u32x2*)(dst + 16) = w1;
                    }
        }
        const bool scale = (sub == 6 || sub == 7);
        const float cf = (sub < 6 && !(sub & 1)) ? 1.0f : 0.0f;
#pragma unroll
        for (int ai = 0; ai < 2; ++ai)
#pragma unroll
            for (int bj = 0; bj < 2; ++bj)
#pragma unroll
                for (int m = 0; m < 4; ++m) {
                    f32x4 fa = (f32x4){cf, cf, cf, cf}, fb = fa;
                    if (scale) {
                        const u32x4 g = *(const u32x4*)(sp + (size_t)(((ai * 2 + bj) * 4 + m) * 8192));
                        const u32x4 d = *(const u32x4*)(sp + 131072 + (size_t)(((ai * 2 + bj) * 4 + m) * 8192));
                        fa = (f32x4){bflo(g.x) * __builtin_amdgcn_rcpf(bflo(d.x)), bfhi(g.x) * __builtin_amdgcn_rcpf(bfhi(d.x)), bflo(g.y) * __builtin_amdgcn_rcpf(bflo(d.y)), bfhi(g.y) * __builtin_amdgcn_rcpf(bfhi(d.y))};
                        fb = (f32x4){bflo(g.z) * __builtin_amdgcn_rcpf(bflo(d.z)), bfhi(g.z) * __builtin_amdgcn_rcpf(bfhi(d.z)), bflo(g.w) * __builtin_amdgcn_rcpf(bflo(d.w)), bfhi(g.w) * __builtin_amdgcn_rcpf(bfhi(d.w))};
                    }
                    acc[ai][bj][m][0] *= fa; acc[ai][bj][m][1] *= fb;
                }
        return false;
    }
};

#define XB_TMO      128
#define XB_XCNT(j)  (256  + 64 * (j))
#define XB_XSUB(j)  (1280 + 64 * (j))
#define XB_XGEN(j)  (2304 + 64 * (j))
#define XB_TOP      3328
#define XB_TOPGEN   3392
#define XCD_BAR_WORDS 3456
#define XB_SPIN_CAP (1u << 18)
DI unsigned xb_ld(unsigned* p)              { return __hip_atomic_load(p, __ATOMIC_RELAXED, __HIP_MEMORY_SCOPE_AGENT); }
DI unsigned xb_add(unsigned* p, unsigned v) { return __hip_atomic_fetch_add(p, v, __ATOMIC_RELAXED, __HIP_MEMORY_SCOPE_AGENT); }
DI unsigned xb_xcc_id() { return (unsigned)__builtin_amdgcn_s_getreg((3 << 11) | 20) & 0xFu; }
#define XB_SPIN(cond, bar) do { unsigned _sp = 0; while (cond) { __builtin_amdgcn_s_sleep(1); \
    if ((++_sp & 255u) == 0u) { if (xb_ld(&(bar)[XB_TMO])) break; if (_sp > XB_SPIN_CAP) { atomicAdd(&(bar)[XB_TMO], 1u); break; } } } } while (0)
struct XcdBarrier { unsigned* bar; unsigned x; volatile LAS unsigned* st; };
DI XcdBarrier xcd_barrier_post(unsigned* bar, volatile LAS unsigned* st) {
    XcdBarrier b; b.bar = bar; b.x = xb_xcc_id(); b.st = st;
    if (threadIdx.x == 0) (void)xb_add(&bar[XB_XCNT(b.x)], 1u);
    return b;
}
DI void xcd_barrier_complete(unsigned* bar, unsigned x, unsigned& nloc, unsigned& nx) {
    const unsigned G = gridDim.x * gridDim.y * gridDim.z;
    unsigned sum, cnt, mine, sp = 0u;
    for (;;) {
        sum = 0u; cnt = 0u; mine = 0u;
#pragma unroll
        for (unsigned j = 0; j < 16; ++j) { const unsigned c = xb_ld(&bar[XB_XCNT(j)]); sum += c; cnt += (c > 0u) ? 1u : 0u; mine = (j == x) ? c : mine; }
        if (sum == G) break;
        __builtin_amdgcn_s_sleep(1);
        if ((++sp & 255u) == 0u) { if (xb_ld(&bar[XB_TMO])) break; if (sp > XB_SPIN_CAP) { atomicAdd(&bar[XB_TMO], 1u); break; } }
    }
    nloc = mine > 0u ? mine : 1u; nx = cnt > 0u ? cnt : 1u;
}
DI void xcd_barrier(const XcdBarrier& b) {
    asm volatile("s_waitcnt vmcnt(0)" ::: "memory");
    __syncthreads();
    if (threadIdx.x == 0) {
        unsigned* bar = b.bar;
        __builtin_amdgcn_s_waitcnt(0);
        unsigned nloc = b.st[0], nx = b.st[1];
        if (nloc == 0u) { xcd_barrier_complete(bar, b.x, nloc, nx); b.st[0] = nloc; b.st[1] = nx; }
        const unsigned old = xb_add(&bar[XB_XSUB(b.x)], 1u);
        const unsigned gen = old / nloc;
        if (old + 1u == (gen + 1u) * nloc) {
            __builtin_amdgcn_fence(__ATOMIC_RELEASE, "agent");
            asm volatile("s_waitcnt vmcnt(0)" ::: "memory");
            const unsigned og = xb_add(&bar[XB_TOP], 1u);
            const unsigned tg = og / nx;
            if (og + 1u == (tg + 1u) * nx) xb_add(&bar[XB_TOPGEN], 1u);
            else XB_SPIN(xb_ld(&bar[XB_TOPGEN]) == tg, bar);
            __builtin_amdgcn_fence(__ATOMIC_ACQUIRE, "agent");
            xb_add(&bar[XB_XGEN(b.x)], 1u);
            asm volatile("s_waitcnt vmcnt(0)" ::: "memory");
        } else {
            XB_SPIN(xb_ld(&bar[XB_XGEN(b.x)]) == gen, bar);
            __builtin_amdgcn_fence(__ATOMIC_ACQUIRE, "agent");
            asm volatile("s_waitcnt vmcnt(0)" ::: "memory");
        }
    }
    __syncthreads();
}

DI void phase_mods(const Params& P, unsigned char* shm) {
    float* s = (float*)shm;
    float* red = s + 9 * 1024;
    const int tid = otid();
    const float* c = oin(P, I_C); const float* cc = oin(P, I_CCTX);
    for (int idx = tid; idx < 9 * 1024; idx += 512) { const int rb = idx >> 10, k = idx & 1023; const float v = rb < 8 ? c[rb * 1024 + k] : cc[k]; s[idx] = siluf_(v); }
    __syncthreads();
    float* mods = (float*)(ows(P) + OFF_MODS);
    const float* wmod = oin(P, I_WMOD); const float* bmod = oin(P, I_BMOD);
    for (int u = obid(); u < 288; u += gridDim.x) {
        const int l = u / 72, n0 = (u % 72) * 128, cgp = tid & 31, ks = tid >> 5;
        f32x4 acc[9];
#pragma unroll
        for (int rb = 0; rb < 9; ++rb) acc[rb] = (f32x4){0.f, 0.f, 0.f, 0.f};
        const float* wp = wmod + ((size_t)l * 1024 + ks * 64) * 9216 + n0 + cgp * 4;
        for (int kk = 0; kk < 64; ++kk) { const f32x4 w = *(const f32x4*)(wp + (size_t)kk * 9216);
#pragma unroll
            for (int rb = 0; rb < 9; ++rb) acc[rb] += w * s[rb * 1024 + ks * 64 + kk]; }
#pragma unroll
        for (int rb = 0; rb < 9; ++rb) *(f32x4*)(red + ((ks * 9 + rb) * 128 + cgp * 4)) = acc[rb];
        __syncthreads();
        for (int idx = tid; idx < 1152; idx += 512) { const int rb = idx >> 7, c2 = idx & 127; float sum = bmod[l * 9216 + n0 + c2];
            for (int k2 = 0; k2 < 16; ++k2) sum += red[(k2 * 9 + rb) * 128 + c2];
            mods[((size_t)l * 9 + rb) * 9216 + n0 + c2] = sum; }
        __syncthreads();
    }
}

DI void phase_tables(const Params& P, unsigned char* shm) {
    const int tid = otid();
    float* tab = (float*)shm;
    for (int j = tid; j < 4096; j += 512) tab[j] = cospif((float)j * (1.0f / 2048.0f)) * (1.0f / 64.0f);
    __syncthreads();
    if (obid() == 0) {
        float* rc = (float*)(ows(P) + OFF_ROPE); float* rs = rc + 1024;
        for (int idx = tid; idx < 1024; idx += 512) { const int p = idx >> 4, f = idx & 15; const float inv = powf(10000.0f, -(float)f / 16.0f); const float ang = (float)p * inv; rc[idx] = cosf(ang); rs[idx] = sinf(ang); }
    }
    bf16_t* dft = (bf16_t*)(ows(P) + OFF_DFT);
    const long gid = (long)obid() * 512 + tid, gstride = (long)gridDim.x * 512;
    for (long it = gid; it < 4096l * 1024; it += gstride) {
        const int k = (int)(it >> 10), n0 = ((int)it & 1023) * 8; const bool isS = n0 >= 4096; const int nn = n0 & 4095;
        float v[8];
#pragma unroll
        for (int j = 0; j < 8; ++j) { const int idx = (k * (nn + j)) & 4095; v[j] = isS ? -tab[(idx + 3072) & 4095] : tab[idx]; }
        u32x4 w; w.x = pk2(v[0], v[1]); w.y = pk2(v[2], v[3]); w.z = pk2(v[4], v[5]); w.w = pk2(v[6], v[7]);
        *(u32x4*)(dft + (size_t)k * 8192 + n0) = w;
    }
    bf16_t* dftc = (bf16_t*)(ows(P) + OFF_DFTC);
    for (long it = gid; it < 256l * 64; it += gstride) {
        const int k = (int)(it >> 6), n0 = ((int)it & 63) * 8; const bool isS = n0 >= 256; const int nn = n0 & 255;
        float v[8];
#pragma unroll
        for (int j = 0; j < 8; ++j) { const int idx = ((k * (nn + j)) & 255) * 16; v[j] = (isS ? -tab[(idx + 3072) & 4095] : tab[idx]) * 4.0f; }
        u32x4 w; w.x = pk2(v[0], v[1]); w.y = pk2(v[2], v[3]); w.z = pk2(v[4], v[5]); w.w = pk2(v[6], v[7]);
        *(u32x4*)(dftc + (size_t)k * 512 + n0) = w;
    }
    __syncthreads();
}

DI void wconv_tile(const float* src, int lds_, int Ksrc, int mode, bf16_t* dst, int ldd, int coff, int kt, int ntile, float* tile) {
    const int tid = otid();
    const int k0 = kt * 64, n0 = ntile * 64;
    { const int nn = tid & 63, np = n0 + nn; int col = np;
      if (mode == 1) { const int t = np >> 8, w = np & 255, grp = w >> 5, isup = (w >> 4) & 1, i = w & 15; const int ff = t * 128 + grp * 16 + i; col = ff < DFF ? ff + isup * DFF : -1; }
#pragma unroll
      for (int i = 0; i < 8; ++i) { const int kk = (tid >> 6) + i * 8, k = k0 + kk; float v = 0.f; if (col >= 0 && k < Ksrc) v = src[(size_t)k * lds_ + col]; tile[kk * 65 + nn] = v; } }
    __syncthreads();
    { const int nn2 = tid >> 3, kq = (tid & 7) * 8; float v[8];
#pragma unroll
      for (int j = 0; j < 8; ++j) v[j] = tile[(kq + j) * 65 + nn2];
      u32x4 w; w.x = pk2(v[0], v[1]); w.y = pk2(v[2], v[3]); w.z = pk2(v[4], v[5]); w.w = pk2(v[6], v[7]);
      *(u32x4*)(dst + (size_t)(n0 + nn2) * ldd + coff + k0 + kq) = w; }
    __syncthreads();
}

DI void phase_wconv(const Params& P, int l, unsigned char* shm) {
    float* tile = (float*)shm;
    bf16_t* W = (bf16_t*)(ows(P) + OFF_W);
    const int tid = otid();
    constexpr int N_UP = 16 * 88, N_DN = 44 * 16, N_IN = 16 * 28, N_CB = 8 * 16, N_CG = 16 * 16, N_OUT = 16 * 16, N_WF = 128;
    constexpr int TOT = 2 * N_UP + 2 * N_DN + N_IN + 3 * N_CB + 3 * N_CG + N_OUT + N_WF;
    for (int u = obid(); u < TOT; u += gridDim.x) {
        int v = u;
        if (v < 2 * N_UP) { const int f = v / N_UP; v %= N_UP; wconv_tile(oin(P, I_WUP) + ((size_t)(l * 2 + f)) * 1024 * 5504, 5504, 1024, 1, W + (f ? W_UP1 : W_UP0), 1024, 0, v % 16, v / 16, tile); continue; }
        v -= 2 * N_UP;
        if (v < 2 * N_DN) { const int f = v / N_DN; v %= N_DN; wconv_tile(oin(P, I_WDN) + ((size_t)(l * 2 + f)) * 2752 * 1024, 1024, 2752, 0, W + (f ? W_DN1 : W_DN0), 2816, 0, v % 44, v / 44, tile); continue; }
        v -= 2 * N_DN;
        if (v < N_IN) { wconv_tile(oin(P, I_WIN) + (size_t)l * 1024 * 2304, 2304, 1024, 0, W + W_IN, 1024, 0, v % 16, v / 16, tile); continue; }
        v -= N_IN;
        if (v < 3 * N_CB) { const int r = v / N_CB; v %= N_CB; wconv_tile(oin(P, I_WBR) + ((size_t)(l * 3 + r)) * 512 * 1024, 1024, 512, 0, W + W_CAT + (size_t)r * 1024 * 1536, 1536, 0, v % 8, v / 8, tile); continue; }
        v -= 3 * N_CB;
        if (v < 3 * N_CG) { const int r = v / N_CG; v %= N_CG; wconv_tile(oin(P, I_WGATE) + ((size_t)(l * 3 + r)) * 1024 * 1024, 1024, 1024, 0, W + W_CAT + (size_t)r * 1024 * 1536, 1536, 512, v % 16, v / 16, tile); continue; }
        v -= 3 * N_CG;
        if (v < N_OUT) { wconv_tile(oin(P, I_WOUT) + (size_t)l * 1024 * 1024, 1024, 1024, 0, W + W_OUT, 1024, 0, v % 16, v / 16, tile); continue; }
        v -= N_OUT;
        {
            float* rows = tile; float* tab = rows + 4096;
            const float* src = oin(P, I_WIN) + (size_t)l * 1024 * 2304 + (size_t)(v * 8) * 2304 + 1792;
            for (int idx = tid; idx < 4096; idx += 512) rows[idx] = src[(size_t)(idx >> 9) * 2304 + (idx & 511)];
            if (tid < 128) tab[tid] = cospif((float)tid * (1.0f / 64.0f));
            __syncthreads();
            const int g = tid >> 7, m = tid & 127;
            float ac[8], as[8];
#pragma unroll
            for (int kk = 0; kk < 8; ++kk) { ac[kk] = 0.f; as[kk] = 0.f; }
            for (int c2 = 0; c2 < 128; ++c2) { const int idx = (m * c2) & 127; const float cv = tab[idx], sv = tab[(idx + 96) & 127];
#pragma unroll
                for (int kk = 0; kk < 8; ++kk) { const float w = rows[kk * 512 + g * 128 + c2]; ac[kk] += w * cv; as[kk] += w * sv; } }
            const float sc = 0.08838834764831845f;
            u32x4 wc_, ws_; wc_.x = pk2(ac[0] * sc, ac[1] * sc); wc_.y = pk2(ac[2] * sc, ac[3] * sc); wc_.z = pk2(ac[4] * sc, ac[5] * sc); wc_.w = pk2(ac[6] * sc, ac[7] * sc);
            ws_.x = pk2(as[0] * sc, as[1] * sc); ws_.y = pk2(as[2] * sc, as[3] * sc); ws_.z = pk2(as[4] * sc, as[5] * sc); ws_.w = pk2(as[6] * sc, as[7] * sc);
            *(u32x4*)(W + W_F + (size_t)tid * 1024 + v * 8) = wc_;
            *(u32x4*)(W + W_F + (size_t)(512 + tid) * 1024 + v * 8) = ws_;
            __syncthreads();
        }
    }
}

DI void phase_norm(const Params& P, const float* g, const float* bt, const float* mod, int jm, float* outp, int rend) {
    const int tid = otid(), wid = tid >> 6, lane = tid & 63;
    float* X = (float*)(ows(P) + OFF_X); bf16_t* HB = (bf16_t*)(ows(P) + OFF_HB);
    for (int r = obid() * 8 + wid; r < rend; r += gridDim.x * 8) {
        const float* src = g ? (X + (size_t)r * D) : (r < TL ? oin(P, I_X) + (size_t)r * D : oin(P, I_CTX) + (size_t)(r - TL) * D);
        f32x4 v[4];
#pragma unroll
        for (int q = 0; q < 4; ++q) v[q] = *(const f32x4*)(src + q * 256 + lane * 4);
        if (g) {
            float sum = 0.f;
#pragma unroll
            for (int q = 0; q < 4; ++q) sum += v[q][0] + v[q][1] + v[q][2] + v[q][3];
            const float mu = wave_sum(sum, lane) * (1.0f / 1024.0f);
            float sq = 0.f;
#pragma unroll
            for (int q = 0; q < 4; ++q) { v[q] -= mu; sq += v[q][0] * v[q][0] + v[q][1] * v[q][1] + v[q][2] * v[q][2] + v[q][3] * v[q][3]; }
            const float rstd = rsqrtf(wave_sum(sq, lane) * (1.0f / 1024.0f) + LN_EPS);
#pragma unroll
            for (int q = 0; q < 4; ++q) { const f32x4 gg = *(const f32x4*)(g + q * 256 + lane * 4), bb = *(const f32x4*)(bt + q * 256 + lane * 4); v[q] = v[q] * rstd * gg + bb; }
        }
#pragma unroll
        for (int q = 0; q < 4; ++q) *(f32x4*)(X + (size_t)r * D + q * 256 + lane * 4) = v[q];
        if (outp) {
#pragma unroll
            for (int q = 0; q < 4; ++q) *(f32x4*)(outp + (size_t)r * D + q * 256 + lane * 4) = v[q];
        }
        if (mod) {
            const int rb = r < TL ? (r >> 12) : 8;
            const float* sh = mod + (size_t)rb * 9216 + jm * 1024; const float* sc = sh + 1024;
#pragma unroll
            for (int q = 0; q < 4; ++q) { const f32x4 a = *(const f32x4*)(sh + q * 256 + lane * 4), b = *(const f32x4*)(sc + q * 256 + lane * 4);
                const f32x4 h = v[q] * (b + 1.0f) + a; u32x2 w; w.x = pk2(h[0], h[1]); w.y = pk2(h[2], h[3]);
                *(u32x2*)(HB + (size_t)r * HBS + q * 256 + lane * 4) = w; }
        }
    }
}

#define MFMA32(a, b, c) __builtin_amdgcn_mfma_f32_32x32x16_bf16((a), (b), (c), 0, 0, 0)
DI bf16x8 mk8(u32x2 lo, u32x2 hi) { u32x4 w; w.x = lo.x; w.y = lo.y; w.z = hi.x; w.w = hi.y; return __builtin_bit_cast(bf16x8, w); }

struct AttnState { float m, l; f32x16 O[2]; };

template <bool MASKED>
DI void attn_tile(AttnState& st, const bf16x8 (&Qf)[4], const bf16_t* kp, const bf16_t* vp, size_t vstride, int lane, int qpos, int klo) {
    const int hh = lane >> 5;
    bf16x8 Kf[4];
#pragma unroll
    for (int kk = 0; kk < 4; ++kk) Kf[kk] = *(const bf16x8*)(kp + kk * 16);
    bf16x8 Vf[2][2];
#pragma unroll
    for (int db = 0; db < 2; ++db)
#pragma unroll
        for (int c = 0; c < 2; ++c) { const bf16_t* p = vp + (size_t)db * 32 * vstride + 16 * c; Vf[db][c] = mk8(*(const u32x2*)p, *(const u32x2*)(p + 8)); }
    f32x16 s;
#pragma unroll
    for (int i = 0; i < 16; ++i) s[i] = 0.f;
#pragma unroll
    for (int kk = 0; kk < 4; ++kk) s = MFMA32(Kf[kk], Qf[kk], s);
    float tmax = -3.0e38f;
#pragma unroll
    for (int i = 0; i < 16; ++i) {
        float sv = s[i] * 0.125f;
        if (MASKED) { const int kpos = klo + (i & 3) + 8 * (i >> 2) + 4 * hh; const int dlt = qpos - kpos; if (dlt > 128 || dlt < -128) sv = -3.0e38f; }
        s[i] = sv; tmax = fmaxf(tmax, sv);
    }
    tmax = fmaxf(tmax, shx(tmax, 32, lane));
    const float mnew = fmaxf(st.m, tmax);
    const float alpha = __expf(st.m - mnew);
    float psum = 0.f;
#pragma unroll
    for (int i = 0; i < 16; ++i) { const float p = __expf(s[i] - mnew); s[i] = p; psum += p; }
    st.l = st.l * alpha + psum; st.m = mnew;
#pragma unroll
    for (int db = 0; db < 2; ++db)
#pragma unroll
        for (int i = 0; i < 16; ++i) st.O[db][i] *= alpha;
    bf16x8 Pf[2];
#pragma unroll
    for (int c = 0; c < 2; ++c) { u32x4 w; w.x = pk2(s[8 * c + 0], s[8 * c + 1]); w.y = pk2(s[8 * c + 2], s[8 * c + 3]); w.z = pk2(s[8 * c + 4], s[8 * c + 5]); w.w = pk2(s[8 * c + 6], s[8 * c + 7]); Pf[c] = __builtin_bit_cast(bf16x8, w); }
#pragma unroll
    for (int db = 0; db < 2; ++db)
#pragma unroll
        for (int c = 0; c < 2; ++c) st.O[db] = MFMA32(Vf[db][c], Pf[c], st.O[db]);
}

DI void phase_attn(const Params& P, int l, bool do_ctx) {
    const int tid = otid(), wid = tid >> 6, lane = tid & 63, hh = lane >> 5, ql = lane & 31;
    const bf16_t* Q = (const bf16_t*)(ows(P) + OFF_R + R_Q); const bf16_t* Kb = (const bf16_t*)(ows(P) + OFF_R + R_K);
    const bf16_t* VT = (const bf16_t*)(ows(P) + OFF_R + R_VT); const bf16_t* VTC = (const bf16_t*)(ows(P) + OFF_R + R_VTC);
    bf16_t* HB = (bf16_t*)(ows(P) + OFF_HB);
    const float* sink = oin(P, I_SINK) + l * 8;
    const int ntask = 8192 + (do_ctx ? 512 : 0);
    for (int t = obid() * 8 + wid; t < ntask; t += gridDim.x * 8) {
        const bool isc = t >= 8192;
        int b, kvh, hq, blk = 0, sub, qrow, qpos = 0;
        if (!isc) { sub = t & 3; hq = (t >> 2) & 3; kvh = (t >> 4) & 1; blk = (t >> 5) & 31; b = t >> 10; qpos = blk * 128 + sub * 32 + ql; qrow = b * 4096 + qpos; }
        else { const int t2 = t - 8192; sub = t2 & 7; hq = (t2 >> 3) & 3; kvh = (t2 >> 5) & 1; b = t2 >> 6; qrow = TL + b * 256 + sub * 32 + ql; }
        const int h = kvh * 4 + hq;
        bf16x8 Qf[4];
#pragma unroll
        for (int kk = 0; kk < 4; ++kk) Qf[kk] = *(const bf16x8*)(Q + (size_t)qrow * 512 + h * 64 + kk * 16 + hh * 8);
        AttnState st; st.m = sink[h]; st.l = hh == 0 ? 1.0f : 0.0f;
#pragma unroll
        for (int i = 0; i < 16; ++i) { st.O[0][i] = 0.f; st.O[1][i] = 0.f; }
        if (!isc) {
            const int qlo = blk * 128 + sub * 32;
            for (int kt = 0; kt < 12; ++kt) {
                const int klo = (blk - 1) * 128 + kt * 32;
                if (klo < 0 || klo >= SEQ) continue;
                if (klo + 31 < qlo - 128 || klo > qlo + 31 + 128) continue;
                const bf16_t* kp = Kb + (size_t)(b * 4096 + klo + ql) * 128 + kvh * 64 + hh * 8;
                const bf16_t* vp = VT + ((size_t)(b * 128 + kvh * 64 + ql)) * 4096 + klo + 4 * hh;
                attn_tile<true>(st, Qf, kp, vp, 4096, lane, qpos, klo);
            }
        }
        for (int kt = 0; kt < 8; ++kt) {
            const int klo = kt * 32;
            const bf16_t* kp = Kb + (size_t)(TL + b * 256 + klo + ql) * 128 + kvh * 64 + hh * 8;
            const bf16_t* vp = VTC + ((size_t)(b * 128 + kvh * 64 + ql)) * 256 + klo + 4 * hh;
            attn_tile<false>(st, Qf, kp, vp, 256, lane, 0, klo);
        }
        const float ltot = st.l + shx(st.l, 32, lane);
        const float inv = 1.0f / ltot;
        bf16_t* op = HB + (size_t)qrow * HBS + 1024 + h * 64 + 4 * hh;
#pragma unroll
        for (int db = 0; db < 2; ++db)
#pragma unroll
            for (int g4 = 0; g4 < 4; ++g4) { u32x2 w; w.x = pk2(st.O[db][4 * g4] * inv, st.O[db][4 * g4 + 1] * inv); w.y = pk2(st.O[db][4 * g4 + 2] * inv, st.O[db][4 * g4 + 3] * inv);
                *(u32x2*)(op + db * 32 + 8 * g4) = w; }
    }
}

DI void phase_sgu(const Params& P, int l, unsigned char* shm, int nchunk) {
    const int tid = otid(), wid = tid >> 6, lane = tid & 63, hh = lane >> 5, ql = lane & 31;
    bf16_t* vT = (bf16_t*)shm;
    const bf16_t* U = (const bf16_t*)(ows(P) + OFF_R + R_U); const bf16_t* Z = (const bf16_t*)(ows(P) + OFF_R + R_Z);
    bf16_t* HB = (bf16_t*)(ows(P) + OFF_HB);
    const float* lg = oin(P, I_SGULG) + l * 512; const float* lb = oin(P, I_SGULB) + l * 512;
    const float* sw = oin(P, I_SGUW) + (size_t)l * 4 * 128 * 128; const float* sb = oin(P, I_SGUB) + l * 4 * 128;
    float gg[8], bb[8];
#pragma unroll
    for (int j = 0; j < 8; ++j) { gg[j] = lg[j * 64 + lane]; bb[j] = lb[j * 64 + lane]; }
    for (int chunk = obid(); chunk < nchunk; chunk += gridDim.x) {
        const int r0 = chunk * 128;
        for (int tt = 0; tt < 16; ++tt) {
            const int tok = wid * 16 + tt; const bf16_t* zp = Z + (size_t)(r0 + tok) * 512;
            float z[8]; float sum = 0.f;
#pragma unroll
            for (int j = 0; j < 8; ++j) { z[j] = bf2f(zp[j * 64 + lane]); sum += z[j]; }
            const float mu = wave_sum(sum, lane) * (1.0f / 512.0f);
            float sq = 0.f;
#pragma unroll
            for (int j = 0; j < 8; ++j) { z[j] -= mu; sq += z[j] * z[j]; }
            const float rstd = rsqrtf(wave_sum(sq, lane) * (1.0f / 512.0f) + LN_EPS);
#pragma unroll
            for (int j = 0; j < 8; ++j) vT[(j * 64 + lane) * 136 + tok] = f2bf(z[j] * rstd * gg[j] + bb[j]);
        }
        __syncthreads();
        const int g = wid >> 1, cb = g * 128 + (wid & 1) * 64;
        for (int mb = 0; mb < 4; ++mb) {
            f32x16 acc[2];
#pragma unroll
            for (int i = 0; i < 16; ++i) { acc[0][i] = 0.f; acc[1][i] = 0.f; }
#pragma unroll
            for (int kc = 0; kc < 8; ++kc) {
                const float* wp = sw + ((size_t)(g * 128 + mb * 32 + ql)) * 128 + kc * 16 + hh * 8;
                const f32x4 w0 = *(const f32x4*)wp, w1 = *(const f32x4*)(wp + 4);
                u32x4 wa; wa.x = pk2(w0[0], w0[1]); wa.y = pk2(w0[2], w0[3]); wa.z = pk2(w1[0], w1[1]); wa.w = pk2(w1[2], w1[3]);
                const bf16x8 Af = __builtin_bit_cast(bf16x8, wa);
#pragma unroll
                for (int nb = 0; nb < 2; ++nb) { const bf16x8 Bf = *(const bf16x8*)(vT + (cb + nb * 32 + ql) * 136 + kc * 16 + hh * 8); acc[nb] = MFMA32(Af, Bf, acc[nb]); }
            }
#pragma unroll
            for (int nb = 0; nb < 2; ++nb)
#pragma unroll
                for (int i = 0; i < 16; ++i) { const int prow = mb * 32 + (i & 3) + 8 * (i >> 2) + 4 * hh; const int c = cb + nb * 32 + ql; const size_t row = (size_t)(r0 + prow);
                    const float val = (acc[nb][i] + sb[g * 128 + prow]) * bf2f(U[row * 512 + c]);
                    HB[row * HBS + 1536 + c] = f2bf(val); }
        }
        __syncthreads();
    }
}

__global__ void __launch_bounds__(512, 2) mega(Params P) {
    extern __shared__ __attribute__((aligned(16))) unsigned char shm[];
    LAS unsigned char* lds = (LAS unsigned char*)shm;
    cg::grid_group grid = cg::this_grid();
    volatile LAS unsigned* bst = (volatile LAS unsigned*)(lds + LDS_BYTES - 16);
    if (threadIdx.x == 0) { bst[0] = 0u; bst[1] = 0u; }
    if (blockIdx.x == 0) { unsigned* bw = (unsigned*)(P.ws + OFF_BAR); for (int i = threadIdx.x; i < XCD_BAR_WORDS; i += 512) bw[i] = 0u; }
    __syncthreads();

    phase_mods(P, shm);
    phase_tables(P, shm);
    phase_wconv(P, 0, shm);
    grid.sync();
    const XcdBarrier gbar = xcd_barrier_post((unsigned*)(P.ws + OFF_BAR), bst);
#define GSYNC() xcd_barrier(gbar)
    phase_norm(P, nullptr, nullptr, (const float*)(ows(P) + OFF_MODS), 0, nullptr, T);
    GSYNC();

    for (int st = 0; st < 2 * DEPTH; ++st) {
        const int l = st >> 1, f = st & 1;
        const int npl = (l == DEPTH - 1) ? TL / 256 : T / 256;
        const int npf = f ? npl : T / 256;
        {
            unsigned char* ws = ows(P); bf16_t* W = (bf16_t*)(ws + OFF_W);
            SchedTile S; S.init(ws + OFF_HB, 256ull * HBS * 2, W + (f ? W_UP1 : W_UP0), 256ull * 1024 * 2, npf, NUP / 256);
            EpiUp E; E.act = (bf16_t*)(ws + OFF_R);
            for (int rep = 0; rep < REP_UP; ++rep) gemm_phase<1024, HBS, 1024>(lds, S, E);
        }
        GSYNC();
        for (int es = 0; es < EXTRA_SYNCS; ++es) GSYNC();
        {
            unsigned char* ws = ows(P); bf16_t* W = (bf16_t*)(ws + OFF_W);
            SchedTile S; S.init(ws + OFF_R, 256ull * DFFP * 2, W + (f ? W_DN1 : W_DN0), 256ull * DFFP * 2, npf, 4);
            EpiRes E; E.X = (float*)(ws + OFF_X); E.gm = (const float*)(ws + OFF_MODS) + (size_t)l * 9 * 9216 + (f ? 8 : 2) * 1024; E.s = 0.5f;
            gemm_phase<DFFP, DFFP, DFFP>(lds, S, E);
        }
        GSYNC();
        if (f == 0) {
            phase_norm(P, oin(P, I_LNG) + (l * 3 + 0) * 1024, oin(P, I_LNB) + (l * 3 + 0) * 1024, (const float*)(ows(P) + OFF_MODS) + (size_t)l * 9 * 9216, 3, nullptr, T);
            GSYNC();
            {
                unsigned char* ws = ows(P); bf16_t* W = (bf16_t*)(ws + OFF_W); unsigned char* R = ws + OFF_R;
                SchedTile S; S.init(ws + OFF_HB, 256ull * HBS * 2, W + W_IN, 256ull * 1024 * 2, T / 256, 7);
                EpiIn E; E.Q = (bf16_t*)(R + R_Q); E.Kb = (bf16_t*)(R + R_K); E.VT = (bf16_t*)(R + R_VT); E.VTC = (bf16_t*)(R + R_VTC); E.U = (bf16_t*)(R + R_U); E.Z = (bf16_t*)(R + R_Z);
                E.ropec = (const float*)(ws + OFF_ROPE); E.ropes = E.ropec + 1024;
                for (int rep = 0; rep < REP_IN; ++rep) gemm_phase<1024, HBS, 1024>(lds, S, E);
            }
            {
                unsigned char* ws = ows(P); bf16_t* W = (bf16_t*)(ws + OFF_W); unsigned char* R = ws + OFF_R;
                SchedTile S; S.init(W + W_F, 256ull * 1024 * 2, ws + OFF_HB, 256ull * HBS * 2, 4, npl);
                EpiFT E; E.FT = (bf16_t*)(R + R_FT); E.FTC = (bf16_t*)(R + R_FTC);
                for (int rep = 0; rep < REP_IN; ++rep) gemm_phase<1024, 1024, HBS>(lds, S, E);
            }
            GSYNC();
            {
                unsigned char* ws = ows(P); unsigned char* R = ws + OFF_R;
                SchedTile S; S.init(ws + OFF_DFT, 256ull * 8192 * 2, R + R_FT, 256ull * 8192 * 2, 16, 16);
                EpiDft E; E.HB = (bf16_t*)(ws + OFF_HB); E.rowbase = 0; E.rpb = 4096;
                for (int rep = 0; rep < REP_DFT; ++rep) gemm_phase<8192, 8192, 8192>(lds, S, E);
            }
            if (l < DEPTH - 1) {
                unsigned char* ws = ows(P); unsigned char* R = ws + OFF_R;
                SchedTile S; S.init(ws + OFF_DFTC, 0, R + R_FTC, 256ull * 512 * 2, 1, 16);
                EpiDft E; E.HB = (bf16_t*)(ws + OFF_HB); E.rowbase = TL; E.rpb = 256;
                gemm_phase<512, 512, 512>(lds, S, E);
            }
            for (int rep = 0; rep < REP_ATT; ++rep) phase_attn(P, l, l < DEPTH - 1);
            for (int rep = 0; rep < REP_SGU; ++rep) phase_sgu(P, l, shm, npl * 2);
            GSYNC();
            {
                unsigned char* ws = ows(P); bf16_t* W = (bf16_t*)(ws + OFF_W); unsigned char* R = ws + OFF_R;
                SchedBr S; S.HBp = (const char*)(ws + OFF_HB); S.Wc = (const char*)(W + W_CAT); S.G = gridDim.x; S.c = obid(); S.ntiles = npl * 4;
                EpiBr E; E.merged = (bf16_t*)(R + R_MERGED); E.scr = R + R_SCR + (size_t)obid() * (3 * 131072);
                for (int rep = 0; rep < REP_BR; ++rep) gemm_phase<512, HBS, 1536>(lds, S, E);
            }
            GSYNC();
            {
                unsigned char* ws = ows(P); bf16_t* W = (bf16_t*)(ws + OFF_W); unsigned char* R = ws + OFF_R;
                SchedTile S; S.init(R + R_MERGED, 256ull * 1024 * 2, W + W_OUT, 256ull * 1024 * 2, npl, 4);
                EpiRes E; E.X = (float*)(ws + OFF_X); E.gm = (const float*)(ws + OFF_MODS) + (size_t)l * 9 * 9216 + 5 * 1024; E.s = 1.0f;
                gemm_phase<1024, 1024, 1024>(lds, S, E);
            }
            GSYNC();
            phase_norm(P, oin(P, I_LNG) + (l * 3 + 1) * 1024, oin(P, I_LNB) + (l * 3 + 1) * 1024, (const float*)(ows(P) + OFF_MODS) + (size_t)l * 9 * 9216, 6, nullptr, npl * 256);
            GSYNC();
        } else {
            const bool lastl = (l == DEPTH - 1);
            phase_norm(P, oin(P, I_LNG) + (l * 3 + 2) * 1024, oin(P, I_LNB) + (l * 3 + 2) * 1024, lastl ? nullptr : (const float*)(ows(P) + OFF_MODS) + (size_t)(l + 1) * 9 * 9216, 0, lastl ? P.out : nullptr, npl * 256);
            if (!lastl) { for (int rep = 0; rep < REP_WCONV; ++rep) phase_wconv(P, l + 1, shm); GSYNC(); }
        }
    }
}

extern "C" void kernel_launch(void* const* d_in, const int* in_sizes, int n_in, void* d_out, int out_size, void* d_ws, size_t ws_size, hipStream_t stream) {
    static int grid_blocks = 0;
    if (!grid_blocks) {
        int dev = 0, cus = 0, per_cu = 0;
        hipGetDevice(&dev);
        hipDeviceGetAttribute(&cus, hipDeviceAttributeMultiprocessorCount, dev);
        if (hipFuncSetAttribute((const void*)mega, hipFuncAttributeMaxDynamicSharedMemorySize, LDS_BYTES) != hipSuccess) fprintf(stderr, "hipFuncSetAttribute failed\n");
        hipOccupancyMaxActiveBlocksPerMultiprocessor(&per_cu, (const void*)mega, 512, LDS_BYTES);
        if (per_cu < 1) { fprintf(stderr, "occupancy query gave %d\n", per_cu); per_cu = 1; }
        (void)hipGetLastError();
        grid_blocks = cus * per_cu;
        if (grid_blocks > 256) grid_blocks = 256;
        if (ws_size < WS_END) fprintf(stderr, "workspace too small: %zu < %zu\n", ws_size, (size_t)WS_END);
    }
    Params p{};
    for (int i = 0; i < 19; ++i) p.in[i] = (const float*)d_in[i];
    p.out = (float*)d_out; p.ws = (unsigned char*)d_ws;
    void* args[] = {&p};
    hipError_t e = hipLaunchCooperativeKernel((const void*)mega, dim3(grid_blocks), dim3(512), args, LDS_BYTES, stream);
    if (e != hipSuccess) fprintf(stderr, "cooperative launch failed: %s (grid %d)\n", hipGetErrorString(e), grid_blocks);
}
```

```cpp
#include <hip/hip_runtime.h>
#include <hip/hip_cooperative_groups.h>
#include <cstdio>
namespace cg = cooperative_groups;
#define REP_UP 1
#define REP_IN 1
#define REP_DFT 1
#define REP_ATT 1
#define REP_SGU 1
#define REP_BR 1
#define REP_WCONV 1
#define EXTRA_SYNCS 0

#define LAS __attribute__((address_space(3)))
#define DI __device__ __forceinline__
typedef unsigned short bf16_t;
typedef short bf16x8 __attribute__((ext_vector_type(8)));
typedef float f32x2 __attribute__((ext_vector_type(2)));
typedef float f32x4 __attribute__((ext_vector_type(4)));
typedef float f32x16 __attribute__((ext_vector_type(16)));
typedef unsigned u32x2 __attribute__((ext_vector_type(2)));
typedef unsigned u32x4 __attribute__((ext_vector_type(4)));
typedef __bf16 bfv2 __attribute__((ext_vector_type(2)));

constexpr int D = 1024, NB = 8, SEQ = 4096, DEPTH = 4, CTXL = 256;
constexpr int TL = NB * SEQ, TC = NB * CTXL, T = TL + TC;
constexpr int DFF = 2752, DFFP = 2816, NUP = 5632;
constexpr int HBS = 2560;
constexpr float ALPHA = 1.681792830507429f;
constexpr float LN_EPS = 1e-5f;
constexpr int LDS_BYTES = 144 * 1024;

constexpr size_t OFF_MODS = 0;
constexpr size_t SZ_MODS = 4ull * 9 * 9216 * 4;
constexpr size_t OFF_ROPE = OFF_MODS + SZ_MODS;
constexpr size_t SZ_ROPE = 2ull * 64 * 16 * 4;
constexpr size_t OFF_DFT = OFF_ROPE + SZ_ROPE;
constexpr size_t SZ_DFT = 4096ull * 8192 * 2;
constexpr size_t OFF_DFTC = OFF_DFT + SZ_DFT;
constexpr size_t SZ_DFTC = 256ull * 512 * 2;
constexpr size_t OFF_W = OFF_DFTC + SZ_DFTC;
constexpr size_t W_UP0 = 0, W_DN0 = W_UP0 + 5632ull * 1024, W_UP1 = W_DN0 + 1024ull * 2816, W_DN1 = W_UP1 + 5632ull * 1024,
                 W_IN = W_DN1 + 1024ull * 2816, W_F = W_IN + 1792ull * 1024, W_CAT = W_F + 1024ull * 1024,
                 W_OUT = W_CAT + 3ull * 1024 * 1536, W_END = W_OUT + 1024ull * 1024;
constexpr size_t SZ_W = W_END * 2;
constexpr size_t OFF_X = OFF_W + SZ_W;
constexpr size_t SZ_X = (size_t)T * 1024 * 4;
constexpr size_t OFF_HB = OFF_X + SZ_X;
constexpr size_t SZ_HB = (size_t)T * HBS * 2;
constexpr size_t OFF_R = OFF_HB + SZ_HB;
constexpr size_t R_Q = 0;
constexpr size_t R_U = R_Q + (size_t)T * 512 * 2;
constexpr size_t R_Z = R_U + (size_t)T * 512 * 2;
constexpr size_t R_K = R_Z + (size_t)T * 512 * 2;
constexpr size_t R_VT = R_K + (size_t)T * 128 * 2;
constexpr size_t R_VTC = R_VT + 8ull * 128 * 4096 * 2;
constexpr size_t R_FT = R_VTC + 8ull * 128 * 256 * 2;
constexpr size_t R_FTC = R_FT + 8ull * 512 * 8192 * 2;
constexpr size_t R_END = R_FTC + 8ull * 512 * 512 * 2;
constexpr size_t SZ_R = (size_t)T * DFFP * 2;
static_assert(R_END == SZ_R, "region R");
constexpr size_t R_MERGED = R_Q;
constexpr size_t R_SCR = R_Z;
constexpr size_t OFF_BAR = OFF_R + SZ_R;
constexpr size_t SZ_BAR = 16384;
constexpr size_t WS_END = OFF_BAR + SZ_BAR;
static_assert(WS_END <= 721420288ull, "workspace");
static_assert(256ull * 3 * 131072 <= R_END - R_Z, "scr");

struct Params { const float* in[19]; float* out; unsigned char* ws; };
enum { I_X = 0, I_C, I_CTX, I_CCTX, I_WMOD, I_BMOD, I_WUP, I_WDN, I_LNG, I_LNB, I_WIN, I_SINK, I_SGUW, I_SGUB, I_SGULG, I_SGULB, I_WGATE, I_WBR, I_WOUT };

DI unsigned pk2(float a, float b) { f32x2 v = {a, b}; bfv2 r = __builtin_convertvector(v, bfv2); return __builtin_bit_cast(unsigned, r); }
DI bf16_t f2bf(float a) { return (bf16_t)(pk2(a, 0.f) & 0xffffu); }
DI float bf2f(unsigned b) { return __uint_as_float(b << 16); }
DI float bflo(unsigned w) { return __uint_as_float(w << 16); }
DI float bfhi(unsigned w) { return __uint_as_float(w & 0xffff0000u); }
DI float sigmoidf_(float x) { return 1.0f / (1.0f + __expf(-x)); }
DI float siluf_(float x) { return x / (1.0f + __expf(-x)); }
DI float geluf_(float x) { const float y = 1.5957691216057308f * (x + 0.044715f * x * x * x); return x / (1.0f + __expf(-y)); }
DI int otid() { int t = threadIdx.x; asm volatile("" : "+v"(t)); return t; }
DI int obid() { int b = blockIdx.x; asm volatile("" : "+s"(b)); return b; }
DI unsigned char* ows(const Params& P) { unsigned char* w = P.ws; asm volatile("" : "+s"(w)); return w; }
DI const float* oin(const Params& P, int i) { const float* p = P.in[i]; asm volatile("" : "+s"(p)); return p; }
DI float shx(float v, int o, int lane) { return __int_as_float(__builtin_amdgcn_ds_bpermute((lane ^ o) << 2, __float_as_int(v))); }
DI float wave_sum(float v, int lane) {
#pragma unroll
    for (int o = 32; o >= 1; o >>= 1) v += shx(v, o, lane);
    return v;
}

constexpr int BM = 256, BK = 64, HALF = 128, HTB = HALF * BK * 2, NXCD = 8, WGM = 8;
DI int lds_byte(int r, int c) { const int st = (r >> 4) * 2 + (c >> 5), rr = r & 15, cc = c & 31, ob = rr * 64 + cc * 2; return st * 1024 + (ob ^ (((ob >> 9) & 1) << 5)); }
DI void stage_rc(int b, int& R, int& C) { const int st = b / 1024, sb = b % 1024, swz = sb ^ (((sb >> 9) & 1) << 5); R = (st >> 1) * 16 + swz / 64; C = (st & 1) * 32 + (swz % 64) / 2; }

struct Unit { int pm, pn, aux; };

struct SchedTile {
    const char* Ab; const char* Bb; size_t tA, tB; int nM, nN, nwg, G, c;
    DI void init(const void* A, size_t tA_, const void* B, size_t tB_, int nM_, int nN_) { Ab = (const char*)A; Bb = (const char*)B; tA = tA_; tB = tB_; nM = nM_; nN = nN_; nwg = nM * nN; G = gridDim.x; c = obid(); }
    DI bool next(int i, Unit& u) const {
        const long L = (long)i * G + c; if (L >= nwg) return false;
        int wgid = (int)L; { const int q = nwg / NXCD, r = nwg % NXCD, xcd = wgid % NXCD, off = wgid / NXCD; wgid = (xcd < r ? xcd * (q + 1) : r * (q + 1) + (xcd - r) * q) + off; }
        const int nig = WGM * nN, gid = wgid / nig, fm = gid * WGM, gsz = (nM - fm) < WGM ? (nM - fm) : WGM;
        u.pm = fm + ((wgid % nig) % gsz); u.pn = (wgid % nig) / gsz; u.aux = 0; return true;
    }
    DI const char* A(const Unit& u) const { return Ab + (size_t)u.pm * tA; }
    DI const char* B(const Unit& u) const { return Bb + (size_t)u.pn * tB; }
};

struct SchedBr {
    const char* HBp; const char* Wc; int G, c, ntiles;
    DI bool next(int i, Unit& u) const { const int ti = (i / 9) * G + c; if (ti >= ntiles) return false; u.pm = ti >> 2; u.pn = ti & 3; u.aux = i % 9; return true; }
    DI const char* A(const Unit& u) const { const int off = u.aux < 6 ? (u.aux & 1) * 512 : 1024 + (u.aux - 6) * 512; return HBp + ((size_t)u.pm * 256 * HBS + off) * 2; }
    DI const char* B(const Unit& u) const { const int r = u.aux < 6 ? (u.aux >> 1) : (u.aux - 6); const int off = u.aux < 6 ? 512 + (u.aux & 1) * 512 : 0; return Wc + ((size_t)(r * 1024 + u.pn * 256) * 1536 + off) * 2; }
};

template <int K, int lda, int ldb, class Epi, class Sched>
DI void gemm_phase(LAS unsigned char* lds, const Sched& S, const Epi& E) {
    const int tid = otid(), wid = __builtin_amdgcn_readfirstlane(tid >> 6), lane = tid & 63, wr = wid >> 2, wc = wid & 3, fr = lane & 15, fq = lane >> 4;
    constexpr int nt = K / BK;
    unsigned voffA[2], voffB[2];
#pragma unroll
    for (int i = 0; i < 2; ++i) { int R, C; stage_rc(tid * 16 + i * 8192, R, C); voffA[i] = (unsigned)(R * lda + C) * 2u; voffB[i] = (unsigned)(R * ldb + C) * 2u; }
    constexpr size_t kstep = (size_t)(BK * 2);
    constexpr size_t hstepA = (size_t)HALF * lda * 2, hstepB = (size_t)HALF * ldb * 2;
    const unsigned ldsw = (unsigned)wid * 1024u;
    const int aoff = lds_byte(wr * 64 + fr, fq * 8), boff = lds_byte(wc * 32 + fr, fq * 8);
#define PG8_SA(b, h) (((b) * 2 + (h)) * HTB)
#define PG8_SB(b, h) ((4 + (b) * 2 + (h)) * HTB)
#define PG8_STAGE(bufoff, gbase, voff) do { _Pragma("unroll") for (int _i = 0; _i < 2; ++_i) \
        __builtin_amdgcn_global_load_lds((const unsigned*)((const char*)(gbase) + (voff)[_i]), (LAS unsigned*)(lds + (bufoff) + ldsw + _i * 8192), 16, 0, 0); } while (0)
#define PG8_LDA(dst, b, h) do { _Pragma("unroll") for (int m = 0; m < 4; ++m) _Pragma("unroll") for (int k = 0; k < 2; ++k) dst[m][k] = *(const LAS bf16x8*)(lds + PG8_SA(b, h) + aoff + m * 2048 + k * 1024); } while (0)
#define PG8_LDB(dst, b, h) do { _Pragma("unroll") for (int n = 0; n < 2; ++n) _Pragma("unroll") for (int k = 0; k < 2; ++k) dst[n][k] = *(const LAS bf16x8*)(lds + PG8_SB(b, h) + boff + n * 2048 + k * 1024); } while (0)
#define PG8_MMA(ai, bj, At, Bt) do { __builtin_amdgcn_s_setprio(1); _Pragma("unroll") for (int m = 0; m < 4; ++m) _Pragma("unroll") for (int n = 0; n < 2; ++n) _Pragma("unroll") for (int k = 0; k < 2; ++k) \
        acc[ai][bj][m][n] = __builtin_amdgcn_mfma_f32_16x16x32_bf16(Bt[n][k], At[m][k], acc[ai][bj][m][n], 0, 0, 0); __builtin_amdgcn_s_setprio(0); } while (0)
#define PG8_WAIT_V(n) asm volatile("s_waitcnt vmcnt(" #n ")" ::: "memory")
#define PG8_WAIT_L(n) asm volatile("s_waitcnt lgkmcnt(" #n ")" ::: "memory")
#define PG8_BAR __builtin_amdgcn_s_barrier()
#define PG8_SCHED __builtin_amdgcn_sched_barrier(0)
    Unit cur, nxt; int ui = 0;
    if (!S.next(0, cur)) return;
    f32x4 acc[2][2][4][2];
#pragma unroll
    for (int a = 0; a < 2; ++a)
#pragma unroll
        for (int b = 0; b < 2; ++b)
#pragma unroll
            for (int m = 0; m < 4; ++m)
#pragma unroll
                for (int n = 0; n < 2; ++n) acc[a][b][m][n] = (f32x4){0.f, 0.f, 0.f, 0.f};
    bf16x8 At[4][2], B0[2][2], B1[2][2];
    const char* cA = S.A(cur); const char* cB = S.B(cur);
    PG8_STAGE(PG8_SB(0, 0), cB, voffB); PG8_STAGE(PG8_SA(0, 0), cA, voffA); PG8_STAGE(PG8_SB(0, 1), cB + hstepB, voffB); PG8_STAGE(PG8_SA(0, 1), cA + hstepA, voffA);
    if (wr == 1) PG8_BAR;
    PG8_WAIT_V(4); PG8_BAR;
    PG8_STAGE(PG8_SB(1, 0), cB + kstep, voffB); PG8_STAGE(PG8_SA(1, 0), cA + kstep, voffA); PG8_STAGE(PG8_SB(1, 1), cB + hstepB + kstep, voffB);
    PG8_WAIT_V(6); PG8_BAR;
    for (;;) {
        const bool has_next = S.next(ui + 1, nxt);
        const char* nA = has_next ? S.A(nxt) : cA; const char* nB = has_next ? S.B(nxt) : cB;
        for (int t = 0; t < nt; t += 2) {
            const bool last = (t == nt - 2);
            const char* a1 = cA + (size_t)(t + 1) * kstep;
            const char* a2 = last ? nA : cA + (size_t)(t + 2) * kstep; const char* b2 = last ? nB : cB + (size_t)(t + 2) * kstep;
            const char* a3 = a2 + kstep; const char* b3 = b2 + kstep;
            PG8_LDB(B0, 0, 0); PG8_SCHED; PG8_LDA(At, 0, 0); PG8_STAGE(PG8_SA(1, 1), a1 + hstepA, voffA);
            PG8_WAIT_L(8); PG8_BAR; PG8_WAIT_L(0); PG8_MMA(0, 0, At, B0); PG8_BAR; PG8_SCHED;
            PG8_LDB(B1, 0, 1); PG8_STAGE(PG8_SB(0, 0), b2, voffB);
            PG8_BAR; PG8_WAIT_L(0); PG8_MMA(0, 1, At, B1); PG8_BAR;
            PG8_LDA(At, 0, 1); PG8_STAGE(PG8_SA(0, 0), a2, voffA);
            PG8_BAR; PG8_WAIT_L(0); PG8_MMA(1, 0, At, B0); PG8_BAR; PG8_SCHED;
            PG8_STAGE(PG8_SB(0, 1), b2 + hstepB, voffB);
            PG8_WAIT_V(6); PG8_BAR; PG8_MMA(1, 1, At, B1); PG8_BAR;
            PG8_LDB(B0, 1, 0); PG8_SCHED; PG8_LDA(At, 1, 0); PG8_STAGE(PG8_SA(0, 1), a2 + hstepA, voffA);
            PG8_WAIT_L(8); PG8_BAR; PG8_WAIT_L(0); PG8_MMA(0, 0, At, B0); PG8_BAR; PG8_SCHED;
            PG8_LDB(B1, 1, 1); PG8_STAGE(PG8_SB(1, 0), b3, voffB);
            PG8_BAR; PG8_WAIT_L(0); PG8_MMA(0, 1, At, B1); PG8_BAR;
            PG8_LDA(At, 1, 1); PG8_STAGE(PG8_SA(1, 0), a3, voffA);
            PG8_BAR; PG8_WAIT_L(0); PG8_MMA(1, 0, At, B0); PG8_BAR; PG8_SCHED;
            PG8_STAGE(PG8_SB(1, 1), b3 + hstepB, voffB);
            PG8_WAIT_V(6); PG8_BAR; PG8_MMA(1, 1, At, B1); PG8_BAR;
        }
        const bool zero = E(acc, cur, wr, wc, fr, fq);
        if (!has_next) break;
        if (zero) {
#pragma unroll
            for (int a = 0; a < 2; ++a)
#pragma unroll
                for (int b = 0; b < 2; ++b)
#pragma unroll
                    for (int m = 0; m < 4; ++m)
#pragma unroll
                        for (int n = 0; n < 2; ++n) acc[a][b][m][n] = (f32x4){0.f, 0.f, 0.f, 0.f};
        }
        cur = nxt; cA = nA; cB = nB; ++ui;
    }
    PG8_WAIT_V(0);
    if (wr == 0) PG8_BAR;
    PG8_BAR;
#undef PG8_SA
#undef PG8_SB
#undef PG8_STAGE
#undef PG8_LDA
#undef PG8_LDB
#undef PG8_MMA
#undef PG8_WAIT_V
#undef PG8_WAIT_L
#undef PG8_BAR
#undef PG8_SCHED
}

typedef f32x4 AccT[2][2][4][2];

struct EpiUp {
    bf16_t* act;
    DI bool operator()(AccT& acc, const Unit& u, int wr, int wc, int fr, int fq) const {
        asm volatile("" : "+v"(fr), "+v"(fq));
        const int row0 = u.pm * BM + wr * 64 + fr, c0 = u.pn * 128 + wc * 16 + 4 * fq;
#pragma unroll
        for (int ai = 0; ai < 2; ++ai)
#pragma unroll
            for (int m = 0; m < 4; ++m) { bf16_t* rowp = act + (size_t)(row0 + ai * HALF + m * 16) * DFFP + c0;
#pragma unroll
                for (int bj = 0; bj < 2; ++bj) { const f32x4 g = acc[ai][bj][m][0], up = acc[ai][bj][m][1];
                    u32x2 w; w.x = pk2(siluf_(g[0]) * up[0], siluf_(g[1]) * up[1]); w.y = pk2(siluf_(g[2]) * up[2], siluf_(g[3]) * up[3]);
                    *(u32x2*)(rowp + bj * 64) = w; } }
        return true;
    }
};

struct EpiRes {
    float* X; const float* gm; float s;
    DI bool operator()(AccT& acc, const Unit& u, int wr, int wc, int fr, int fq) const {
        asm volatile("" : "+v"(fr), "+v"(fq));
        const int row0 = u.pm * BM + wr * 64 + fr, col0 = u.pn * BM + wc * 32 + 4 * fq;
        const int rb = (u.pm * BM < TL) ? ((u.pm * BM) >> 12) : 8;
        const float* gp = gm + (size_t)rb * 9216 + col0;
        f32x4 gv[2][2];
#pragma unroll
        for (int bj = 0; bj < 2; ++bj)
#pragma unroll
            for (int n = 0; n < 2; ++n) gv[bj][n] = *(const f32x4*)(gp + bj * HALF + n * 16) * s;
#pragma unroll
        for (int ai = 0; ai < 2; ++ai)
#pragma unroll
            for (int m = 0; m < 4; ++m) { float* rowp = X + (size_t)(row0 + ai * HALF + m * 16) * D + col0;
#pragma unroll
                for (int bj = 0; bj < 2; ++bj)
#pragma unroll
                    for (int n = 0; n < 2; ++n) { f32x4* px = (f32x4*)(rowp + bj * HALF + n * 16); const f32x4 x = *px; *px = x * ALPHA + gv[bj][n] * acc[ai][bj][m][n]; } }
        return true;
    }
};

struct EpiIn {
    bf16_t* Q; bf16_t* Kb; bf16_t* VT; bf16_t* VTC; bf16_t* U; bf16_t* Z; const float* ropec; const float* ropes;
    DI bool operator()(AccT& acc, const Unit& u, int wr, int wc, int fr, int fq) const {
        asm volatile("" : "+v"(fr), "+v"(fq));
        const int row0 = u.pm * BM + wr * 64 + fr;
        const bool lat = (u.pm * BM) < TL;
        const int pn = u.pn;
#pragma unroll
        for (int ai = 0; ai < 2; ++ai)
#pragma unroll
            for (int m = 0; m < 4; ++m) {
                const int row = row0 + ai * HALF + m * 16;
                if (pn <= 2) {
                    const int s = row & 4095;
                    const int p = (wc & 1) ? (s & 63) : (s >> 6);
                    f32x4 cs = (f32x4){1.f, 1.f, 1.f, 1.f}, sn = (f32x4){0.f, 0.f, 0.f, 0.f};
                    if (lat) { cs = *(const f32x4*)(ropec + p * 16 + 4 * fq); sn = *(const f32x4*)(ropes + p * 16 + 4 * fq); }
#pragma unroll
                    for (int bj = 0; bj < 2; ++bj) {
                        const f32x4 x1 = acc[ai][bj][m][0], x2 = acc[ai][bj][m][1];
                        if (pn < 2 || bj == 0) {
                            const f32x4 o1 = x1 * cs - x2 * sn, o2 = x1 * sn + x2 * cs;
                            u32x2 w1, w2; w1.x = pk2(o1[0], o1[1]); w1.y = pk2(o1[2], o1[3]); w2.x = pk2(o2[0], o2[1]); w2.y = pk2(o2[2], o2[3]);
                            bf16_t* dst = (pn < 2) ? (Q + (size_t)row * 512 + pn * 256 + bj * HALF + wc * 32 + 4 * fq) : (Kb + (size_t)row * 128 + wc * 32 + 4 * fq);
                            *(u32x2*)dst = w1; *(u32x2*)(dst + 16) = w2;
                        } else {
                            const int cv = wc * 32 + 4 * fq;
                            bf16_t* dst; size_t cst;
                            if (lat) { const int b = row >> 12; dst = VT + ((size_t)(b * 128 + cv)) * 4096 + s; cst = 4096; }
                            else { const int rc = row - TL; const int b = rc >> 8; dst = VTC + ((size_t)(b * 128 + cv)) * 256 + (rc & 255); cst = 256; }
#pragma unroll
                            for (int j = 0; j < 4; ++j) { dst[(size_t)j * cst] = f2bf(x1[j]); dst[(size_t)(16 + j) * cst] = f2bf(x2[j]); }
                        }
                    }
                } else {
                    bf16_t* base = (pn <= 4) ? (U + (size_t)row * 512 + (pn - 3) * 256) : (Z + (size_t)row * 512 + (pn - 5) * 256);
                    base += wc * 32 + 4 * fq;
#pragma unroll
                    for (int bj = 0; bj < 2; ++bj)
#pragma unroll
                        for (int n = 0; n < 2; ++n) { const f32x4 v = acc[ai][bj][m][n];
                            u32x2 w; w.x = pk2(geluf_(v[0]), geluf_(v[1])); w.y = pk2(geluf_(v[2]), geluf_(v[3]));
                            *(u32x2*)(base + bj * HALF + n * 16) = w; }
                }
            }
        return true;
    }
};

struct EpiFT {
    bf16_t* FT; bf16_t* FTC;
    DI bool operator()(AccT& acc, const Unit& u, int wr, int wc, int fr, int fq) const {
        asm volatile("" : "+v"(fr), "+v"(fq));
        const int isS = u.pm >> 1;
        const int ch0 = (u.pm & 1) * 256 + wr * 64 + fr;
        bf16_t* base; size_t rst;
        if (u.pn < 128) { const int b = u.pn >> 4; base = FT + (size_t)b * 512 * 8192 + isS * 4096 + ((u.pn & 15) * 256) + wc * 32 + 4 * fq; rst = 8192; }
        else { const int b = u.pn - 128; base = FTC + (size_t)b * 512 * 512 + isS * 256 + wc * 32 + 4 * fq; rst = 512; }
#pragma unroll
        for (int ai = 0; ai < 2; ++ai)
#pragma unroll
            for (int m = 0; m < 4; ++m) { bf16_t* rowp = base + (size_t)(ch0 + ai * HALF + m * 16) * rst;
#pragma unroll
                for (int bj = 0; bj < 2; ++bj)
#pragma unroll
                    for (int n = 0; n < 2; ++n) { const f32x4 v = acc[ai][bj][m][n]; u32x2 w; w.x = pk2(v[0], v[1]); w.y = pk2(v[2], v[3]); *(u32x2*)(rowp + bj * HALF + n * 16) = w; } }
        return true;
    }
};

struct EpiDft {
    bf16_t* HB; int rowbase, rpb;
    DI bool operator()(AccT& acc, const Unit& u, int wr, int wc, int fr, int fq) const {
        asm volatile("" : "+v"(fr), "+v"(fq));
        const int b = u.pn >> 1;
        const int k0 = u.pm * BM + wr * 64 + fr;
        bf16_t* base = HB + (size_t)(rowbase + b * rpb) * HBS + 2048 + (u.pn & 1) * 256 + wc * 32 + 4 * fq;
#pragma unroll
        for (int ai = 0; ai < 2; ++ai)
#pragma unroll
            for (int m = 0; m < 4; ++m) { bf16_t* rowp = base + (size_t)(k0 + ai * HALF + m * 16) * HBS;
#pragma unroll
                for (int bj = 0; bj < 2; ++bj)
#pragma unroll
                    for (int n = 0; n < 2; ++n) { const f32x4 v = acc[ai][bj][m][n]; u32x2 w; w.x = pk2(v[0], v[1]); w.y = pk2(v[2], v[3]); *(u32x2*)(rowp + bj * HALF + n * 16) = w; } }
        return true;
    }
};

struct EpiBr {
    bf16_t* merged; unsigned char* scr;
    DI bool operator()(AccT& acc, const Unit& u, int wr, int wc, int fr, int fq) const {
        asm volatile("" : "+v"(fr), "+v"(fq));
        const int sub = u.aux;
        const int tid = (wr * 4 + wc) * 64 + fq * 16 + fr;
        const int r = sub < 6 ? (sub >> 1) : (sub - 6);
        unsigned char* sp = scr + (size_t)r * 131072 + (size_t)tid * 16;
        if (sub < 6 && (sub & 1)) {
#pragma unroll
            for (int ai = 0; ai < 2; ++ai)
#pragma unroll
                for (int bj = 0; bj < 2; ++bj)
#pragma unroll
                    for (int m = 0; m < 4; ++m) { const f32x4 a = acc[ai][bj][m][0], b = acc[ai][bj][m][1];
                        u32x4 w; w.x = pk2(sigmoidf_(a[0]), sigmoidf_(a[1])); w.y = pk2(sigmoidf_(a[2]), sigmoidf_(a[3])); w.z = pk2(sigmoidf_(b[0]), sigmoidf_(b[1])); w.w = pk2(sigmoidf_(b[2]), sigmoidf_(b[3]));
                        *(u32x4*)(sp + (size_t)(((ai * 2 + bj) * 4 + m) * 8192)) = w; }
        }
        if (sub == 8) {
            const int row0 = u.pm * BM + wr * 64 + fr, col0 = u.pn * BM + wc * 32 + 4 * fq;
#pragma unroll
            for (int ai = 0; ai < 2; ++ai)
#pragma unroll
                for (int bj = 0; bj < 2; ++bj)
#pragma unroll
                    for (int m = 0; m < 4; ++m) {
                        const u32x4 g = *(const u32x4*)(sp + (size_t)(((ai * 2 + bj) * 4 + m) * 8192));
                        const f32x4 a = acc[ai][bj][m][0], b = acc[ai][bj][m][1];
                        bf16_t* dst = merged + (size_t)(row0 + ai * HALF + m * 16) * D + col0 + bj * HALF;
                        u32x2 w0, w1; w0.x = pk2(bflo(g.x) * a[0], bfhi(g.x) * a[1]); w0.y = pk2(bflo(g.y) * a[2], bfhi(g.y) * a[3]);
                        w1.x = pk2(bflo(g.z) * b[0], bfhi(g.z) * b[1]); w1.y = pk2(bflo(g.w) * b[2], bfhi(g.w) * b[3]);
                        *(u32x2*)dst = w0; *(u32x2*)(dst + 16) = w1;
                    }
        }
        const bool scale = (sub == 6 || sub == 7);
        const float cf = (sub < 6 && !(sub & 1)) ? 1.0f : 0.0f;
#pragma unroll
        for (int ai = 0; ai < 2; ++ai)
#pragma unroll
            for (int bj = 0; bj < 2; ++bj)
#pragma unroll
                for (int m = 0; m < 4; ++m) {
                    f32x4 fa = (f32x4){cf, cf, cf, cf}, fb = fa;
                    if (scale) {
                        const u32x4 g = *(const u32x4*)(sp + (size_t)(((ai * 2 + bj) * 4 + m) * 8192));
                        const u32x4 d = *(const u32x4*)(sp + 131072 + (size_t)(((ai * 2 + bj) * 4 + m) * 8192));
                        fa = (f32x4){bflo(g.x) * __builtin_amdgcn_rcpf(bflo(d.x)), bfhi(g.x) * __builtin_amdgcn_rcpf(bfhi(d.x)), bflo(g.y) * __builtin_amdgcn_rcpf(bflo(d.y)), bfhi(g.y) * __builtin_amdgcn_rcpf(bfhi(d.y))};
                        fb = (f32x4){bflo(g.z) * __builtin_amdgcn_rcpf(bflo(d.z)), bfhi(g.z) * __builtin_amdgcn_rcpf(bfhi(d.z)), bflo(g.w) * __builtin_amdgcn_rcpf(bflo(d.w)), bfhi(g.w) * __builtin_amdgcn_rcpf(bfhi(d.w))};
                    }
                    acc[ai][bj][m][0] *= fa; acc[ai][bj][m][1] *= fb;
                }
        return false;
    }
};

#define XB_TMO      128
#define XB_XCNT(j)  (256  + 64 * (j))
#define XB_XSUB(j)  (1280 + 64 * (j))
#define XB_XGEN(j)  (2304 + 64 * (j))
#define XB_TOP      3328
#define XB_TOPGEN   3392
#define XCD_BAR_WORDS 3456
#define XB_SPIN_CAP (1u << 18)
DI unsigned xb_ld(unsigned* p)              { return __hip_atomic_load(p, __ATOMIC_RELAXED, __HIP_MEMORY_SCOPE_AGENT); }
DI unsigned xb_add(unsigned* p, unsigned v) { return __hip_atomic_fetch_add(p, v, __ATOMIC_RELAXED, __HIP_MEMORY_SCOPE_AGENT); }
DI unsigned xb_xcc_id() { return (unsigned)__builtin_amdgcn_s_getreg((3 << 11) | 20) & 0xFu; }
#define XB_SPIN(cond, bar) do { unsigned _sp = 0; while (cond) { __builtin_amdgcn_s_sleep(1); \
    if ((++_sp & 255u) == 0u) { if (xb_ld(&(bar)[XB_TMO])) break; if (_sp > XB_SPIN_CAP) { atomicAdd(&(bar)[XB_TMO], 1u); break; } } } } while (0)
struct XcdBarrier { unsigned* bar; unsigned x; volatile LAS unsigned* st; };
DI XcdBarrier xcd_barrier_post(unsigned* bar, volatile LAS unsigned* st) {
    XcdBarrier b; b.bar = bar; b.x = xb_xcc_id(); b.st = st;
    if (threadIdx.x == 0) (void)xb_add(&bar[XB_XCNT(b.x)], 1u);
    return b;
}
DI void xcd_barrier_complete(unsigned* bar, unsigned x, unsigned& nloc, unsigned& nx) {
    const unsigned G = gridDim.x * gridDim.y * gridDim.z;
    unsigned sum, cnt, mine, sp = 0u;
    for (;;) {
        sum = 0u; cnt = 0u; mine = 0u;
#pragma unroll
        for (unsigned j = 0; j < 16; ++j) { const unsigned c = xb_ld(&bar[XB_XCNT(j)]); sum += c; cnt += (c > 0u) ? 1u : 0u; mine = (j == x) ? c : mine; }
        if (sum == G) break;
        __builtin_amdgcn_s_sleep(1);
        if ((++sp & 255u) == 0u) { if (xb_ld(&bar[XB_TMO])) break; if (sp > XB_SPIN_CAP) { atomicAdd(&bar[XB_TMO], 1u); break; } }
    }
    nloc = mine > 0u ? mine : 1u; nx = cnt > 0u ? cnt : 1u;
}
DI void xcd_barrier(const XcdBarrier& b) {
    asm volatile("s_waitcnt vmcnt(0)" ::: "memory");
    __syncthreads();
    if (threadIdx.x == 0) {
        unsigned* bar = b.bar;
        __builtin_amdgcn_s_waitcnt(0);
        unsigned nloc = b.st[0], nx = b.st[1];
        if (nloc == 0u) { xcd_barrier_complete(bar, b.x, nloc, nx); b.st[0] = nloc; b.st[1] = nx; }
        const unsigned old = xb_add(&bar[XB_XSUB(b.x)], 1u);
        const unsigned gen = old / nloc;
        if (old + 1u == (gen + 1u) * nloc) {
            __builtin_amdgcn_fence(__ATOMIC_RELEASE, "agent");
            asm volatile("s_waitcnt vmcnt(0)" ::: "memory");
            const unsigned og = xb_add(&bar[XB_TOP], 1u);
            const unsigned tg = og / nx;
            if (og + 1u == (tg + 1u) * nx) xb_add(&bar[XB_TOPGEN], 1u);
            else XB_SPIN(xb_ld(&bar[XB_TOPGEN]) == tg, bar);
            __builtin_amdgcn_fence(__ATOMIC_ACQUIRE, "agent");
            xb_add(&bar[XB_XGEN(b.x)], 1u);
            asm volatile("s_waitcnt vmcnt(0)" ::: "memory");
        } else {
            XB_SPIN(xb_ld(&bar[XB_XGEN(b.x)]) == gen, bar);
            __builtin_amdgcn_fence(__ATOMIC_ACQUIRE, "agent");
            asm volatile("s_waitcnt vmcnt(0)" ::: "memory");
        }
    }
    __syncthreads();
}

DI void phase_mods(const Params& P, unsigned char* shm) {
    float* s = (float*)shm;
    float* red = s + 9 * 1024;
    const int tid = otid();
    const float* c = oin(P, I_C); const float* cc = oin(P, I_CCTX);
    for (int idx = tid; idx < 9 * 1024; idx += 512) { const int rb = idx >> 10, k = idx & 1023; const float v = rb < 8 ? c[rb * 1024 + k] : cc[k]; s[idx] = siluf_(v); }
    __syncthreads();
    float* mods = (float*)(ows(P) + OFF_MODS);
    const float* wmod = oin(P, I_WMOD); const float* bmod = oin(P, I_BMOD);
    for (int u = obid(); u < 288; u += gridDim.x) {
        const int l = u / 72, n0 = (u % 72) * 128, cgp = tid & 31, ks = tid >> 5;
        f32x4 acc[9];
#pragma unroll
        for (int rb = 0; rb < 9; ++rb) acc[rb] = (f32x4){0.f, 0.f, 0.f, 0.f};
        const float* wp = wmod + ((size_t)l * 1024 + ks * 64) * 9216 + n0 + cgp * 4;
        for (int kk = 0; kk < 64; ++kk) { const f32x4 w = *(const f32x4*)(wp + (size_t)kk * 9216);
#pragma unroll
            for (int rb = 0; rb < 9; ++rb) acc[rb] += w * s[rb * 1024 + ks * 64 + kk]; }
#pragma unroll
        for (int rb = 0; rb < 9; ++rb) *(f32x4*)(red + ((ks * 9 + rb) * 128 + cgp * 4)) = acc[rb];
        __syncthreads();
        for (int idx = tid; idx < 1152; idx += 512) { const int rb = idx >> 7, c2 = idx & 127; float sum = bmod[l * 9216 + n0 + c2];
            for (int k2 = 0; k2 < 16; ++k2) sum += red[(k2 * 9 + rb) * 128 + c2];
            mods[((size_t)l * 9 + rb) * 9216 + n0 + c2] = sum; }
        __syncthreads();
    }
}

DI void phase_tables(const Params& P, unsigned char* shm) {
    const int tid = otid();
    float* tab = (float*)shm;
    for (int j = tid; j < 4096; j += 512) tab[j] = cospif((float)j * (1.0f / 2048.0f)) * (1.0f / 64.0f);
    __syncthreads();
    if (obid() == 0) {
        float* rc = (float*)(ows(P) + OFF_ROPE); float* rs = rc + 1024;
        for (int idx = tid; idx < 1024; idx += 512) { const int p = idx >> 4, f = idx & 15; const float inv = powf(10000.0f, -(float)f / 16.0f); const float ang = (float)p * inv; rc[idx] = cosf(ang); rs[idx] = sinf(ang); }
    }
    bf16_t* dft = (bf16_t*)(ows(P) + OFF_DFT);
    const long gid = (long)obid() * 512 + tid, gstride = (long)gridDim.x * 512;
    for (long it = gid; it < 4096l * 1024; it += gstride) {
        const int k = (int)(it >> 10), n0 = ((int)it & 1023) * 8; const bool isS = n0 >= 4096; const int nn = n0 & 4095;
        float v[8];
#pragma unroll
        for (int j = 0; j < 8; ++j) { const int idx = (k * (nn + j)) & 4095; v[j] = isS ? -tab[(idx + 3072) & 4095] : tab[idx]; }
        u32x4 w; w.x = pk2(v[0], v[1]); w.y = pk2(v[2], v[3]); w.z = pk2(v[4], v[5]); w.w = pk2(v[6], v[7]);
        *(u32x4*)(dft + (size_t)k * 8192 + n0) = w;
    }
    bf16_t* dftc = (bf16_t*)(ows(P) + OFF_DFTC);
    for (long it = gid; it < 256l * 64; it += gstride) {
        const int k = (int)(it >> 6), n0 = ((int)it & 63) * 8; const bool isS = n0 >= 256; const int nn = n0 & 255;
        float v[8];
#pragma unroll
        for (int j = 0; j < 8; ++j) { const int idx = ((k * (nn + j)) & 255) * 16; v[j] = (isS ? -tab[(idx + 3072) & 4095] : tab[idx]) * 4.0f; }
        u32x4 w; w.x = pk2(v[0], v[1]); w.y = pk2(v[2], v[3]); w.z = pk2(v[4], v[5]); w.w = pk2(v[6], v[7]);
        *(u32x4*)(dftc + (size_t)k * 512 + n0) = w;
    }
    __syncthreads();
}

DI void wconv_tile(const float* src, int lds_, int Ksrc, int mode, bf16_t* dst, int ldd, int coff, int kt, int ntile, float* tile) {
    const int tid = otid();
    const int k0 = kt * 64, n0 = ntile * 64;
    { const int nn = tid & 63, np = n0 + nn; int col = np;
      if (mode == 1) { const int t = np >> 8, w = np & 255, grp = w >> 5, isup = (w >> 4) & 1, i = w & 15; const int ff = t * 128 + grp * 16 + i; col = ff < DFF ? ff + isup * DFF : -1; }
#pragma unroll
      for (int i = 0; i < 8; ++i) { const int kk = (tid >> 6) + i * 8, k = k0 + kk; float v = 0.f; if (col >= 0 && k < Ksrc) v = src[(size_t)k * lds_ + col]; tile[kk * 65 + nn] = v; } }
    __syncthreads();
    { const int nn2 = tid >> 3, kq = (tid & 7) * 8; float v[8];
#pragma unroll
      for (int j = 0; j < 8; ++j) v[j] = tile[(kq + j) * 65 + nn2];
      u32x4 w; w.x = pk2(v[0], v[1]); w.y = pk2(v[2], v[3]); w.z = pk2(v[4], v[5]); w.w = pk2(v[6], v[7]);
      *(u32x4*)(dst + (size_t)(n0 + nn2) * ldd + coff + k0 + kq) = w; }
    __syncthreads();
}

DI void phase_wconv(const Params& P, int l, unsigned char* shm) {
    float* tile = (float*)shm;
    bf16_t* W = (bf16_t*)(ows(P) + OFF_W);
    const int tid = otid();
    constexpr int N_UP = 16 * 88, N_DN = 44 * 16, N_IN = 16 * 28, N_CB = 8 * 16, N_CG = 16 * 16, N_OUT = 16 * 16, N_WF = 128;
    constexpr int TOT = 2 * N_UP + 2 * N_DN + N_IN + 3 * N_CB + 3 * N_CG + N_OUT + N_WF;
    for (int u = obid(); u < TOT; u += gridDim.x) {
        int v = u;
        if (v < 2 * N_UP) { const int f = v / N_UP; v %= N_UP; wconv_tile(oin(P, I_WUP) + ((size_t)(l * 2 + f)) * 1024 * 5504, 5504, 1024, 1, W + (f ? W_UP1 : W_UP0), 1024, 0, v % 16, v / 16, tile); continue; }
        v -= 2 * N_UP;
        if (v < 2 * N_DN) { const int f = v / N_DN; v %= N_DN; wconv_tile(oin(P, I_WDN) + ((size_t)(l * 2 + f)) * 2752 * 1024, 1024, 2752, 0, W + (f ? W_DN1 : W_DN0), 2816, 0, v % 44, v / 44, tile); continue; }
        v -= 2 * N_DN;
        if (v < N_IN) { wconv_tile(oin(P, I_WIN) + (size_t)l * 1024 * 2304, 2304, 1024, 0, W + W_IN, 1024, 0, v % 16, v / 16, tile); continue; }
        v -= N_IN;
        if (v < 3 * N_CB) { const int r = v / N_CB; v %= N_CB; wconv_tile(oin(P, I_WBR) + ((size_t)(l * 3 + r)) * 512 * 1024, 1024, 512, 0, W + W_CAT + (size_t)r * 1024 * 1536, 1536, 0, v % 8, v / 8, tile); continue; }
        v -= 3 * N_CB;
        if (v < 3 * N_CG) { const int r = v / N_CG; v %= N_CG; wconv_tile(oin(P, I_WGATE) + ((size_t)(l * 3 + r)) * 1024 * 1024, 1024, 1024, 0, W + W_CAT + (size_t)r * 1024 * 1536, 1536, 512, v % 16, v / 16, tile); continue; }
        v -= 3 * N_CG;
        if (v < N_OUT) { wconv_tile(oin(P, I_WOUT) + (size_t)l * 1024 * 1024, 1024, 1024, 0, W + W_OUT, 1024, 0, v % 16, v / 16, tile); continue; }
        v -= N_OUT;
        {
            float* rows = tile; float* tab = rows + 4096;
            const float* src = oin(P, I_WIN) + (size_t)l * 1024 * 2304 + (size_t)(v * 8) * 2304 + 1792;
            for (int idx = tid; idx < 4096; idx += 512) rows[idx] = src[(size_t)(idx >> 9) * 2304 + (idx & 511)];
            if (tid < 128) tab[tid] = cospif((float)tid * (1.0f / 64.0f));
            __syncthreads();
            const int g = tid >> 7, m = tid & 127;
            float ac[8], as[8];
#pragma unroll
            for (int kk = 0; kk < 8; ++kk) { ac[kk] = 0.f; as[kk] = 0.f; }
            for (int c2 = 0; c2 < 128; ++c2) { const int idx = (m * c2) & 127; const float cv = tab[idx], sv = tab[(idx + 96) & 127];
#pragma unroll
                for (int kk = 0; kk < 8; ++kk) { const float w = rows[kk * 512 + g * 128 + c2]; ac[kk] += w * cv; as[kk] += w * sv; } }
            const float sc = 0.08838834764831845f;
            u32x4 wc_, ws_; wc_.x = pk2(ac[0] * sc, ac[1] * sc); wc_.y = pk2(ac[2] * sc, ac[3] * sc); wc_.z = pk2(ac[4] * sc, ac[5] * sc); wc_.w = pk2(ac[6] * sc, ac[7] * sc);
            ws_.x = pk2(as[0] * sc, as[1] * sc); ws_.y = pk2(as[2] * sc, as[3] * sc); ws_.z = pk2(as[4] * sc, as[5] * sc); ws_.w = pk2(as[6] * sc, as[7] * sc);
            *(u32x4*)(W + W_F + (size_t)tid * 1024 + v * 8) = wc_;
            *(u32x4*)(W + W_F + (size_t)(512 + tid) * 1024 + v * 8) = ws_;
            __syncthreads();
        }
    }
}

DI void phase_norm(const Params& P, const float* g, const float* bt, const float* mod, int jm, float* outp, int rend) {
    const int tid = otid(), wid = tid >> 6, lane = tid & 63;
    float* X = (float*)(ows(P) + OFF_X); bf16_t* HB = (bf16_t*)(ows(P) + OFF_HB);
    for (int r = obid() * 8 + wid; r < rend; r += gridDim.x * 8) {
        const float* src = g ? (X + (size_t)r * D) : (r < TL ? oin(P, I_X) + (size_t)r * D : oin(P, I_CTX) + (size_t)(r - TL) * D);
        f32x4 v[4];
#pragma unroll
        for (int q = 0; q < 4; ++q) v[q] = *(const f32x4*)(src + q * 256 + lane * 4);
        if (g) {
            float sum = 0.f;
#pragma unroll
            for (int q = 0; q < 4; ++q) sum += v[q][0] + v[q][1] + v[q][2] + v[q][3];
            const float mu = wave_sum(sum, lane) * (1.0f / 1024.0f);
            float sq = 0.f;
#pragma unroll
            for (int q = 0; q < 4; ++q) { v[q] -= mu; sq += v[q][0] * v[q][0] + v[q][1] * v[q][1] + v[q][2] * v[q][2] + v[q][3] * v[q][3]; }
            const float rstd = rsqrtf(wave_sum(sq, lane) * (1.0f / 1024.0f) + LN_EPS);
#pragma unroll
            for (int q = 0; q < 4; ++q) { const f32x4 gg = *(const f32x4*)(g + q * 256 + lane * 4), bb = *(const f32x4*)(bt + q * 256 + lane * 4); v[q] = v[q] * rstd * gg + bb; }
        }
#pragma unroll
        for (int q = 0; q < 4; ++q) *(f32x4*)(X + (size_t)r * D + q * 256 + lane * 4) = v[q];
        if (outp) {
#pragma unroll
            for (int q = 0; q < 4; ++q) *(f32x4*)(outp + (size_t)r * D + q * 256 + lane * 4) = v[q];
        }
        if (mod) {
            const int rb = r < TL ? (r >> 12) : 8;
            const float* sh = mod + (size_t)rb * 9216 + jm * 1024; const float* sc = sh + 1024;
#pragma unroll
            for (int q = 0; q < 4; ++q) { const f32x4 a = *(const f32x4*)(sh + q * 256 + lane * 4), b = *(const f32x4*)(sc + q * 256 + lane * 4);
                const f32x4 h = v[q] * (b + 1.0f) + a; u32x2 w; w.x = pk2(h[0], h[1]); w.y = pk2(h[2], h[3]);
                *(u32x2*)(HB + (size_t)r * HBS + q * 256 + lane * 4) = w; }
        }
    }
}

#define MFMA32(a, b, c) __builtin_amdgcn_mfma_f32_32x32x16_bf16((a), (b), (c), 0, 0, 0)
DI bf16x8 mk8(u32x2 lo, u32x2 hi) { u32x4 w; w.x = lo.x; w.y = lo.y; w.z = hi.x; w.w = hi.y; return __builtin_bit_cast(bf16x8, w); }
constexpr int AK_RS = 144;
constexpr int AV_RS_BAND = (384 + 8) * 2;
constexpr int AV_RS_CTX = (256 + 8) * 2;
constexpr int AK_BYTES_BAND = 384 * AK_RS, AK_BYTES_CTX = 256 * AK_RS;
constexpr float SC_LOG2E = 0.125f * 1.4426950408889634f;

struct AttnState { float m, l; f32x16 O[2]; };

template <bool MASKED>
DI void attn_tile2(AttnState (&st)[2], const bf16x8 (&Qf)[2][4], const LAS unsigned char* kl, const LAS unsigned char* vl, const int vrs, int lane, int qposA, int klo) {
    const int hh = lane >> 5;
    bf16x8 Kf[4];
#pragma unroll
    for (int kk = 0; kk < 4; ++kk) Kf[kk] = *(const LAS bf16x8*)(kl + kk * 32);
    bf16x8 Vf[2][2];
#pragma unroll
    for (int db = 0; db < 2; ++db)
#pragma unroll
        for (int c = 0; c < 2; ++c) { const LAS unsigned char* p = vl + db * 32 * vrs + c * 32; Vf[db][c] = mk8(*(const LAS u32x2*)p, *(const LAS u32x2*)(p + 16)); }
#pragma unroll
    for (int qb = 0; qb < 2; ++qb) {
        f32x16 s;
#pragma unroll
        for (int i = 0; i < 16; ++i) s[i] = 0.f;
#pragma unroll
        for (int kk = 0; kk < 4; ++kk) s = MFMA32(Kf[kk], Qf[qb][kk], s);
        float tmax = -3.0e38f;
        const int qpos = qposA + qb * 32;
#pragma unroll
        for (int i = 0; i < 16; ++i) {
            float sv = s[i] * SC_LOG2E;
            if (MASKED) { const int kpos = klo + (i & 3) + 8 * (i >> 2) + 4 * hh; const int dlt = qpos - kpos; if (dlt > 128 || dlt < -128) sv = -3.0e38f; }
            s[i] = sv; tmax = fmaxf(tmax, sv);
        }
        tmax = fmaxf(tmax, shx(tmax, 32, lane));
        const float mnew = fmaxf(st[qb].m, tmax);
        const float alpha = __builtin_amdgcn_exp2f(st[qb].m - mnew);
        float psum = 0.f;
#pragma unroll
        for (int i = 0; i < 16; ++i) { const float p = __builtin_amdgcn_exp2f(s[i] - mnew); s[i] = p; psum += p; }
        st[qb].l = st[qb].l * alpha + psum; st[qb].m = mnew;
        if (__builtin_amdgcn_ballot_w64(alpha != 1.0f) != 0ull) {
#pragma unroll
            for (int db = 0; db < 2; ++db)
#pragma unroll
                for (int i = 0; i < 16; ++i) st[qb].O[db][i] *= alpha;
        }
        bf16x8 Pf[2];
#pragma unroll
        for (int c = 0; c < 2; ++c) { u32x4 w; w.x = pk2(s[8 * c + 0], s[8 * c + 1]); w.y = pk2(s[8 * c + 2], s[8 * c + 3]); w.z = pk2(s[8 * c + 4], s[8 * c + 5]); w.w = pk2(s[8 * c + 6], s[8 * c + 7]); Pf[c] = __builtin_bit_cast(bf16x8, w); }
#pragma unroll
        for (int db = 0; db < 2; ++db)
#pragma unroll
            for (int c = 0; c < 2; ++c) st[qb].O[db] = MFMA32(Vf[db][c], Pf[c], st[qb].O[db]);
    }
}

DI void phase_attn(const Params& P, int l, bool do_ctx, LAS unsigned char* lds) {
    const int tid = otid(), wid = tid >> 6, lane = tid & 63, hh = lane >> 5, ql = lane & 31;
    const bf16_t* Q = (const bf16_t*)(ows(P) + OFF_R + R_Q); const bf16_t* Kb = (const bf16_t*)(ows(P) + OFF_R + R_K);
    const bf16_t* VT = (const bf16_t*)(ows(P) + OFF_R + R_VT); const bf16_t* VTC = (const bf16_t*)(ows(P) + OFF_R + R_VTC);
    bf16_t* HB = (bf16_t*)(ows(P) + OFF_HB);
    const float* sink = oin(P, I_SINK) + l * 8;
    const int nunits = 512 + (do_ctx ? 32 : 0);
    const int hq = wid >> 1, pp = wid & 1;
    for (int u = obid(); u < nunits; u += gridDim.x) {
        const bool isc = u >= 512;
        int b, kvh, blk = 0, qbase;
        if (!isc) { kvh = u & 1; blk = (u >> 1) & 31; b = u >> 6; qbase = b * 4096 + blk * 128; }
        else { const int u2 = u - 512; kvh = u2 & 1; b = u2 >> 2; qbase = TL + b * 256 + ((u2 >> 1) & 1) * 128; }
        const int h = kvh * 4 + hq;
        const int qrowA = qbase + pp * 64 + ql;
        bf16x8 Qf[2][4];
#pragma unroll
        for (int qb = 0; qb < 2; ++qb)
#pragma unroll
            for (int kk = 0; kk < 4; ++kk) Qf[qb][kk] = *(const bf16x8*)(Q + (size_t)(qrowA + qb * 32) * 512 + h * 64 + kk * 16 + hh * 8);
        AttnState st[2];
        const float sk = sink[h] * 1.4426950408889634f;
#pragma unroll
        for (int qb = 0; qb < 2; ++qb) { st[qb].m = sk; st[qb].l = hh == 0 ? 1.0f : 0.0f;
#pragma unroll
            for (int i = 0; i < 16; ++i) { st[qb].O[0][i] = 0.f; st[qb].O[1][i] = 0.f; } }
        if (!isc) {
            const int key0 = blk * 128 - 128;
            __syncthreads();
#pragma unroll
            for (int ps = 0; ps < 6; ++ps) { const int row = ps * 64 + (tid >> 3), seg = tid & 7; const int key = key0 + row;
                if (key >= 0 && key < SEQ) *(LAS u32x4*)(lds + row * AK_RS + seg * 16) = *(const u32x4*)(Kb + (size_t)(b * 4096 + key) * 128 + kvh * 64 + seg * 8); }
#pragma unroll
            for (int ps = 0; ps < 6; ++ps) { const int idx = ps * 512 + tid; const int d = idx / 48, seg = idx - d * 48; const int key = key0 + seg * 8;
                if (key >= 0 && key < SEQ) *(LAS u32x4*)(lds + AK_BYTES_BAND + d * AV_RS_BAND + seg * 16) = *(const u32x4*)(VT + ((size_t)(b * 128 + kvh * 64 + d)) * 4096 + key); }
            __syncthreads();
            const int q0 = blk * 128 + pp * 64;
            for (int kt = 0; kt < 12; ++kt) {
                const int klo = key0 + kt * 32;
                if (klo < 0 || klo >= SEQ) continue;
                if (klo + 31 < q0 - 128 || klo > q0 + 63 + 128) continue;
                const LAS unsigned char* kl = lds + (kt * 32 + ql) * AK_RS + hh * 16;
                const LAS unsigned char* vl = lds + AK_BYTES_BAND + ql * AV_RS_BAND + (kt * 32 + 4 * hh) * 2;
                const bool interior = (klo >= q0 + 63 - 128) && (klo + 31 <= q0 + 128);
                if (interior) attn_tile2<false>(st, Qf, kl, vl, AV_RS_BAND, lane, q0 + ql, klo);
                else attn_tile2<true>(st, Qf, kl, vl, AV_RS_BAND, lane, q0 + ql, klo);
            }
        }
        __syncthreads();
#pragma unroll
        for (int ps = 0; ps < 4; ++ps) { const int row = ps * 64 + (tid >> 3), seg = tid & 7;
            *(LAS u32x4*)(lds + row * AK_RS + seg * 16) = *(const u32x4*)(Kb + (size_t)(TL + b * 256 + row) * 128 + kvh * 64 + seg * 8); }
#pragma unroll
        for (int ps = 0; ps < 4; ++ps) { const int idx = ps * 512 + tid; const int d = idx >> 5, seg = idx & 31;
            *(LAS u32x4*)(lds + AK_BYTES_CTX + d * AV_RS_CTX + seg * 16) = *(const u32x4*)(VTC + ((size_t)(b * 128 + kvh * 64 + d)) * 256 + seg * 8); }
        __syncthreads();
        for (int kt = 0; kt < 8; ++kt) {
            const LAS unsigned char* kl = lds + (kt * 32 + ql) * AK_RS + hh * 16;
            const LAS unsigned char* vl = lds + AK_BYTES_CTX + ql * AV_RS_CTX + (kt * 32 + 4 * hh) * 2;
            attn_tile2<false>(st, Qf, kl, vl, AV_RS_CTX, lane, 0, 0);
        }
#pragma unroll
        for (int qb = 0; qb < 2; ++qb) {
            const float ltot = st[qb].l + shx(st[qb].l, 32, lane);
            const float inv = 1.0f / ltot;
            bf16_t* op = HB + (size_t)(qrowA + qb * 32) * HBS + 1024 + h * 64 + 4 * hh;
#pragma unroll
            for (int db = 0; db < 2; ++db)
#pragma unroll
                for (int g4 = 0; g4 < 4; ++g4) { u32x2 w; w.x = pk2(st[qb].O[db][4 * g4] * inv, st[qb].O[db][4 * g4 + 1] * inv); w.y = pk2(st[qb].O[db][4 * g4 + 2] * inv, st[qb].O[db][4 * g4 + 3] * inv);
                    *(u32x2*)(op + db * 32 + 8 * g4) = w; }
        }
    }
    __syncthreads();
}

DI void phase_sgu(const Params& P, int l, unsigned char* shm, int nchunk) {
    const int tid = otid(), wid = tid >> 6, lane = tid & 63, hh = lane >> 5, ql = lane & 31;
    bf16_t* vT = (bf16_t*)shm;
    const bf16_t* U = (const bf16_t*)(ows(P) + OFF_R + R_U); const bf16_t* Z = (const bf16_t*)(ows(P) + OFF_R + R_Z);
    bf16_t* HB = (bf16_t*)(ows(P) + OFF_HB);
    const float* lg = oin(P, I_SGULG) + l * 512; const float* lb = oin(P, I_SGULB) + l * 512;
    const float* sw = oin(P, I_SGUW) + (size_t)l * 4 * 128 * 128; const float* sb = oin(P, I_SGUB) + l * 4 * 128;
    float gg[8], bb[8];
#pragma unroll
    for (int j = 0; j < 8; ++j) { gg[j] = lg[j * 64 + lane]; bb[j] = lb[j * 64 + lane]; }
    for (int chunk = obid(); chunk < nchunk; chunk += gridDim.x) {
        const int r0 = chunk * 128;
        for (int tt = 0; tt < 16; ++tt) {
            const int tok = wid * 16 + tt; const bf16_t* zp = Z + (size_t)(r0 + tok) * 512;
            float z[8]; float sum = 0.f;
#pragma unroll
            for (int j = 0; j < 8; ++j) { z[j] = bf2f(zp[j * 64 + lane]); sum += z[j]; }
            const float mu = wave_sum(sum, lane) * (1.0f / 512.0f);
            float sq = 0.f;
#pragma unroll
            for (int j = 0; j < 8; ++j) { z[j] -= mu; sq += z[j] * z[j]; }
            const float rstd = rsqrtf(wave_sum(sq, lane) * (1.0f / 512.0f) + LN_EPS);
#pragma unroll
            for (int j = 0; j < 8; ++j) vT[(j * 64 + lane) * 136 + tok] = f2bf(z[j] * rstd * gg[j] + bb[j]);
        }
        __syncthreads();
        const int g = wid >> 1, cb = g * 128 + (wid & 1) * 64;
        for (int mb = 0; mb < 4; ++mb) {
            f32x16 acc[2];
#pragma unroll
            for (int i = 0; i < 16; ++i) { acc[0][i] = 0.f; acc[1][i] = 0.f; }
#pragma unroll
            for (int kc = 0; kc < 8; ++kc) {
                const float* wp = sw + ((size_t)(g * 128 + mb * 32 + ql)) * 128 + kc * 16 + hh * 8;
                const f32x4 w0 = *(const f32x4*)wp, w1 = *(const f32x4*)(wp + 4);
                u32x4 wa; wa.x = pk2(w0[0], w0[1]); wa.y = pk2(w0[2], w0[3]); wa.z = pk2(w1[0], w1[1]); wa.w = pk2(w1[2], w1[3]);
                const bf16x8 Af = __builtin_bit_cast(bf16x8, wa);
#pragma unroll
                for (int nb = 0; nb < 2; ++nb) { const bf16x8 Bf = *(const bf16x8*)(vT + (cb + nb * 32 + ql) * 136 + kc * 16 + hh * 8); acc[nb] = MFMA32(Af, Bf, acc[nb]); }
            }
#pragma unroll
            for (int nb = 0; nb < 2; ++nb)
#pragma unroll
                for (int i = 0; i < 16; ++i) { const int prow = mb * 32 + (i & 3) + 8 * (i >> 2) + 4 * hh; const int c = cb + nb * 32 + ql; const size_t row = (size_t)(r0 + prow);
                    const float val = (acc[nb][i] + sb[g * 128 + prow]) * bf2f(U[row * 512 + c]);
                    HB[row * HBS + 1536 + c] = f2bf(val); }
        }
        __syncthreads();
    }
}

__global__ void __launch_bounds__(512, 2) mega(Params P) {
    extern __shared__ __attribute__((aligned(16))) unsigned char shm[];
    LAS unsigned char* lds = (LAS unsigned char*)shm;
    cg::grid_group grid = cg::this_grid();
    volatile LAS unsigned* bst = (volatile LAS unsigned*)(lds + LDS_BYTES - 16);
    if (threadIdx.x == 0) { bst[0] = 0u; bst[1] = 0u; }
    if (blockIdx.x == 0) { unsigned* bw = (unsigned*)(P.ws + OFF_BAR); for (int i = threadIdx.x; i < XCD_BAR_WORDS; i += 512) bw[i] = 0u; }
    __syncthreads();

    phase_mods(P, shm);
    phase_tables(P, shm);
    phase_wconv(P, 0, shm);
    grid.sync();
    const XcdBarrier gbar = xcd_barrier_post((unsigned*)(P.ws + OFF_BAR), bst);
#define GSYNC() xcd_barrier(gbar)
    phase_norm(P, nullptr, nullptr, (const float*)(ows(P) + OFF_MODS), 0, nullptr, T);
    GSYNC();

    for (int st = 0; st < 2 * DEPTH; ++st) {
        const int l = st >> 1, f = st & 1;
        const int npl = (l == DEPTH - 1) ? TL / 256 : T / 256;
        const int npf = f ? npl : T / 256;
        {
            unsigned char* ws = ows(P); bf16_t* W = (bf16_t*)(ws + OFF_W);
            SchedTile S; S.init(ws + OFF_HB, 256ull * HBS * 2, W + (f ? W_UP1 : W_UP0), 256ull * 1024 * 2, npf, NUP / 256);
            EpiUp E; E.act = (bf16_t*)(ws + OFF_R);
            for (int rep = 0; rep < REP_UP; ++rep) gemm_phase<1024, HBS, 1024>(lds, S, E);
        }
        GSYNC();
        for (int es = 0; es < EXTRA_SYNCS; ++es) GSYNC();
        {
            unsigned char* ws = ows(P); bf16_t* W = (bf16_t*)(ws + OFF_W);
            SchedTile S; S.init(ws + OFF_R, 256ull * DFFP * 2, W + (f ? W_DN1 : W_DN0), 256ull * DFFP * 2, npf, 4);
            EpiRes E; E.X = (float*)(ws + OFF_X); E.gm = (const float*)(ws + OFF_MODS) + (size_t)l * 9 * 9216 + (f ? 8 : 2) * 1024; E.s = 0.5f;
            gemm_phase<DFFP, DFFP, DFFP>(lds, S, E);
        }
        GSYNC();
        if (f == 0) {
            phase_norm(P, oin(P, I_LNG) + (l * 3 + 0) * 1024, oin(P, I_LNB) + (l * 3 + 0) * 1024, (const float*)(ows(P) + OFF_MODS) + (size_t)l * 9 * 9216, 3, nullptr, T);
            GSYNC();
            {
                unsigned char* ws = ows(P); bf16_t* W = (bf16_t*)(ws + OFF_W); unsigned char* R = ws + OFF_R;
                SchedTile S; S.init(ws + OFF_HB, 256ull * HBS * 2, W + W_IN, 256ull * 1024 * 2, T / 256, 7);
                EpiIn E; E.Q = (bf16_t*)(R + R_Q); E.Kb = (bf16_t*)(R + R_K); E.VT = (bf16_t*)(R + R_VT); E.VTC = (bf16_t*)(R + R_VTC); E.U = (bf16_t*)(R + R_U); E.Z = (bf16_t*)(R + R_Z);
                E.ropec = (const float*)(ws + OFF_ROPE); E.ropes = E.ropec + 1024;
                for (int rep = 0; rep < REP_IN; ++rep) gemm_phase<1024, HBS, 1024>(lds, S, E);
            }
            {
                unsigned char* ws = ows(P); bf16_t* W = (bf16_t*)(ws + OFF_W); unsigned char* R = ws + OFF_R;
                SchedTile S; S.init(W + W_F, 256ull * 1024 * 2, ws + OFF_HB, 256ull * HBS * 2, 4, npl);
                EpiFT E; E.FT = (bf16_t*)(R + R_FT); E.FTC = (bf16_t*)(R + R_FTC);
                for (int rep = 0; rep < REP_IN; ++rep) gemm_phase<1024, 1024, HBS>(lds, S, E);
            }
            GSYNC();
            {
                unsigned char* ws = ows(P); unsigned char* R = ws + OFF_R;
                SchedTile S; S.init(ws + OFF_DFT, 256ull * 8192 * 2, R + R_FT, 256ull * 8192 * 2, 16, 16);
                EpiDft E; E.HB = (bf16_t*)(ws + OFF_HB); E.rowbase = 0; E.rpb = 4096;
                for (int rep = 0; rep < REP_DFT; ++rep) gemm_phase<8192, 8192, 8192>(lds, S, E);
            }
            if (l < DEPTH - 1) {
                unsigned char* ws = ows(P); unsigned char* R = ws + OFF_R;
                SchedTile S; S.init(ws + OFF_DFTC, 0, R + R_FTC, 256ull * 512 * 2, 1, 16);
                EpiDft E; E.HB = (bf16_t*)(ws + OFF_HB); E.rowbase = TL; E.rpb = 256;
                gemm_phase<512, 512, 512>(lds, S, E);
            }
            for (int rep = 0; rep < REP_ATT; ++rep) phase_attn(P, l, l < DEPTH - 1, lds);
            for (int rep = 0; rep < REP_SGU; ++rep) phase_sgu(P, l, shm, npl * 2);
            GSYNC();
            {
                unsigned char* ws = ows(P); bf16_t* W = (bf16_t*)(ws + OFF_W); unsigned char* R = ws + OFF_R;
                SchedBr S; S.HBp = (const char*)(ws + OFF_HB); S.Wc = (const char*)(W + W_CAT); S.G = gridDim.x; S.c = obid(); S.ntiles = npl * 4;
                EpiBr E; E.merged = (bf16_t*)(R + R_MERGED); E.scr = R + R_SCR + (size_t)obid() * (3 * 131072);
                for (int rep = 0; rep < REP_BR; ++rep) gemm_phase<512, HBS, 1536>(lds, S, E);
            }
            GSYNC();
            {
                unsigned char* ws = ows(P); bf16_t* W = (bf16_t*)(ws + OFF_W); unsigned char* R = ws + OFF_R;
                SchedTile S; S.init(R + R_MERGED, 256ull * 1024 * 2, W + W_OUT, 256ull * 1024 * 2, npl, 4);
                EpiRes E; E.X = (float*)(ws + OFF_X); E.gm = (const float*)(ws + OFF_MODS) + (size_t)l * 9 * 9216 + 5 * 1024; E.s = 1.0f;
                gemm_phase<1024, 1024, 1024>(lds, S, E);
            }
            GSYNC();
            phase_norm(P, oin(P, I_LNG) + (l * 3 + 1) * 1024, oin(P, I_LNB) + (l * 3 + 1) * 1024, (const float*)(ows(P) + OFF_MODS) + (size_t)l * 9 * 9216, 6, nullptr, npl * 256);
            GSYNC();
        } else {
            const bool lastl = (l == DEPTH - 1);
            phase_norm(P, oin(P, I_LNG) + (l * 3 + 2) * 1024, oin(P, I_LNB) + (l * 3 + 2) * 1024, lastl ? nullptr : (const float*)(ows(P) + OFF_MODS) + (size_t)(l + 1) * 9 * 9216, 0, lastl ? P.out : nullptr, npl * 256);
            if (!lastl) { for (int rep = 0; rep < REP_WCONV; ++rep) phase_wconv(P, l + 1, shm); GSYNC(); }
        }
    }
}

extern "C" void kernel_launch(void* const* d_in, const int* in_sizes, int n_in, void* d_out, int out_size, void* d_ws, size_t ws_size, hipStream_t stream) {
    static int grid_blocks = 0;
    if (!grid_blocks) {
        int dev = 0, cus = 0, per_cu = 0;
        hipGetDevice(&dev);
        hipDeviceGetAttribute(&cus, hipDeviceAttributeMultiprocessorCount, dev);
        if (hipFuncSetAttribute((const void*)mega, hipFuncAttributeMaxDynamicSharedMemorySize, LDS_BYTES) != hipSuccess) fprintf(stderr, "hipFuncSetAttribute failed\n");
        hipOccupancyMaxActiveBlocksPerMultiprocessor(&per_cu, (const void*)mega, 512, LDS_BYTES);
        if (per_cu < 1) { fprintf(stderr, "occupancy query gave %d\n", per_cu); per_cu = 1; }
        (void)hipGetLastError();
        grid_blocks = cus * per_cu;
        if (grid_blocks > 256) grid_blocks = 256;
        if (ws_size < WS_END) fprintf(stderr, "workspace too small: %zu < %zu\n", ws_size, (size_t)WS_END);
    }
    Params p{};
    for (int i = 0; i < 19; ++i) p.in[i] = (const float*)d_in[i];
    p.out = (float*)d_out; p.ws = (unsigned char*)d_ws;
    void* args[] = {&p};
    hipError_t e = hipLaunchCooperativeKernel((const void*)mega, dim3(grid_blocks), dim3(512), args, LDS_BYTES, stream);
    if (e != hipSuccess) fprintf(stderr, "cooperative launch failed: %s (grid %d)\n", hipGetErrorString(e), grid_blocks);
}
```

```cpp
#include <hip/hip_runtime.h>
#include <hip/hip_cooperative_groups.h>
#include <cstdio>
namespace cg = cooperative_groups;
#define REP_UP 1
#define REP_IN 1
#define REP_DFT 1
#define REP_ATT 1
#define REP_SGU 1
#define REP_BR 1
#define REP_WCONV 1
#define EXTRA_SYNCS 0

#define LAS __attribute__((address_space(3)))
#define DI __device__ __forceinline__
typedef unsigned short bf16_t;
typedef short bf16x8 __attribute__((ext_vector_type(8)));
typedef float f32x2 __attribute__((ext_vector_type(2)));
typedef float f32x4 __attribute__((ext_vector_type(4)));
typedef float f32x16 __attribute__((ext_vector_type(16)));
typedef unsigned u32x2 __attribute__((ext_vector_type(2)));
typedef unsigned u32x4 __attribute__((ext_vector_type(4)));
typedef __bf16 bfv2 __attribute__((ext_vector_type(2)));

constexpr int D = 1024, NB = 8, SEQ = 4096, DEPTH = 4, CTXL = 256;
constexpr int TL = NB * SEQ, TC = NB * CTXL, T = TL + TC;
constexpr int DFF = 2752, DFFP = 2816, NUP = 5632;
constexpr int HBS = 2560;
constexpr float ALPHA = 1.681792830507429f;
constexpr float LN_EPS = 1e-5f;
constexpr int LDS_BYTES = 144 * 1024;

constexpr size_t OFF_MODS = 0;
constexpr size_t SZ_MODS = 4ull * 9 * 9216 * 4;
constexpr size_t OFF_ROPE = OFF_MODS + SZ_MODS;
constexpr size_t SZ_ROPE = 2ull * 64 * 16 * 4;
constexpr size_t OFF_DFT = OFF_ROPE + SZ_ROPE;
constexpr size_t SZ_DFT = 4096ull * 8192 * 2;
constexpr size_t OFF_DFTC = OFF_DFT + SZ_DFT;
constexpr size_t SZ_DFTC = 256ull * 512 * 2;
constexpr size_t OFF_W = OFF_DFTC + SZ_DFTC;
constexpr size_t W_UP0 = 0, W_DN0 = W_UP0 + 5632ull * 1024, W_UP1 = W_DN0 + 1024ull * 2816, W_DN1 = W_UP1 + 5632ull * 1024,
                 W_IN = W_DN1 + 1024ull * 2816, W_F = W_IN + 1792ull * 1024, W_CAT = W_F + 1024ull * 1024,
                 W_OUT = W_CAT + 3ull * 1024 * 1536, W_END = W_OUT + 1024ull * 1024;
constexpr size_t SZ_W = W_END * 2;
constexpr size_t OFF_X = OFF_W + SZ_W;
constexpr size_t SZ_X = (size_t)T * 1024 * 4;
constexpr size_t OFF_HB = OFF_X + SZ_X;
constexpr size_t SZ_HB = (size_t)T * HBS * 2;
constexpr size_t OFF_R = OFF_HB + SZ_HB;
constexpr size_t R_Q = 0;
constexpr size_t R_U = R_Q + (size_t)T * 512 * 2;
constexpr size_t R_Z = R_U + (size_t)T * 512 * 2;
constexpr size_t R_K = R_Z + (size_t)T * 512 * 2;
constexpr size_t R_VT = R_K + (size_t)T * 128 * 2;
constexpr size_t R_VTC = R_VT + 8ull * 128 * 4096 * 2;
constexpr size_t R_FT = R_VTC + 8ull * 128 * 256 * 2;
constexpr size_t R_FTC = R_FT + 8ull * 512 * 8192 * 2;
constexpr size_t R_END = R_FTC + 8ull * 512 * 512 * 2;
constexpr size_t SZ_R = (size_t)T * DFFP * 2;
static_assert(R_END == SZ_R, "region R");
constexpr size_t R_MERGED = R_Q;
constexpr size_t R_SCR = R_Z;
constexpr size_t OFF_BAR = OFF_R + SZ_R;
constexpr size_t SZ_BAR = 16384;
constexpr size_t OFF_STATS = OFF_BAR + SZ_BAR;
constexpr size_t SZ_STATS = (size_t)T * 2 * 4;
constexpr size_t WS_END = OFF_STATS + SZ_STATS;
static_assert(WS_END <= 721420288ull, "workspace");
static_assert(256ull * 3 * 131072 <= R_END - R_Z, "scr");

struct Params { const float* in[19]; float* out; unsigned char* ws; };
enum { I_X = 0, I_C, I_CTX, I_CCTX, I_WMOD, I_BMOD, I_WUP, I_WDN, I_LNG, I_LNB, I_WIN, I_SINK, I_SGUW, I_SGUB, I_SGULG, I_SGULB, I_WGATE, I_WBR, I_WOUT };

DI unsigned pk2(float a, float b) { f32x2 v = {a, b}; bfv2 r = __builtin_convertvector(v, bfv2); return __builtin_bit_cast(unsigned, r); }
DI bf16_t f2bf(float a) { return (bf16_t)(pk2(a, 0.f) & 0xffffu); }
DI float bf2f(unsigned b) { return __uint_as_float(b << 16); }
DI float bflo(unsigned w) { return __uint_as_float(w << 16); }
DI float bfhi(unsigned w) { return __uint_as_float(w & 0xffff0000u); }
DI float sigmoidf_(float x) { return 1.0f / (1.0f + __expf(-x)); }
DI float siluf_(float x) { return x / (1.0f + __expf(-x)); }
DI float geluf_(float x) { const float y = 1.5957691216057308f * (x + 0.044715f * x * x * x); return x / (1.0f + __expf(-y)); }
DI int otid() { int t = threadIdx.x; asm volatile("" : "+v"(t)); return t; }
DI int obid() { int b = blockIdx.x; asm volatile("" : "+s"(b)); return b; }
DI unsigned char* ows(const Params& P) { unsigned char* w = P.ws; asm volatile("" : "+s"(w)); return w; }
DI const float* oin(const Params& P, int i) { const float* p = P.in[i]; asm volatile("" : "+s"(p)); return p; }
DI float shx(float v, int o, int lane) { return __int_as_float(__builtin_amdgcn_ds_bpermute((lane ^ o) << 2, __float_as_int(v))); }
DI float wave_sum(float v, int lane) {
#pragma unroll
    for (int o = 32; o >= 1; o >>= 1) v += shx(v, o, lane);
    return v;
}

constexpr int BM = 256, BK = 64, HALF = 128, HTB = HALF * BK * 2, NXCD = 8, WGM = 8;
DI int lds_byte(int r, int c) { const int st = (r >> 4) * 2 + (c >> 5), rr = r & 15, cc = c & 31, ob = rr * 64 + cc * 2; return st * 1024 + (ob ^ (((ob >> 9) & 1) << 5)); }
DI void stage_rc(int b, int& R, int& C) { const int st = b / 1024, sb = b % 1024, swz = sb ^ (((sb >> 9) & 1) << 5); R = (st >> 1) * 16 + swz / 64; C = (st & 1) * 32 + (swz % 64) / 2; }

struct Unit { int pm, pn, aux; };

struct SchedTile {
    const char* Ab; const char* Bb; size_t tA, tB; int nM, nN, nwg, G, c;
    DI void init(const void* A, size_t tA_, const void* B, size_t tB_, int nM_, int nN_) { Ab = (const char*)A; Bb = (const char*)B; tA = tA_; tB = tB_; nM = nM_; nN = nN_; nwg = nM * nN; G = gridDim.x; c = obid(); }
    DI bool next(int i, Unit& u) const {
        const long L = (long)i * G + c; if (L >= nwg) return false;
        int wgid = (int)L; { const int q = nwg / NXCD, r = nwg % NXCD, xcd = wgid % NXCD, off = wgid / NXCD; wgid = (xcd < r ? xcd * (q + 1) : r * (q + 1) + (xcd - r) * q) + off; }
        const int nig = WGM * nN, gid = wgid / nig, fm = gid * WGM, gsz = (nM - fm) < WGM ? (nM - fm) : WGM;
        u.pm = fm + ((wgid % nig) % gsz); u.pn = (wgid % nig) / gsz; u.aux = 0; return true;
    }
    DI const char* A(const Unit& u) const { return Ab + (size_t)u.pm * tA; }
    DI const char* B(const Unit& u) const { return Bb + (size_t)u.pn * tB; }
};

struct SchedBr {
    const char* HBp; const char* Wc; int G, c, ntiles;
    DI bool next(int i, Unit& u) const { const int ti = (i / 9) * G + c; if (ti >= ntiles) return false; u.pm = ti >> 2; u.pn = ti & 3; u.aux = i % 9; return true; }
    DI const char* A(const Unit& u) const { const int off = u.aux < 6 ? (u.aux & 1) * 512 : 1024 + (u.aux - 6) * 512; return HBp + ((size_t)u.pm * 256 * HBS + off) * 2; }
    DI const char* B(const Unit& u) const { const int r = u.aux < 6 ? (u.aux >> 1) : (u.aux - 6); const int off = u.aux < 6 ? 512 + (u.aux & 1) * 512 : 0; return Wc + ((size_t)(r * 1024 + u.pn * 256) * 1536 + off) * 2; }
};

template <int K, int lda, int ldb, class Epi, class Sched>
DI void gemm_phase(LAS unsigned char* lds, const Sched& S, const Epi& E) {
    const int tid = otid(), wid = __builtin_amdgcn_readfirstlane(tid >> 6), lane = tid & 63, wr = wid >> 2, wc = wid & 3, fr = lane & 15, fq = lane >> 4;
    constexpr int nt = K / BK;
    unsigned voffA[2], voffB[2];
#pragma unroll
    for (int i = 0; i < 2; ++i) { int R, C; stage_rc(tid * 16 + i * 8192, R, C); voffA[i] = (unsigned)(R * lda + C) * 2u; voffB[i] = (unsigned)(R * ldb + C) * 2u; }
    constexpr size_t kstep = (size_t)(BK * 2);
    constexpr size_t hstepA = (size_t)HALF * lda * 2, hstepB = (size_t)HALF * ldb * 2;
    const unsigned ldsw = (unsigned)wid * 1024u;
    const int aoff = lds_byte(wr * 64 + fr, fq * 8), boff = lds_byte(wc * 32 + fr, fq * 8);
#define PG8_SA(b, h) (((b) * 2 + (h)) * HTB)
#define PG8_SB(b, h) ((4 + (b) * 2 + (h)) * HTB)
#define PG8_STAGE(bufoff, gbase, voff) do { _Pragma("unroll") for (int _i = 0; _i < 2; ++_i) \
        __builtin_amdgcn_global_load_lds((const unsigned*)((const char*)(gbase) + (voff)[_i]), (LAS unsigned*)(lds + (bufoff) + ldsw + _i * 8192), 16, 0, 0); } while (0)
#define PG8_LDA(dst, b, h) do { _Pragma("unroll") for (int m = 0; m < 4; ++m) _Pragma("unroll") for (int k = 0; k < 2; ++k) dst[m][k] = *(const LAS bf16x8*)(lds + PG8_SA(b, h) + aoff + m * 2048 + k * 1024); } while (0)
#define PG8_LDB(dst, b, h) do { _Pragma("unroll") for (int n = 0; n < 2; ++n) _Pragma("unroll") for (int k = 0; k < 2; ++k) dst[n][k] = *(const LAS bf16x8*)(lds + PG8_SB(b, h) + boff + n * 2048 + k * 1024); } while (0)
#define PG8_MMA(ai, bj, At, Bt) do { __builtin_amdgcn_s_setprio(1); _Pragma("unroll") for (int m = 0; m < 4; ++m) _Pragma("unroll") for (int n = 0; n < 2; ++n) _Pragma("unroll") for (int k = 0; k < 2; ++k) \
        acc[ai][bj][m][n] = __builtin_amdgcn_mfma_f32_16x16x32_bf16(Bt[n][k], At[m][k], acc[ai][bj][m][n], 0, 0, 0); __builtin_amdgcn_s_setprio(0); } while (0)
#define PG8_WAIT_V(n) asm volatile("s_waitcnt vmcnt(" #n ")" ::: "memory")
#define PG8_WAIT_L(n) asm volatile("s_waitcnt lgkmcnt(" #n ")" ::: "memory")
#define PG8_BAR __builtin_amdgcn_s_barrier()
#define PG8_SCHED __builtin_amdgcn_sched_barrier(0)
    Unit cur, nxt; int ui = 0;
    if (!S.next(0, cur)) return;
    f32x4 acc[2][2][4][2];
#pragma unroll
    for (int a = 0; a < 2; ++a)
#pragma unroll
        for (int b = 0; b < 2; ++b)
#pragma unroll
            for (int m = 0; m < 4; ++m)
#pragma unroll
                for (int n = 0; n < 2; ++n) acc[a][b][m][n] = (f32x4){0.f, 0.f, 0.f, 0.f};
    bf16x8 At[4][2], B0[2][2], B1[2][2];
    const char* cA = S.A(cur); const char* cB = S.B(cur);
    PG8_STAGE(PG8_SB(0, 0), cB, voffB); PG8_STAGE(PG8_SA(0, 0), cA, voffA); PG8_STAGE(PG8_SB(0, 1), cB + hstepB, voffB); PG8_STAGE(PG8_SA(0, 1), cA + hstepA, voffA);
    if (wr == 1) PG8_BAR;
    PG8_WAIT_V(4); PG8_BAR;
    PG8_STAGE(PG8_SB(1, 0), cB + kstep, voffB); PG8_STAGE(PG8_SA(1, 0), cA + kstep, voffA); PG8_STAGE(PG8_SB(1, 1), cB + hstepB + kstep, voffB);
    PG8_WAIT_V(6); PG8_BAR;
    for (;;) {
        const bool has_next = S.next(ui + 1, nxt);
        const char* nA = has_next ? S.A(nxt) : cA; const char* nB = has_next ? S.B(nxt) : cB;
        for (int t = 0; t < nt; t += 2) {
            const bool last = (t == nt - 2);
            const char* a1 = cA + (size_t)(t + 1) * kstep;
            const char* a2 = last ? nA : cA + (size_t)(t + 2) * kstep; const char* b2 = last ? nB : cB + (size_t)(t + 2) * kstep;
            const char* a3 = a2 + kstep; const char* b3 = b2 + kstep;
            PG8_LDB(B0, 0, 0); PG8_SCHED; PG8_LDA(At, 0, 0); PG8_STAGE(PG8_SA(1, 1), a1 + hstepA, voffA);
            PG8_WAIT_L(8); PG8_BAR; PG8_WAIT_L(0); PG8_MMA(0, 0, At, B0); PG8_BAR; PG8_SCHED;
            PG8_LDB(B1, 0, 1); PG8_STAGE(PG8_SB(0, 0), b2, voffB);
            PG8_BAR; PG8_WAIT_L(0); PG8_MMA(0, 1, At, B1); PG8_BAR;
            PG8_LDA(At, 0, 1); PG8_STAGE(PG8_SA(0, 0), a2, voffA);
            PG8_BAR; PG8_WAIT_L(0); PG8_MMA(1, 0, At, B0); PG8_BAR; PG8_SCHED;
            PG8_STAGE(PG8_SB(0, 1), b2 + hstepB, voffB);
            PG8_WAIT_V(6); PG8_BAR; PG8_MMA(1, 1, At, B1); PG8_BAR;
            PG8_LDB(B0, 1, 0); PG8_SCHED; PG8_LDA(At, 1, 0); PG8_STAGE(PG8_SA(0, 1), a2 + hstepA, voffA);
            PG8_WAIT_L(8); PG8_BAR; PG8_WAIT_L(0); PG8_MMA(0, 0, At, B0); PG8_BAR; PG8_SCHED;
            PG8_LDB(B1, 1, 1); PG8_STAGE(PG8_SB(1, 0), b3, voffB);
            PG8_BAR; PG8_WAIT_L(0); PG8_MMA(0, 1, At, B1); PG8_BAR;
            PG8_LDA(At, 1, 1); PG8_STAGE(PG8_SA(1, 0), a3, voffA);
            PG8_BAR; PG8_WAIT_L(0); PG8_MMA(1, 0, At, B0); PG8_BAR; PG8_SCHED;
            PG8_STAGE(PG8_SB(1, 1), b3 + hstepB, voffB);
            PG8_WAIT_V(6); PG8_BAR; PG8_MMA(1, 1, At, B1); PG8_BAR;
        }
        const bool zero = E(acc, cur, wr, wc, fr, fq);
        if (!has_next) break;
        if (zero) {
#pragma unroll
            for (int a = 0; a < 2; ++a)
#pragma unroll
                for (int b = 0; b < 2; ++b)
#pragma unroll
                    for (int m = 0; m < 4; ++m)
#pragma unroll
                        for (int n = 0; n < 2; ++n) acc[a][b][m][n] = (f32x4){0.f, 0.f, 0.f, 0.f};
        }
        cur = nxt; cA = nA; cB = nB; ++ui;
    }
    PG8_WAIT_V(0);
    if (wr == 0) PG8_BAR;
    PG8_BAR;
#undef PG8_SA
#undef PG8_SB
#undef PG8_STAGE
#undef PG8_LDA
#undef PG8_LDB
#undef PG8_MMA
#undef PG8_WAIT_V
#undef PG8_WAIT_L
#undef PG8_BAR
#undef PG8_SCHED
}

typedef f32x4 AccT[2][2][4][2];

struct EpiUp {
    bf16_t* act;
    DI bool operator()(AccT& acc, const Unit& u, int wr, int wc, int fr, int fq) const {
        asm volatile("" : "+v"(fr)); asm volatile("" : "+v"(fq));
        const int row0 = u.pm * BM + wr * 64 + fr, c0 = u.pn * 128 + wc * 16 + 4 * fq;
#pragma unroll
        for (int ai = 0; ai < 2; ++ai)
#pragma unroll
            for (int m = 0; m < 4; ++m) { bf16_t* rowp = act + (size_t)(row0 + ai * HALF + m * 16) * DFFP + c0;
#pragma unroll
                for (int bj = 0; bj < 2; ++bj) { const f32x4 g = acc[ai][bj][m][0], up = acc[ai][bj][m][1];
                    u32x2 w; w.x = pk2(siluf_(g[0]) * up[0], siluf_(g[1]) * up[1]); w.y = pk2(siluf_(g[2]) * up[2], siluf_(g[3]) * up[3]);
                    *(u32x2*)(rowp + bj * 64) = w; } }
        return true;
    }
};

struct EpiRes {
    float* X; const float* gm; const float* stats; const float* lg; const float* lb; float s; int ident;
    DI bool operator()(AccT& acc, const Unit& u, int wr, int wc, int fr, int fq) const {
        asm volatile("" : "+v"(fr)); asm volatile("" : "+v"(fq));
        const int row0 = u.pm * BM + wr * 64 + fr, col0 = u.pn * BM + wc * 32 + 4 * fq;
        const int rb = (u.pm * BM < TL) ? ((u.pm * BM) >> 12) : 8;
        const float* gp = gm + (size_t)rb * 9216 + col0;
        const float sv = s; const f32x4 s4 = (f32x4){sv, sv, sv, sv};
        f32x4 gv[2][2], gl[2][2], bl[2][2];
#pragma unroll
        for (int bj = 0; bj < 2; ++bj)
#pragma unroll
            for (int n = 0; n < 2; ++n) { gv[bj][n] = *(const f32x4*)(gp + bj * HALF + n * 16) * s4;
                gl[bj][n] = *(const f32x4*)(lg + col0 + bj * HALF + n * 16) * ALPHA; bl[bj][n] = *(const f32x4*)(lb + col0 + bj * HALF + n * 16) * ALPHA;
                if (ident) { gl[bj][n] = (f32x4){ALPHA, ALPHA, ALPHA, ALPHA}; bl[bj][n] = (f32x4){0.f, 0.f, 0.f, 0.f}; } }
#pragma unroll
        for (int ai = 0; ai < 2; ++ai)
#pragma unroll
            for (int m = 0; m < 4; ++m) { const int row = row0 + ai * HALF + m * 16; float* rowp = X + (size_t)row * D + col0;
                float mu = stats[(size_t)row * 2], rstd = stats[(size_t)row * 2 + 1];
                if (ident) { mu = 0.f; rstd = 1.f; }
#pragma unroll
                for (int bj = 0; bj < 2; ++bj)
#pragma unroll
                    for (int n = 0; n < 2; ++n) { f32x4* px = (f32x4*)(rowp + bj * HALF + n * 16); const f32x4 t = *px; *px = ((t - mu) * rstd) * gl[bj][n] + bl[bj][n] + gv[bj][n] * acc[ai][bj][m][n]; } }
        return true;
    }
};

struct EpiIn {
    bf16_t* Q; bf16_t* Kb; bf16_t* VT; bf16_t* VTC; bf16_t* U; bf16_t* Z; const float* ropec; const float* ropes;
    DI bool operator()(AccT& acc, const Unit& u, int wr, int wc, int fr, int fq) const {
        asm volatile("" : "+v"(fr)); asm volatile("" : "+v"(fq));
        const int row0 = u.pm * BM + wr * 64 + fr;
        const bool lat = (u.pm * BM) < TL;
        const int pn = u.pn;
#pragma unroll
        for (int ai = 0; ai < 2; ++ai)
#pragma unroll
            for (int m = 0; m < 4; ++m) {
                const int row = row0 + ai * HALF + m * 16;
                if (pn <= 2) {
                    const int s = row & 4095;
                    const int p = (wc & 1) ? (s & 63) : (s >> 6);
                    f32x4 cs = (f32x4){1.f, 1.f, 1.f, 1.f}, sn = (f32x4){0.f, 0.f, 0.f, 0.f};
                    if (lat) { cs = *(const f32x4*)(ropec + p * 16 + 4 * fq); sn = *(const f32x4*)(ropes + p * 16 + 4 * fq); }
#pragma unroll
                    for (int bj = 0; bj < 2; ++bj) {
                        const f32x4 x1 = acc[ai][bj][m][0], x2 = acc[ai][bj][m][1];
                        if (pn < 2 || bj == 0) {
                            const f32x4 o1 = x1 * cs - x2 * sn, o2 = x1 * sn + x2 * cs;
                            u32x2 w1, w2; w1.x = pk2(o1[0], o1[1]); w1.y = pk2(o1[2], o1[3]); w2.x = pk2(o2[0], o2[1]); w2.y = pk2(o2[2], o2[3]);
                            bf16_t* dst = (pn < 2) ? (Q + (size_t)row * 512 + pn * 256 + bj * HALF + wc * 32 + 4 * fq) : (Kb + (size_t)row * 128 + wc * 32 + 4 * fq);
                            *(u32x2*)dst = w1; *(u32x2*)(dst + 16) = w2;
                        } else {
                            const int cv = wc * 32 + 4 * fq;
                            bf16_t* dst; size_t cst;
                            if (lat) { const int b = row >> 12; dst = VT + ((size_t)(b * 128 + cv)) * 4096 + s; cst = 4096; }
                            else { const int rc = row - TL; const int b = rc >> 8; dst = VTC + ((size_t)(b * 128 + cv)) * 256 + (rc & 255); cst = 256; }
#pragma unroll
                            for (int j = 0; j < 4; ++j) { dst[(size_t)j * cst] = f2bf(x1[j]); dst[(size_t)(16 + j) * cst] = f2bf(x2[j]); }
                        }
                    }
                } else {
                    bf16_t* base = (pn <= 4) ? (U + (size_t)row * 512 + (pn - 3) * 256) : (Z + (size_t)row * 512 + (pn - 5) * 256);
                    base += wc * 32 + 4 * fq;
#pragma unroll
                    for (int bj = 0; bj < 2; ++bj)
#pragma unroll
                        for (int n = 0; n < 2; ++n) { const f32x4 v = acc[ai][bj][m][n];
                            u32x2 w; w.x = pk2(geluf_(v[0]), geluf_(v[1])); w.y = pk2(geluf_(v[2]), geluf_(v[3]));
                            *(u32x2*)(base + bj * HALF + n * 16) = w; }
                }
            }
        return true;
    }
};

struct EpiFT {
    bf16_t* FT; bf16_t* FTC;
    DI bool operator()(AccT& acc, const Unit& u, int wr, int wc, int fr, int fq) const {
        asm volatile("" : "+v"(fr)); asm volatile("" : "+v"(fq));
        const int isS = u.pm >> 1;
        const int ch0 = (u.pm & 1) * 256 + wr * 64 + fr;
        bf16_t* base; size_t rst;
        if (u.pn < 128) { const int b = u.pn >> 4; base = FT + (size_t)b * 512 * 8192 + isS * 4096 + ((u.pn & 15) * 256) + wc * 32 + 4 * fq; rst = 8192; }
        else { const int b = u.pn - 128; base = FTC + (size_t)b * 512 * 512 + isS * 256 + wc * 32 + 4 * fq; rst = 512; }
#pragma unroll
        for (int ai = 0; ai < 2; ++ai)
#pragma unroll
            for (int m = 0; m < 4; ++m) { bf16_t* rowp = base + (size_t)(ch0 + ai * HALF + m * 16) * rst;
#pragma unroll
                for (int bj = 0; bj < 2; ++bj)
#pragma unroll
                    for (int n = 0; n < 2; ++n) { const f32x4 v = acc[ai][bj][m][n]; u32x2 w; w.x = pk2(v[0], v[1]); w.y = pk2(v[2], v[3]); *(u32x2*)(rowp + bj * HALF + n * 16) = w; } }
        return true;
    }
};

struct EpiDft {
    bf16_t* HB; int rowbase, rpb;
    DI bool operator()(AccT& acc, const Unit& u, int wr, int wc, int fr, int fq) const {
        asm volatile("" : "+v"(fr)); asm volatile("" : "+v"(fq));
        const int b = u.pn >> 1;
        const int k0 = u.pm * BM + wr * 64 + fr;
        bf16_t* base = HB + (size_t)(rowbase + b * rpb) * HBS + 2048 + (u.pn & 1) * 256 + wc * 32 + 4 * fq;
#pragma unroll
        for (int ai = 0; ai < 2; ++ai)
#pragma unroll
            for (int m = 0; m < 4; ++m) { bf16_t* rowp = base + (size_t)(k0 + ai * HALF + m * 16) * HBS;
#pragma unroll
                for (int bj = 0; bj < 2; ++bj)
#pragma unroll
                    for (int n = 0; n < 2; ++n) { const f32x4 v = acc[ai][bj][m][n]; u32x2 w; w.x = pk2(v[0], v[1]); w.y = pk2(v[2], v[3]); *(u32x2*)(rowp + bj * HALF + n * 16) = w; } }
        return true;
    }
};

struct EpiBr {
    bf16_t* merged; unsigned char* scr;
    DI bool operator()(AccT& acc, const Unit& u, int wr, int wc, int fr, int fq) const {
        asm volatile("" : "+v"(fr)); asm volatile("" : "+v"(fq));
        const int sub = u.aux;
        const int tid = (wr * 4 + wc) * 64 + fq * 16 + fr;
        const int r = sub < 6 ? (sub >> 1) : (sub - 6);
        unsigned char* sp = scr + (size_t)r * 131072 + (size_t)tid * 16;
        if (sub < 6 && (sub & 1)) {
#pragma unroll
            for (int ai = 0; ai < 2; ++ai)
#pragma unroll
                for (int bj = 0; bj < 2; ++bj)
#pragma unroll
                    for (int m = 0; m < 4; ++m) { const f32x4 a = acc[ai][bj][m][0], b = acc[ai][bj][m][1];
                        u32x4 w; w.x = pk2(sigmoidf_(a[0]), sigmoidf_(a[1])); w.y = pk2(sigmoidf_(a[2]), sigmoidf_(a[3])); w.z = pk2(sigmoidf_(b[0]), sigmoidf_(b[1])); w.w = pk2(sigmoidf_(b[2]), sigmoidf_(b[3]));
                        *(u32x4*)(sp + (size_t)(((ai * 2 + bj) * 4 + m) * 8192)) = w; }
        }
        if (sub == 8) {
            const int row0 = u.pm * BM + wr * 64 + fr, col0 = u.pn * BM + wc * 32 + 4 * fq;
#pragma unroll
            for (int ai = 0; ai < 2; ++ai)
#pragma unroll
                for (int bj = 0; bj < 2; ++bj)
#pragma unroll
                    for (int m = 0; m < 4; ++m) {
                        const u32x4 g = *(const u32x4*)(sp + (size_t)(((ai * 2 + bj) * 4 + m) * 8192));
                        const f32x4 a = acc[ai][bj][m][0], b = acc[ai][bj][m][1];
                        bf16_t* dst = merged + (size_t)(row0 + ai * HALF + m * 16) * D + col0 + bj * HALF;
                        u32x2 w0, w1; w0.x = pk2(bflo(g.x) * a[0], bfhi(g.x) * a[1]); w0.y = pk2(bflo(g.y) * a[2], bfhi(g.y) * a[3]);
                        w1.x = pk2(bflo(g.z) * b[0], bfhi(g.z) * b[1]); w1.y = pk2(bflo(g.w) * b[2], bfhi(g.w) * b[3]);
                        *(u32x2*)dst = w0; *(u32x2*)(dst + 16) = w1;
                    }
        }
        const bool scale = (sub == 6 || sub == 7);
        const float cf = (sub < 6 && !(sub & 1)) ? 1.0f : 0.0f;
#pragma unroll
        for (int ai = 0; ai < 2; ++ai)
#pragma unroll
            for (int bj = 0; bj < 2; ++bj)
#pragma unroll
                for (int m = 0; m < 4; ++m) {
                    f32x4 fa = (f32x4){cf, cf, cf, cf}, fb = fa;
                    if (scale) {
                        const u32x4 g = *(const u32x4*)(sp + (size_t)(((ai * 2 + bj) * 4 + m) * 8192));
                        const u32x4 d = *(const u32x4*)(sp + 131072 + (size_t)(((ai * 2 + bj) * 4 + m) * 8192));
                        fa = (f32x4){bflo(g.x) * __builtin_amdgcn_rcpf(bflo(d.x)), bfhi(g.x) * __builtin_amdgcn_rcpf(bfhi(d.x)), bflo(g.y) * __builtin_amdgcn_rcpf(bflo(d.y)), bfhi(g.y) * __builtin_amdgcn_rcpf(bfhi(d.y))};
                        fb = (f32x4){bflo(g.z) * __builtin_amdgcn_rcpf(bflo(d.z)), bfhi(g.z) * __builtin_amdgcn_rcpf(bfhi(d.z)), bflo(g.w) * __builtin_amdgcn_rcpf(bflo(d.w)), bfhi(g.w) * __builtin_amdgcn_rcpf(bfhi(d.w))};
                    }
                    acc[ai][bj][m][0] *= fa; acc[ai][bj][m][1] *= fb;
                }
        return false;
    }
};

#define XB_TMO      128
#define XB_XCNT(j)  (256  + 64 * (j))
#define XB_XSUB(j)  (1280 + 64 * (j))
#define XB_XGEN(j)  (2304 + 64 * (j))
#define XB_TOP      3328
#define XB_TOPGEN   3392
#define XCD_BAR_WORDS 3456
#define XB_SPIN_CAP (1u << 18)
DI unsigned xb_ld(unsigned* p)              { return __hip_atomic_load(p, __ATOMIC_RELAXED, __HIP_MEMORY_SCOPE_AGENT); }
DI unsigned xb_add(unsigned* p, unsigned v) { return __hip_atomic_fetch_add(p, v, __ATOMIC_RELAXED, __HIP_MEMORY_SCOPE_AGENT); }
DI unsigned xb_xcc_id() { return (unsigned)__builtin_amdgcn_s_getreg((3 << 11) | 20) & 0xFu; }
#define XB_SPIN(cond, bar) do { unsigned _sp = 0; while (cond) { __builtin_amdgcn_s_sleep(1); \
    if ((++_sp & 255u) == 0u) { if (xb_ld(&(bar)[XB_TMO])) break; if (_sp > XB_SPIN_CAP) { atomicAdd(&(bar)[XB_TMO], 1u); break; } } } } while (0)
struct XcdBarrier { unsigned* bar; unsigned x; volatile LAS unsigned* st; };
DI XcdBarrier xcd_barrier_post(unsigned* bar, volatile LAS unsigned* st) {
    XcdBarrier b; b.bar = bar; b.x = xb_xcc_id(); b.st = st;
    if (threadIdx.x == 0) (void)xb_add(&bar[XB_XCNT(b.x)], 1u);
    return b;
}
DI void xcd_barrier_complete(unsigned* bar, unsigned x, unsigned& nloc, unsigned& nx) {
    const unsigned G = gridDim.x * gridDim.y * gridDim.z;
    unsigned sum, cnt, mine, sp = 0u;
    for (;;) {
        sum = 0u; cnt = 0u; mine = 0u;
#pragma unroll
        for (unsigned j = 0; j < 16; ++j) { const unsigned c = xb_ld(&bar[XB_XCNT(j)]); sum += c; cnt += (c > 0u) ? 1u : 0u; mine = (j == x) ? c : mine; }
        if (sum == G) break;
        __builtin_amdgcn_s_sleep(1);
        if ((++sp & 255u) == 0u) { if (xb_ld(&bar[XB_TMO])) break; if (sp > XB_SPIN_CAP) { atomicAdd(&bar[XB_TMO], 1u); break; } }
    }
    nloc = mine > 0u ? mine : 1u; nx = cnt > 0u ? cnt : 1u;
}
DI void xcd_barrier(const XcdBarrier& b) {
    asm volatile("s_waitcnt vmcnt(0)" ::: "memory");
    __syncthreads();
    if (threadIdx.x == 0) {
        unsigned* bar = b.bar;
        __builtin_amdgcn_s_waitcnt(0);
        unsigned nloc = b.st[0], nx = b.st[1];
        if (nloc == 0u) { xcd_barrier_complete(bar, b.x, nloc, nx); b.st[0] = nloc; b.st[1] = nx; }
        const unsigned old = xb_add(&bar[XB_XSUB(b.x)], 1u);
        const unsigned gen = old / nloc;
        if (old + 1u == (gen + 1u) * nloc) {
            __builtin_amdgcn_fence(__ATOMIC_RELEASE, "agent");
            asm volatile("s_waitcnt vmcnt(0)" ::: "memory");
            const unsigned og = xb_add(&bar[XB_TOP], 1u);
            const unsigned tg = og / nx;
            if (og + 1u == (tg + 1u) * nx) xb_add(&bar[XB_TOPGEN], 1u);
            else XB_SPIN(xb_ld(&bar[XB_TOPGEN]) == tg, bar);
            __builtin_amdgcn_fence(__ATOMIC_ACQUIRE, "agent");
            xb_add(&bar[XB_XGEN(b.x)], 1u);
            asm volatile("s_waitcnt vmcnt(0)" ::: "memory");
        } else {
            XB_SPIN(xb_ld(&bar[XB_XGEN(b.x)]) == gen, bar);
            __builtin_amdgcn_fence(__ATOMIC_ACQUIRE, "agent");
            asm volatile("s_waitcnt vmcnt(0)" ::: "memory");
        }
    }
    __syncthreads();
}

DI void phase_mods(const Params& P, unsigned char* shm) {
    float* s = (float*)shm;
    float* red = s + 9 * 1024;
    const int tid = otid();
    const float* c = oin(P, I_C); const float* cc = oin(P, I_CCTX);
    for (int idx = tid; idx < 9 * 1024; idx += 512) { const int rb = idx >> 10, k = idx & 1023; const float v = rb < 8 ? c[rb * 1024 + k] : cc[k]; s[idx] = siluf_(v); }
    __syncthreads();
    float* mods = (float*)(ows(P) + OFF_MODS);
    const float* wmod = oin(P, I_WMOD); const float* bmod = oin(P, I_BMOD);
    for (int u = obid(); u < 288; u += gridDim.x) {
        const int l = u / 72, n0 = (u % 72) * 128, cgp = tid & 31, ks = tid >> 5;
        f32x4 acc[9];
#pragma unroll
        for (int rb = 0; rb < 9; ++rb) acc[rb] = (f32x4){0.f, 0.f, 0.f, 0.f};
        const float* wp = wmod + ((size_t)l * 1024 + ks * 64) * 9216 + n0 + cgp * 4;
        for (int kk = 0; kk < 64; ++kk) { const f32x4 w = *(const f32x4*)(wp + (size_t)kk * 9216);
#pragma unroll
            for (int rb = 0; rb < 9; ++rb) acc[rb] += w * s[rb * 1024 + ks * 64 + kk]; }
#pragma unroll
        for (int rb = 0; rb < 9; ++rb) *(f32x4*)(red + ((ks * 9 + rb) * 128 + cgp * 4)) = acc[rb];
        __syncthreads();
        for (int idx = tid; idx < 1152; idx += 512) { const int rb = idx >> 7, c2 = idx & 127; float sum = bmod[l * 9216 + n0 + c2];
            for (int k2 = 0; k2 < 16; ++k2) sum += red[(k2 * 9 + rb) * 128 + c2];
            mods[((size_t)l * 9 + rb) * 9216 + n0 + c2] = sum; }
        __syncthreads();
    }
}

DI void phase_tables(const Params& P, unsigned char* shm) {
    const int tid = otid();
    float* tab = (float*)shm;
    for (int j = tid; j < 4096; j += 512) tab[j] = cospif((float)j * (1.0f / 2048.0f)) * (1.0f / 64.0f);
    __syncthreads();
    if (obid() == 0) {
        float* rc = (float*)(ows(P) + OFF_ROPE); float* rs = rc + 1024;
        for (int idx = tid; idx < 1024; idx += 512) { const int p = idx >> 4, f = idx & 15; const float inv = powf(10000.0f, -(float)f / 16.0f); const float ang = (float)p * inv; rc[idx] = cosf(ang); rs[idx] = sinf(ang); }
    }
    bf16_t* dft = (bf16_t*)(ows(P) + OFF_DFT);
    const long gid = (long)obid() * 512 + tid, gstride = (long)gridDim.x * 512;
    for (long it = gid; it < 4096l * 1024; it += gstride) {
        const int k = (int)(it >> 10), n0 = ((int)it & 1023) * 8; const bool isS = n0 >= 4096; const int nn = n0 & 4095;
        float v[8];
#pragma unroll
        for (int j = 0; j < 8; ++j) { const int idx = (k * (nn + j)) & 4095; v[j] = isS ? -tab[(idx + 3072) & 4095] : tab[idx]; }
        u32x4 w; w.x = pk2(v[0], v[1]); w.y = pk2(v[2], v[3]); w.z = pk2(v[4], v[5]); w.w = pk2(v[6], v[7]);
        *(u32x4*)(dft + (size_t)k * 8192 + n0) = w;
    }
    bf16_t* dftc = (bf16_t*)(ows(P) + OFF_DFTC);
    for (long it = gid; it < 256l * 64; it += gstride) {
        const int k = (int)(it >> 6), n0 = ((int)it & 63) * 8; const bool isS = n0 >= 256; const int nn = n0 & 255;
        float v[8];
#pragma unroll
        for (int j = 0; j < 8; ++j) { const int idx = ((k * (nn + j)) & 255) * 16; v[j] = (isS ? -tab[(idx + 3072) & 4095] : tab[idx]) * 4.0f; }
        u32x4 w; w.x = pk2(v[0], v[1]); w.y = pk2(v[2], v[3]); w.z = pk2(v[4], v[5]); w.w = pk2(v[6], v[7]);
        *(u32x4*)(dftc + (size_t)k * 512 + n0) = w;
    }
    __syncthreads();
}

DI void wconv_tile(const float* src, int lds_, int Ksrc, int mode, bf16_t* dst, int ldd, int coff, int kt, int ntile, float* tile) {
    const int tid = otid();
    const int k0 = kt * 64, n0 = ntile * 64;
    { const int nn = tid & 63, np = n0 + nn; int col = np;
      if (mode == 1) { const int t = np >> 8, w = np & 255, grp = w >> 5, isup = (w >> 4) & 1, i = w & 15; const int ff = t * 128 + grp * 16 + i; col = ff < DFF ? ff + isup * DFF : -1; }
#pragma unroll
      for (int i = 0; i < 8; ++i) { const int kk = (tid >> 6) + i * 8, k = k0 + kk; float v = 0.f; if (col >= 0 && k < Ksrc) v = src[(size_t)k * lds_ + col]; tile[kk * 65 + nn] = v; } }
    __syncthreads();
    { const int nn2 = tid >> 3, kq = (tid & 7) * 8; float v[8];
#pragma unroll
      for (int j = 0; j < 8; ++j) v[j] = tile[(kq + j) * 65 + nn2];
      u32x4 w; w.x = pk2(v[0], v[1]); w.y = pk2(v[2], v[3]); w.z = pk2(v[4], v[5]); w.w = pk2(v[6], v[7]);
      *(u32x4*)(dst + (size_t)(n0 + nn2) * ldd + coff + k0 + kq) = w; }
    __syncthreads();
}

DI void phase_wconv(const Params& P, int l, int grp, int w0, int nw, unsigned char* shm) {
    float* tile = (float*)shm;
    bf16_t* W = (bf16_t*)(ows(P) + OFF_W);
    const int tid = otid();
    constexpr int N_UP = 16 * 88, N_DN = 44 * 16, N_IN = 16 * 28, N_CB = 8 * 16, N_CG = 16 * 16, N_OUT = 16 * 16, N_WF = 128;
    const int wk = obid() - w0;
    if (wk < 0 || wk >= nw) return;
    __syncthreads();
    if (grp < 2) {
        const int f = grp;
        for (int u = wk; u < N_UP + N_DN; u += nw) {
            if (u < N_UP) wconv_tile(oin(P, I_WUP) + ((size_t)(l * 2 + f)) * 1024 * 5504, 5504, 1024, 1, W + (f ? W_UP1 : W_UP0), 1024, 0, u % 16, u / 16, tile);
            else { const int v = u - N_UP; wconv_tile(oin(P, I_WDN) + ((size_t)(l * 2 + f)) * 2752 * 1024, 1024, 2752, 0, W + (f ? W_DN1 : W_DN0), 2816, 0, v % 44, v / 44, tile); }
        }
        return;
    }
    constexpr int TOT = N_IN + 3 * N_CB + 3 * N_CG + N_OUT + N_WF;
    for (int u = wk; u < TOT; u += nw) {
        int v = u;
        if (v < N_IN) { wconv_tile(oin(P, I_WIN) + (size_t)l * 1024 * 2304, 2304, 1024, 0, W + W_IN, 1024, 0, v % 16, v / 16, tile); continue; }
        v -= N_IN;
        if (v < 3 * N_CB) { const int r = v / N_CB; v %= N_CB; wconv_tile(oin(P, I_WBR) + ((size_t)(l * 3 + r)) * 512 * 1024, 1024, 512, 0, W + W_CAT + (size_t)r * 1024 * 1536, 1536, 0, v % 8, v / 8, tile); continue; }
        v -= 3 * N_CB;
        if (v < 3 * N_CG) { const int r = v / N_CG; v %= N_CG; wconv_tile(oin(P, I_WGATE) + ((size_t)(l * 3 + r)) * 1024 * 1024, 1024, 1024, 0, W + W_CAT + (size_t)r * 1024 * 1536, 1536, 512, v % 16, v / 16, tile); continue; }
        v -= 3 * N_CG;
        if (v < N_OUT) { wconv_tile(oin(P, I_WOUT) + (size_t)l * 1024 * 1024, 1024, 1024, 0, W + W_OUT, 1024, 0, v % 16, v / 16, tile); continue; }
        v -= N_OUT;
        {
            float* rows = tile; float* tab = rows + 4096;
            const float* src = oin(P, I_WIN) + (size_t)l * 1024 * 2304 + (size_t)(v * 8) * 2304 + 1792;
            for (int idx = tid; idx < 4096; idx += 512) rows[idx] = src[(size_t)(idx >> 9) * 2304 + (idx & 511)];
            if (tid < 128) tab[tid] = cospif((float)tid * (1.0f / 64.0f));
            __syncthreads();
            const int g = tid >> 7, m = tid & 127;
            float ac[8], as[8];
#pragma unroll
            for (int kk = 0; kk < 8; ++kk) { ac[kk] = 0.f; as[kk] = 0.f; }
            for (int c2 = 0; c2 < 128; ++c2) { const int idx = (m * c2) & 127; const float cv = tab[idx], sv = tab[(idx + 96) & 127];
#pragma unroll
                for (int kk = 0; kk < 8; ++kk) { const float w = rows[kk * 512 + g * 128 + c2]; ac[kk] += w * cv; as[kk] += w * sv; } }
            const float sc = 0.08838834764831845f;
            u32x4 wc_, ws_; wc_.x = pk2(ac[0] * sc, ac[1] * sc); wc_.y = pk2(ac[2] * sc, ac[3] * sc); wc_.z = pk2(ac[4] * sc, ac[5] * sc); wc_.w = pk2(ac[6] * sc, ac[7] * sc);
            ws_.x = pk2(as[0] * sc, as[1] * sc); ws_.y = pk2(as[2] * sc, as[3] * sc); ws_.z = pk2(as[4] * sc, as[5] * sc); ws_.w = pk2(as[6] * sc, as[7] * sc);
            *(u32x4*)(W + W_F + (size_t)tid * 1024 + v * 8) = wc_;
            *(u32x4*)(W + W_F + (size_t)(512 + tid) * 1024 + v * 8) = ws_;
            __syncthreads();
        }
    }
}

DI void phase_norm(const Params& P, const float* g, const float* bt, const float* mod, int jm, float* outp, int rend) {
    const int tid = otid(), wid = tid >> 6, lane = tid & 63;
    float* X = (float*)(ows(P) + OFF_X); bf16_t* HB = (bf16_t*)(ows(P) + OFF_HB); float* stats = (float*)(ows(P) + OFF_STATS);
    for (int r = obid() * 8 + wid; r < rend; r += gridDim.x * 8) {
        const float* src = g ? (X + (size_t)r * D) : (r < TL ? oin(P, I_X) + (size_t)r * D : oin(P, I_CTX) + (size_t)(r - TL) * D);
        f32x4 v[4];
#pragma unroll
        for (int q = 0; q < 4; ++q) v[q] = *(const f32x4*)(src + q * 256 + lane * 4);
        if (g) {
            float sum = 0.f;
#pragma unroll
            for (int q = 0; q < 4; ++q) sum += v[q][0] + v[q][1] + v[q][2] + v[q][3];
            const float mu = wave_sum(sum, lane) * (1.0f / 1024.0f);
            float sq = 0.f;
#pragma unroll
            for (int q = 0; q < 4; ++q) { v[q] -= mu; sq += v[q][0] * v[q][0] + v[q][1] * v[q][1] + v[q][2] * v[q][2] + v[q][3] * v[q][3]; }
            const float rstd = rsqrtf(wave_sum(sq, lane) * (1.0f / 1024.0f) + LN_EPS);
            if (lane == 0) { stats[(size_t)r * 2] = mu; stats[(size_t)r * 2 + 1] = rstd; }
#pragma unroll
            for (int q = 0; q < 4; ++q) { const f32x4 gg = *(const f32x4*)(g + q * 256 + lane * 4), bb = *(const f32x4*)(bt + q * 256 + lane * 4); v[q] = v[q] * rstd * gg + bb; }
        } else {
#pragma unroll
            for (int q = 0; q < 4; ++q) *(f32x4*)(X + (size_t)r * D + q * 256 + lane * 4) = v[q];
        }
        if (outp) {
#pragma unroll
            for (int q = 0; q < 4; ++q) *(f32x4*)(outp + (size_t)r * D + q * 256 + lane * 4) = v[q];
        }
        if (mod) {
            const int rb = r < TL ? (r >> 12) : 8;
            const float* sh = mod + (size_t)rb * 9216 + jm * 1024; const float* sc = sh + 1024;
#pragma unroll
            for (int q = 0; q < 4; ++q) { const f32x4 a = *(const f32x4*)(sh + q * 256 + lane * 4), b = *(const f32x4*)(sc + q * 256 + lane * 4);
                const f32x4 h = v[q] * (b + 1.0f) + a; u32x2 w; w.x = pk2(h[0], h[1]); w.y = pk2(h[2], h[3]);
                *(u32x2*)(HB + (size_t)r * HBS + q * 256 + lane * 4) = w; }
        }
    }
}

#define MFMA32(a, b, c) __builtin_amdgcn_mfma_f32_32x32x16_bf16((a), (b), (c), 0, 0, 0)
DI bf16x8 mk8(u32x2 lo, u32x2 hi) { u32x4 w; w.x = lo.x; w.y = lo.y; w.z = hi.x; w.w = hi.y; return __builtin_bit_cast(bf16x8, w); }
constexpr int AK_RS = 144;
constexpr int AV_RS_BAND = (384 + 8) * 2;
constexpr int AV_RS_CTX = (256 + 8) * 2;
constexpr int AK_BYTES_BAND = 384 * AK_RS, AK_BYTES_CTX = 256 * AK_RS;
constexpr float SC_LOG2E = 0.125f * 1.4426950408889634f;

struct AttnState { float m, l; f32x16 O[2]; };

template <bool MASKED>
DI void attn_tile2(AttnState (&st)[2], const bf16x8 (&Qf)[2][4], const LAS unsigned char* kl, const LAS unsigned char* vl, const int vrs, int lane, int qposA, int klo) {
    const int hh = lane >> 5;
    bf16x8 Kf[4];
#pragma unroll
    for (int kk = 0; kk < 4; ++kk) Kf[kk] = *(const LAS bf16x8*)(kl + kk * 32);
    bf16x8 Vf[2][2];
#pragma unroll
    for (int db = 0; db < 2; ++db)
#pragma unroll
        for (int c = 0; c < 2; ++c) { const LAS unsigned char* p = vl + db * 32 * vrs + c * 32; Vf[db][c] = mk8(*(const LAS u32x2*)p, *(const LAS u32x2*)(p + 16)); }
#pragma unroll
    for (int qb = 0; qb < 2; ++qb) {
        f32x16 s;
#pragma unroll
        for (int i = 0; i < 16; ++i) s[i] = 0.f;
#pragma unroll
        for (int kk = 0; kk < 4; ++kk) s = MFMA32(Kf[kk], Qf[qb][kk], s);
        float tmax = -3.0e38f;
        const int qpos = qposA + qb * 32;
#pragma unroll
        for (int i = 0; i < 16; ++i) {
            float sv = s[i] * SC_LOG2E;
            if (MASKED) { const int kpos = klo + (i & 3) + 8 * (i >> 2) + 4 * hh; const int dlt = qpos - kpos; if (dlt > 128 || dlt < -128) sv = -3.0e38f; }
            s[i] = sv; tmax = fmaxf(tmax, sv);
        }
        tmax = fmaxf(tmax, shx(tmax, 32, lane));
        const float mnew = fmaxf(st[qb].m, tmax);
        const float alpha = __builtin_amdgcn_exp2f(st[qb].m - mnew);
        float psum = 0.f;
#pragma unroll
        for (int i = 0; i < 16; ++i) { const float p = __builtin_amdgcn_exp2f(s[i] - mnew); s[i] = p; psum += p; }
        st[qb].l = st[qb].l * alpha + psum; st[qb].m = mnew;
        if (__builtin_amdgcn_ballot_w64(alpha != 1.0f) != 0ull) {
#pragma unroll
            for (int db = 0; db < 2; ++db)
#pragma unroll
                for (int i = 0; i < 16; ++i) st[qb].O[db][i] *= alpha;
        }
        bf16x8 Pf[2];
#pragma unroll
        for (int c = 0; c < 2; ++c) { u32x4 w; w.x = pk2(s[8 * c + 0], s[8 * c + 1]); w.y = pk2(s[8 * c + 2], s[8 * c + 3]); w.z = pk2(s[8 * c + 4], s[8 * c + 5]); w.w = pk2(s[8 * c + 6], s[8 * c + 7]); Pf[c] = __builtin_bit_cast(bf16x8, w); }
#pragma unroll
        for (int db = 0; db < 2; ++db)
#pragma unroll
            for (int c = 0; c < 2; ++c) st[qb].O[db] = MFMA32(Vf[db][c], Pf[c], st[qb].O[db]);
    }
}

DI void phase_attn(const Params& P, int l, bool do_ctx, LAS unsigned char* lds) {
    const int tid = otid(), wid = tid >> 6, lane = tid & 63, hh = lane >> 5, ql = lane & 31;
    const bf16_t* Q = (const bf16_t*)(ows(P) + OFF_R + R_Q); const bf16_t* Kb = (const bf16_t*)(ows(P) + OFF_R + R_K);
    const bf16_t* VT = (const bf16_t*)(ows(P) + OFF_R + R_VT); const bf16_t* VTC = (const bf16_t*)(ows(P) + OFF_R + R_VTC);
    bf16_t* HB = (bf16_t*)(ows(P) + OFF_HB);
    const float* sink = oin(P, I_SINK) + l * 8;
    const int nunits = 512 + (do_ctx ? 32 : 0);
    const int hq = wid >> 1, pp = wid & 1;
    for (int u = obid(); u < nunits; u += gridDim.x) {
        const bool isc = u >= 512;
        int b, kvh, blk = 0, qbase;
        if (!isc) { kvh = u & 1; blk = (u >> 1) & 31; b = u >> 6; qbase = b * 4096 + blk * 128; }
        else { const int u2 = u - 512; kvh = u2 & 1; b = u2 >> 2; qbase = TL + b * 256 + ((u2 >> 1) & 1) * 128; }
        const int h = kvh * 4 + hq;
        const int qrowA = qbase + pp * 64 + ql;
        bf16x8 Qf[2][4];
#pragma unroll
        for (int qb = 0; qb < 2; ++qb)
#pragma unroll
            for (int kk = 0; kk < 4; ++kk) Qf[qb][kk] = *(const bf16x8*)(Q + (size_t)(qrowA + qb * 32) * 512 + h * 64 + kk * 16 + hh * 8);
        AttnState st[2];
        const float sk = sink[h] * 1.4426950408889634f;
#pragma unroll
        for (int qb = 0; qb < 2; ++qb) { st[qb].m = sk; st[qb].l = hh == 0 ? 1.0f : 0.0f;
#pragma unroll
            for (int i = 0; i < 16; ++i) { st[qb].O[0][i] = 0.f; st[qb].O[1][i] = 0.f; } }
        if (!isc) {
            const int key0 = blk * 128 - 128;
            __syncthreads();
#pragma unroll
            for (int ps = 0; ps < 6; ++ps) { const int row = ps * 64 + (tid >> 3), seg = tid & 7; const int key = key0 + row;
                if (key >= 0 && key < SEQ) *(LAS u32x4*)(lds + row * AK_RS + seg * 16) = *(const u32x4*)(Kb + (size_t)(b * 4096 + key) * 128 + kvh * 64 + seg * 8); }
#pragma unroll
            for (int ps = 0; ps < 6; ++ps) { const int idx = ps * 512 + tid; const int d = idx / 48, seg = idx - d * 48; const int key = key0 + seg * 8;
                if (key >= 0 && key < SEQ) *(LAS u32x4*)(lds + AK_BYTES_BAND + d * AV_RS_BAND + seg * 16) = *(const u32x4*)(VT + ((size_t)(b * 128 + kvh * 64 + d)) * 4096 + key); }
            __syncthreads();
            const int q0 = blk * 128 + pp * 64;
            for (int kt = 0; kt < 12; ++kt) {
                const int klo = key0 + kt * 32;
                if (klo < 0 || klo >= SEQ) continue;
                if (klo + 31 < q0 - 128 || klo > q0 + 63 + 128) continue;
                const LAS unsigned char* kl = lds + (kt * 32 + ql) * AK_RS + hh * 16;
                const LAS unsigned char* vl = lds + AK_BYTES_BAND + ql * AV_RS_BAND + (kt * 32 + 4 * hh) * 2;
                const bool interior = (klo >= q0 + 63 - 128) && (klo + 31 <= q0 + 128);
                if (interior) attn_tile2<false>(st, Qf, kl, vl, AV_RS_BAND, lane, q0 + ql, klo);
                else attn_tile2<true>(st, Qf, kl, vl, AV_RS_BAND, lane, q0 + ql, klo);
            }
        }
        __syncthreads();
#pragma unroll
        for (int ps = 0; ps < 4; ++ps) { const int row = ps * 64 + (tid >> 3), seg = tid & 7;
            *(LAS u32x4*)(lds + row * AK_RS + seg * 16) = *(const u32x4*)(Kb + (size_t)(TL + b * 256 + row) * 128 + kvh * 64 + seg * 8); }
#pragma unroll
        for (int ps = 0; ps < 4; ++ps) { const int idx = ps * 512 + tid; const int d = idx >> 5, seg = idx & 31;
            *(LAS u32x4*)(lds + AK_BYTES_CTX + d * AV_RS_CTX + seg * 16) = *(const u32x4*)(VTC + ((size_t)(b * 128 + kvh * 64 + d)) * 256 + seg * 8); }
        __syncthreads();
        for (int kt = 0; kt < 8; ++kt) {
            const LAS unsigned char* kl = lds + (kt * 32 + ql) * AK_RS + hh * 16;
            const LAS unsigned char* vl = lds + AK_BYTES_CTX + ql * AV_RS_CTX + (kt * 32 + 4 * hh) * 2;
            attn_tile2<false>(st, Qf, kl, vl, AV_RS_CTX, lane, 0, 0);
        }
#pragma unroll
        for (int qb = 0; qb < 2; ++qb) {
            const float ltot = st[qb].l + shx(st[qb].l, 32, lane);
            const float inv = 1.0f / ltot;
            bf16_t* op = HB + (size_t)(qrowA + qb * 32) * HBS + 1024 + h * 64 + 4 * hh;
#pragma unroll
            for (int db = 0; db < 2; ++db)
#pragma unroll
                for (int g4 = 0; g4 < 4; ++g4) { u32x2 w; w.x = pk2(st[qb].O[db][4 * g4] * inv, st[qb].O[db][4 * g4 + 1] * inv); w.y = pk2(st[qb].O[db][4 * g4 + 2] * inv, st[qb].O[db][4 * g4 + 3] * inv);
                    *(u32x2*)(op + db * 32 + 8 * g4) = w; }
        }
    }
    __syncthreads();
}

DI void phase_sgu(const Params& P, int l, unsigned char* shm, int nchunk) {
    const int tid = otid(), wid = tid >> 6, lane = tid & 63, hh = lane >> 5, ql = lane & 31;
    bf16_t* vT = (bf16_t*)shm;
    const bf16_t* U = (const bf16_t*)(ows(P) + OFF_R + R_U); const bf16_t* Z = (const bf16_t*)(ows(P) + OFF_R + R_Z);
    bf16_t* HB = (bf16_t*)(ows(P) + OFF_HB);
    const float* lg = oin(P, I_SGULG) + l * 512; const float* lb = oin(P, I_SGULB) + l * 512;
    const float* sw = oin(P, I_SGUW) + (size_t)l * 4 * 128 * 128; const float* sb = oin(P, I_SGUB) + l * 4 * 128;
    float gg[8], bb[8];
#pragma unroll
    for (int j = 0; j < 8; ++j) { gg[j] = lg[j * 64 + lane]; bb[j] = lb[j * 64 + lane]; }
    for (int chunk = obid(); chunk < nchunk; chunk += gridDim.x) {
        const int r0 = chunk * 128;
        for (int tt = 0; tt < 16; ++tt) {
            const int tok = wid * 16 + tt; const bf16_t* zp = Z + (size_t)(r0 + tok) * 512;
            float z[8]; float sum = 0.f;
#pragma unroll
            for (int j = 0; j < 8; ++j) { z[j] = bf2f(zp[j * 64 + lane]); sum += z[j]; }
            const float mu = wave_sum(sum, lane) * (1.0f / 512.0f);
            float sq = 0.f;
#pragma unroll
            for (int j = 0; j < 8; ++j) { z[j] -= mu; sq += z[j] * z[j]; }
            const float rstd = rsqrtf(wave_sum(sq, lane) * (1.0f / 512.0f) + LN_EPS);
#pragma unroll
            for (int j = 0; j < 8; ++j) vT[(j * 64 + lane) * 136 + tok] = f2bf(z[j] * rstd * gg[j] + bb[j]);
        }
        __syncthreads();
        const int g = wid >> 1, cb = g * 128 + (wid & 1) * 64;
        for (int mb = 0; mb < 4; ++mb) {
            f32x16 acc[2];
#pragma unroll
            for (int i = 0; i < 16; ++i) { acc[0][i] = 0.f; acc[1][i] = 0.f; }
#pragma unroll
            for (int kc = 0; kc < 8; ++kc) {
                const float* wp = sw + ((size_t)(g * 128 + mb * 32 + ql)) * 128 + kc * 16 + hh * 8;
                const f32x4 w0 = *(const f32x4*)wp, w1 = *(const f32x4*)(wp + 4);
                u32x4 wa; wa.x = pk2(w0[0], w0[1]); wa.y = pk2(w0[2], w0[3]); wa.z = pk2(w1[0], w1[1]); wa.w = pk2(w1[2], w1[3]);
                const bf16x8 Af = __builtin_bit_cast(bf16x8, wa);
#pragma unroll
                for (int nb = 0; nb < 2; ++nb) { const bf16x8 Bf = *(const bf16x8*)(vT + (cb + nb * 32 + ql) * 136 + kc * 16 + hh * 8); acc[nb] = MFMA32(Af, Bf, acc[nb]); }
            }
#pragma unroll
            for (int nb = 0; nb < 2; ++nb)
#pragma unroll
                for (int i = 0; i < 16; ++i) { const int prow = mb * 32 + (i & 3) + 8 * (i >> 2) + 4 * hh; const int c = cb + nb * 32 + ql; const size_t row = (size_t)(r0 + prow);
                    const float val = (acc[nb][i] + sb[g * 128 + prow]) * bf2f(U[row * 512 + c]);
                    HB[row * HBS + 1536 + c] = f2bf(val); }
        }
        __syncthreads();
    }
}

__global__ void __launch_bounds__(512, 2) mega(Params P) {
    extern __shared__ __attribute__((aligned(16))) unsigned char shm[];
    LAS unsigned char* lds = (LAS unsigned char*)shm;
    cg::grid_group grid = cg::this_grid();
    volatile LAS unsigned* bst = (volatile LAS unsigned*)(lds + LDS_BYTES - 16);
    if (threadIdx.x == 0) { bst[0] = 0u; bst[1] = 0u; }
    if (blockIdx.x == 0) { unsigned* bw = (unsigned*)(P.ws + OFF_BAR); for (int i = threadIdx.x; i < XCD_BAR_WORDS; i += 512) bw[i] = 0u; }
    __syncthreads();

    phase_mods(P, shm);
    phase_tables(P, shm);
    phase_wconv(P, 0, 0, 0, gridDim.x, shm);
    grid.sync();
    const XcdBarrier gbar = xcd_barrier_post((unsigned*)(P.ws + OFF_BAR), bst);
#define GSYNC() xcd_barrier(gbar)
    phase_norm(P, nullptr, nullptr, (const float*)(ows(P) + OFF_MODS), 0, nullptr, T);
    GSYNC();

    for (int st = 0; st < 2 * DEPTH; ++st) {
        const int l = st >> 1, f = st & 1;
        const int npl = (l == DEPTH - 1) ? TL / 256 : T / 256;
        const int npf = f ? npl : T / 256;
        {
            unsigned char* ws = ows(P); bf16_t* W = (bf16_t*)(ws + OFF_W);
            SchedTile S; S.init(ws + OFF_HB, 256ull * HBS * 2, W + (f ? W_UP1 : W_UP0), 256ull * 1024 * 2, npf, NUP / 256);
            EpiUp E; E.act = (bf16_t*)(ws + OFF_R);
            for (int rep = 0; rep < REP_UP; ++rep) gemm_phase<1024, HBS, 1024>(lds, S, E);
        }
        GSYNC();
        for (int es = 0; es < EXTRA_SYNCS; ++es) GSYNC();
        {
            unsigned char* ws = ows(P); bf16_t* W = (bf16_t*)(ws + OFF_W);
            SchedTile S; S.init(ws + OFF_R, 256ull * DFFP * 2, W + (f ? W_DN1 : W_DN0), 256ull * DFFP * 2, npf, 4);
            EpiRes E; E.X = (float*)(ws + OFF_X); E.gm = (const float*)(ws + OFF_MODS) + (size_t)l * 9 * 9216 + (f ? 8 : 2) * 1024; E.s = 0.5f; E.stats = (const float*)(ws + OFF_STATS);
            { const int li = f ? (l * 3 + 1) : (st == 0 ? 0 : l * 3 - 1); E.lg = oin(P, I_LNG) + li * 1024; E.lb = oin(P, I_LNB) + li * 1024; E.ident = (st == 0) ? 1 : 0; }
            gemm_phase<DFFP, DFFP, DFFP>(lds, S, E);
        }
        if (f == 0) {
            phase_wconv(P, l, 2, 32, gridDim.x - 32, shm);
            phase_wconv(P, l, 1, 32, gridDim.x - 32, shm);
        }
        GSYNC();
        if (f == 0) {
            phase_norm(P, oin(P, I_LNG) + (l * 3 + 0) * 1024, oin(P, I_LNB) + (l * 3 + 0) * 1024, (const float*)(ows(P) + OFF_MODS) + (size_t)l * 9 * 9216, 3, nullptr, T);
            GSYNC();
            {
                unsigned char* ws = ows(P); bf16_t* W = (bf16_t*)(ws + OFF_W); unsigned char* R = ws + OFF_R;
                SchedTile S; S.init(ws + OFF_HB, 256ull * HBS * 2, W + W_IN, 256ull * 1024 * 2, T / 256, 7);
                EpiIn E; E.Q = (bf16_t*)(R + R_Q); E.Kb = (bf16_t*)(R + R_K); E.VT = (bf16_t*)(R + R_VT); E.VTC = (bf16_t*)(R + R_VTC); E.U = (bf16_t*)(R + R_U); E.Z = (bf16_t*)(R + R_Z);
                E.ropec = (const float*)(ws + OFF_ROPE); E.ropes = E.ropec + 1024;
                for (int rep = 0; rep < REP_IN; ++rep) gemm_phase<1024, HBS, 1024>(lds, S, E);
            }
            {
                unsigned char* ws = ows(P); bf16_t* W = (bf16_t*)(ws + OFF_W); unsigned char* R = ws + OFF_R;
                SchedTile S; S.init(W + W_F, 256ull * 1024 * 2, ws + OFF_HB, 256ull * HBS * 2, 4, npl);
                EpiFT E; E.FT = (bf16_t*)(R + R_FT); E.FTC = (bf16_t*)(R + R_FTC);
                for (int rep = 0; rep < REP_IN; ++rep) gemm_phase<1024, 1024, HBS>(lds, S, E);
            }
            GSYNC();
            {
                unsigned char* ws = ows(P); unsigned char* R = ws + OFF_R;
                SchedTile S; S.init(ws + OFF_DFT, 256ull * 8192 * 2, R + R_FT, 256ull * 8192 * 2, 16, 16);
                EpiDft E; E.HB = (bf16_t*)(ws + OFF_HB); E.rowbase = 0; E.rpb = 4096;
                for (int rep = 0; rep < REP_DFT; ++rep) gemm_phase<8192, 8192, 8192>(lds, S, E);
            }
            if (l < DEPTH - 1) {
                unsigned char* ws = ows(P); unsigned char* R = ws + OFF_R;
                SchedTile S; S.init(ws + OFF_DFTC, 0, R + R_FTC, 256ull * 512 * 2, 1, 16);
                EpiDft E; E.HB = (bf16_t*)(ws + OFF_HB); E.rowbase = TL; E.rpb = 256;
                gemm_phase<512, 512, 512>(lds, S, E);
            }
            for (int rep = 0; rep < REP_ATT; ++rep) phase_attn(P, l, l < DEPTH - 1, lds);
            for (int rep = 0; rep < REP_SGU; ++rep) phase_sgu(P, l, shm, npl * 2);
            GSYNC();
            {
                unsigned char* ws = ows(P); bf16_t* W = (bf16_t*)(ws + OFF_W); unsigned char* R = ws + OFF_R;
                SchedBr S; S.HBp = (const char*)(ws + OFF_HB); S.Wc = (const char*)(W + W_CAT); S.G = gridDim.x; S.c = obid(); S.ntiles = npl * 4;
                EpiBr E; E.merged = (bf16_t*)(R + R_MERGED); E.scr = R + R_SCR + (size_t)obid() * (3 * 131072);
                for (int rep = 0; rep < REP_BR; ++rep) gemm_phase<512, HBS, 1536>(lds, S, E);
            }
            if (l < DEPTH - 1) phase_wconv(P, l + 1, 0, 32, gridDim.x - 32, shm);
            GSYNC();
            {
                unsigned char* ws = ows(P); bf16_t* W = (bf16_t*)(ws + OFF_W); unsigned char* R = ws + OFF_R;
                SchedTile S; S.init(R + R_MERGED, 256ull * 1024 * 2, W + W_OUT, 256ull * 1024 * 2, npl, 4);
                EpiRes E; E.X = (float*)(ws + OFF_X); E.gm = (const float*)(ws + OFF_MODS) + (size_t)l * 9 * 9216 + 5 * 1024; E.s = 1.0f; E.stats = (const float*)(ws + OFF_STATS); E.lg = oin(P, I_LNG) + (l * 3) * 1024; E.lb = oin(P, I_LNB) + (l * 3) * 1024; E.ident = 0;
                gemm_phase<1024, 1024, 1024>(lds, S, E);
            }
            GSYNC();
            phase_norm(P, oin(P, I_LNG) + (l * 3 + 1) * 1024, oin(P, I_LNB) + (l * 3 + 1) * 1024, (const float*)(ows(P) + OFF_MODS) + (size_t)l * 9 * 9216, 6, nullptr, npl * 256);
            GSYNC();
        } else {
            const bool lastl = (l == DEPTH - 1);
            phase_norm(P, oin(P, I_LNG) + (l * 3 + 2) * 1024, oin(P, I_LNB) + (l * 3 + 2) * 1024, lastl ? nullptr : (const float*)(ows(P) + OFF_MODS) + (size_t)(l + 1) * 9 * 9216, 0, lastl ? P.out : nullptr, npl * 256);
            if (!lastl) GSYNC();
        }
    }
}

extern "C" void kernel_launch(void* const* d_in, const int* in_sizes, int n_in, void* d_out, int out_size, void* d_ws, size_t ws_size, hipStream_t stream) {
    static int grid_blocks = 0;
    if (!grid_blocks) {
        int dev = 0, cus = 0, per_cu = 0;
        hipGetDevice(&dev);
        hipDeviceGetAttribute(&cus, hipDeviceAttributeMultiprocessorCount, dev);
        if (hipFuncSetAttribute((const void*)mega, hipFuncAttributeMaxDynamicSharedMemorySize, LDS_BYTES) != hipSuccess) fprintf(stderr, "hipFuncSetAttribute failed\n");
        hipOccupancyMaxActiveBlocksPerMultiprocessor(&per_cu, (const void*)mega, 512, LDS_BYTES);
        if (per_cu < 1) { fprintf(stderr, "occupancy query gave %d\n", per_cu); per_cu = 1; }
        (void)hipGetLastError();
        grid_blocks = cus * per_cu;
        if (grid_blocks > 256) grid_blocks = 256;
        if (ws_size < WS_END) fprintf(stderr, "workspace too small: %zu < %zu\n", ws_size, (size_t)WS_END);
    }
    Params p{};
    for (int i = 0; i < 19; ++i) p.in[i] = (const float*)d_in[i];
    p.out = (float*)d_out; p.ws = (unsigned char*)d_ws;
    void* args[] = {&p};
    hipError_t e = hipLaunchCooperativeKernel((const void*)mega, dim3(grid_blocks), dim3(512), args, LDS_BYTES, stream);
    if (e != hipSuccess) fprintf(stderr, "cooperative launch failed: %s (grid %d)\n", hipGetErrorString(e), grid_blocks);
}
```

```cpp
#include <hip/hip_runtime.h>
#include <hip/hip_cooperative_groups.h>
#include <cstdio>
namespace cg = cooperative_groups;
#define REP_UP 1
#define REP_IN 1
#define REP_DFT 1
#define REP_ATT 1
#define REP_SGU 1
#define REP_BR 1
#define REP_WCONV 1
#define EXTRA_SYNCS 0

#define LAS __attribute__((address_space(3)))
#define DI __device__ __forceinline__
typedef unsigned short bf16_t;
typedef short bf16x8 __attribute__((ext_vector_type(8)));
typedef float f32x2 __attribute__((ext_vector_type(2)));
typedef float f32x4 __attribute__((ext_vector_type(4)));
typedef float f32x16 __attribute__((ext_vector_type(16)));
typedef unsigned u32x2 __attribute__((ext_vector_type(2)));
typedef unsigned u32x4 __attribute__((ext_vector_type(4)));
typedef __bf16 bfv2 __attribute__((ext_vector_type(2)));

constexpr int D = 1024, NB = 8, SEQ = 4096, DEPTH = 4, CTXL = 256;
constexpr int TL = NB * SEQ, TC = NB * CTXL, T = TL + TC;
constexpr int DFF = 2752, DFFP = 2816, NUP = 5632;
constexpr int HBS = 2560;
constexpr float ALPHA = 1.681792830507429f;
constexpr float LN_EPS = 1e-5f;
constexpr int LDS_BYTES = 144 * 1024;

constexpr size_t OFF_MODS = 0;
constexpr size_t SZ_MODS = 4ull * 9 * 9216 * 4;
constexpr size_t OFF_ROPE = OFF_MODS + SZ_MODS;
constexpr size_t SZ_ROPE = 2ull * 64 * 16 * 4;
constexpr size_t OFF_DFT = OFF_ROPE + SZ_ROPE;
constexpr size_t SZ_DFT = 4096ull * 8192 * 2;
constexpr size_t OFF_DFTC = OFF_DFT + SZ_DFT;
constexpr size_t SZ_DFTC = 256ull * 512 * 2;
constexpr size_t OFF_W = OFF_DFTC + SZ_DFTC;
constexpr size_t W_UP0 = 0, W_DN0 = W_UP0 + 5632ull * 1024, W_UP1 = W_DN0 + 1024ull * 2816, W_DN1 = W_UP1 + 5632ull * 1024,
                 W_IN = W_DN1 + 1024ull * 2816, W_F = W_IN + 1792ull * 1024, W_CAT = W_F + 1024ull * 1024,
                 W_OUT = W_CAT + 3ull * 1024 * 1536, W_END = W_OUT + 1024ull * 1024;
constexpr size_t SZ_W = W_END * 2;
constexpr size_t OFF_X = OFF_W + SZ_W;
constexpr size_t SZ_X = (size_t)T * 1024 * 4;
constexpr size_t OFF_HB = OFF_X + SZ_X;
constexpr size_t SZ_HB = (size_t)T * HBS * 2;
constexpr size_t OFF_R = OFF_HB + SZ_HB;
constexpr size_t R_Q = 0;
constexpr size_t R_U = R_Q + (size_t)T * 512 * 2;
constexpr size_t R_Z = R_U + (size_t)T * 512 * 2;
constexpr size_t R_K = R_Z + (size_t)T * 512 * 2;
constexpr size_t R_VT = R_K + (size_t)T * 128 * 2;
constexpr size_t R_VTC = R_VT + 8ull * 128 * 4096 * 2;
constexpr size_t R_FT = R_VTC + 8ull * 128 * 256 * 2;
constexpr size_t R_FTC = R_FT + 8ull * 512 * 8192 * 2;
constexpr size_t R_END = R_FTC + 8ull * 512 * 512 * 2;
constexpr size_t SZ_R = (size_t)T * DFFP * 2;
static_assert(R_END == SZ_R, "region R");
constexpr size_t R_MERGED = R_Q;
constexpr size_t R_SCR = R_Z;
constexpr size_t OFF_BAR = OFF_R + SZ_R;
constexpr size_t SZ_BAR = 16384;
constexpr size_t OFF_STATS = OFF_BAR + SZ_BAR;
constexpr size_t SZ_STATS = (size_t)T * 2 * 4;
constexpr size_t WS_END = OFF_STATS + SZ_STATS;
static_assert(WS_END <= 721420288ull, "workspace");
static_assert(256ull * 3 * 131072 <= R_END - R_Z, "scr");

struct Params { const float* in[19]; float* out; unsigned char* ws; };
enum { I_X = 0, I_C, I_CTX, I_CCTX, I_WMOD, I_BMOD, I_WUP, I_WDN, I_LNG, I_LNB, I_WIN, I_SINK, I_SGUW, I_SGUB, I_SGULG, I_SGULB, I_WGATE, I_WBR, I_WOUT };

DI unsigned pk2(float a, float b) { f32x2 v = {a, b}; bfv2 r = __builtin_convertvector(v, bfv2); return __builtin_bit_cast(unsigned, r); }
DI bf16_t f2bf(float a) { return (bf16_t)(pk2(a, 0.f) & 0xffffu); }
DI float bf2f(unsigned b) { return __uint_as_float(b << 16); }
DI float bflo(unsigned w) { return __uint_as_float(w << 16); }
DI float bfhi(unsigned w) { return __uint_as_float(w & 0xffff0000u); }
DI float sigmoidf_(float x) { return 1.0f / (1.0f + __expf(-x)); }
DI float siluf_(float x) { return x / (1.0f + __expf(-x)); }
DI float geluf_(float x) { const float y = 1.5957691216057308f * (x + 0.044715f * x * x * x); return x / (1.0f + __expf(-y)); }
DI int otid() { int t = threadIdx.x; asm volatile("" : "+v"(t)); return t; }
DI int obid() { int b = blockIdx.x; asm volatile("" : "+s"(b)); return b; }
DI unsigned char* ows(const Params& P) { unsigned char* w = P.ws; asm volatile("" : "+s"(w)); return w; }
DI const float* oin(const Params& P, int i) { const float* p = P.in[i]; asm volatile("" : "+s"(p)); return p; }
DI float shx(float v, int o, int lane) { return __int_as_float(__builtin_amdgcn_ds_bpermute((lane ^ o) << 2, __float_as_int(v))); }
DI float wave_sum(float v, int lane) {
#pragma unroll
    for (int o = 32; o >= 1; o >>= 1) v += shx(v, o, lane);
    return v;
}

constexpr int BM = 256, BK = 64, HALF = 128, HTB = HALF * BK * 2, NXCD = 8, WGM = 8;
DI int lds_byte(int r, int c) { const int st = (r >> 4) * 2 + (c >> 5), rr = r & 15, cc = c & 31, ob = rr * 64 + cc * 2; return st * 1024 + (ob ^ (((ob >> 9) & 1) << 5)); }
DI void stage_rc(int b, int& R, int& C) { const int st = b / 1024, sb = b % 1024, swz = sb ^ (((sb >> 9) & 1) << 5); R = (st >> 1) * 16 + swz / 64; C = (st & 1) * 32 + (swz % 64) / 2; }

struct Unit { int pm, pn, aux; };

struct SchedTile {
    const char* Ab; const char* Bb; size_t tA, tB; int nM, nN, nwg, G, c;
    DI void init(const void* A, size_t tA_, const void* B, size_t tB_, int nM_, int nN_) { Ab = (const char*)A; Bb = (const char*)B; tA = tA_; tB = tB_; nM = nM_; nN = nN_; nwg = nM * nN; G = gridDim.x; c = obid(); }
    DI bool next(int i, Unit& u) const {
        const long L = (long)i * G + c; if (L >= nwg) return false;
        int wgid = (int)L; { const int q = nwg / NXCD, r = nwg % NXCD, xcd = wgid % NXCD, off = wgid / NXCD; wgid = (xcd < r ? xcd * (q + 1) : r * (q + 1) + (xcd - r) * q) + off; }
        const int nig = WGM * nN, gid = wgid / nig, fm = gid * WGM, gsz = (nM - fm) < WGM ? (nM - fm) : WGM;
        u.pm = fm + ((wgid % nig) % gsz); u.pn = (wgid % nig) / gsz; u.aux = 0; return true;
    }
    DI const char* A(const Unit& u) const { return Ab + (size_t)u.pm * tA; }
    DI const char* B(const Unit& u) const { return Bb + (size_t)u.pn * tB; }
};

struct SchedBr {
    const char* HBp; const char* Wc; int G, c, ntiles;
    DI bool next(int i, Unit& u) const { const int ti = (i / 9) * G + c; if (ti >= ntiles) return false; u.pm = ti >> 2; u.pn = ti & 3; u.aux = i % 9; return true; }
    DI const char* A(const Unit& u) const { const int off = u.aux < 6 ? (u.aux & 1) * 512 : 1024 + (u.aux - 6) * 512; return HBp + ((size_t)u.pm * 256 * HBS + off) * 2; }
    DI const char* B(const Unit& u) const { const int r = u.aux < 6 ? (u.aux >> 1) : (u.aux - 6); const int off = u.aux < 6 ? 512 + (u.aux & 1) * 512 : 0; return Wc + ((size_t)(r * 1024 + u.pn * 256) * 1536 + off) * 2; }
};

template <int K, int lda, int ldb, class Epi, class Sched>
DI void gemm_phase(LAS unsigned char* lds, const Sched& S, const Epi& E) {
    const int tid = otid(), wid = __builtin_amdgcn_readfirstlane(tid >> 6), lane = tid & 63, wr = wid >> 2, wc = wid & 3, fr = lane & 15, fq = lane >> 4;
    constexpr int nt = K / BK;
    unsigned voffA[2], voffB[2];
#pragma unroll
    for (int i = 0; i < 2; ++i) { int R, C; stage_rc(tid * 16 + i * 8192, R, C); voffA[i] = (unsigned)(R * lda + C) * 2u; voffB[i] = (unsigned)(R * ldb + C) * 2u; }
    constexpr size_t kstep = (size_t)(BK * 2);
    constexpr size_t hstepA = (size_t)HALF * lda * 2, hstepB = (size_t)HALF * ldb * 2;
    const unsigned ldsw = (unsigned)wid * 1024u;
    const int aoff = lds_byte(wr * 64 + fr, fq * 8), boff = lds_byte(wc * 32 + fr, fq * 8);
#define PG8_SA(b, h) (((b) * 2 + (h)) * HTB)
#define PG8_SB(b, h) ((4 + (b) * 2 + (h)) * HTB)
#define PG8_STAGE(bufoff, gbase, voff) do { _Pragma("unroll") for (int _i = 0; _i < 2; ++_i) \
        __builtin_amdgcn_global_load_lds((const unsigned*)((const char*)(gbase) + (voff)[_i]), (LAS unsigned*)(lds + (bufoff) + ldsw + _i * 8192), 16, 0, 0); } while (0)
#define PG8_LDA(dst, b, h) do { _Pragma("unroll") for (int m = 0; m < 4; ++m) _Pragma("unroll") for (int k = 0; k < 2; ++k) dst[m][k] = *(const LAS bf16x8*)(lds + PG8_SA(b, h) + aoff + m * 2048 + k * 1024); } while (0)
#define PG8_LDB(dst, b, h) do { _Pragma("unroll") for (int n = 0; n < 2; ++n) _Pragma("unroll") for (int k = 0; k < 2; ++k) dst[n][k] = *(const LAS bf16x8*)(lds + PG8_SB(b, h) + boff + n * 2048 + k * 1024); } while (0)
#define PG8_MMA(ai, bj, At, Bt) do { __builtin_amdgcn_s_setprio(1); _Pragma("unroll") for (int m = 0; m < 4; ++m) _Pragma("unroll") for (int n = 0; n < 2; ++n) _Pragma("unroll") for (int k = 0; k < 2; ++k) \
        acc[ai][bj][m][n] = __builtin_amdgcn_mfma_f32_16x16x32_bf16(Bt[n][k], At[m][k], acc[ai][bj][m][n], 0, 0, 0); __builtin_amdgcn_s_setprio(0); } while (0)
#define PG8_WAIT_V(n) asm volatile("s_waitcnt vmcnt(" #n ")" ::: "memory")
#define PG8_WAIT_L(n) asm volatile("s_waitcnt lgkmcnt(" #n ")" ::: "memory")
#define PG8_BAR __builtin_amdgcn_s_barrier()
#define PG8_SCHED __builtin_amdgcn_sched_barrier(0)
    Unit cur, nxt; int ui = 0;
    if (!S.next(0, cur)) return;
    f32x4 acc[2][2][4][2];
#pragma unroll
    for (int a = 0; a < 2; ++a)
#pragma unroll
        for (int b = 0; b < 2; ++b)
#pragma unroll
            for (int m = 0; m < 4; ++m)
#pragma unroll
                for (int n = 0; n < 2; ++n) acc[a][b][m][n] = (f32x4){0.f, 0.f, 0.f, 0.f};
    bf16x8 At[4][2], B0[2][2], B1[2][2];
    const char* cA = S.A(cur); const char* cB = S.B(cur);
    PG8_STAGE(PG8_SB(0, 0), cB, voffB); PG8_STAGE(PG8_SA(0, 0), cA, voffA); PG8_STAGE(PG8_SB(0, 1), cB + hstepB, voffB); PG8_STAGE(PG8_SA(0, 1), cA + hstepA, voffA);
    if (wr == 1) PG8_BAR;
    PG8_WAIT_V(4); PG8_BAR;
    PG8_STAGE(PG8_SB(1, 0), cB + kstep, voffB); PG8_STAGE(PG8_SA(1, 0), cA + kstep, voffA); PG8_STAGE(PG8_SB(1, 1), cB + hstepB + kstep, voffB);
    PG8_WAIT_V(6); PG8_BAR;
    for (;;) {
        const bool has_next = S.next(ui + 1, nxt);
        const char* nA = has_next ? S.A(nxt) : cA; const char* nB = has_next ? S.B(nxt) : cB;
        for (int t = 0; t < nt; t += 2) {
            const bool last = (t == nt - 2);
            const char* a1 = cA + (size_t)(t + 1) * kstep;
            const char* a2 = last ? nA : cA + (size_t)(t + 2) * kstep; const char* b2 = last ? nB : cB + (size_t)(t + 2) * kstep;
            const char* a3 = a2 + kstep; const char* b3 = b2 + kstep;
            PG8_LDB(B0, 0, 0); PG8_SCHED; PG8_LDA(At, 0, 0); PG8_STAGE(PG8_SA(1, 1), a1 + hstepA, voffA);
            PG8_WAIT_L(8); PG8_BAR; PG8_WAIT_L(0); PG8_MMA(0, 0, At, B0); PG8_BAR; PG8_SCHED;
            PG8_LDB(B1, 0, 1); PG8_STAGE(PG8_SB(0, 0), b2, voffB);
            PG8_BAR; PG8_WAIT_L(0); PG8_MMA(0, 1, At, B1); PG8_BAR;
            PG8_LDA(At, 0, 1); PG8_STAGE(PG8_SA(0, 0), a2, voffA);
            PG8_BAR; PG8_WAIT_L(0); PG8_MMA(1, 0, At, B0); PG8_BAR; PG8_SCHED;
            PG8_STAGE(PG8_SB(0, 1), b2 + hstepB, voffB);
            PG8_WAIT_V(6); PG8_BAR; PG8_MMA(1, 1, At, B1); PG8_BAR;
            PG8_LDB(B0, 1, 0); PG8_SCHED; PG8_LDA(At, 1, 0); PG8_STAGE(PG8_SA(0, 1), a2 + hstepA, voffA);
            PG8_WAIT_L(8); PG8_BAR; PG8_WAIT_L(0); PG8_MMA(0, 0, At, B0); PG8_BAR; PG8_SCHED;
            PG8_LDB(B1, 1, 1); PG8_STAGE(PG8_SB(1, 0), b3, voffB);
            PG8_BAR; PG8_WAIT_L(0); PG8_MMA(0, 1, At, B1); PG8_BAR;
            PG8_LDA(At, 1, 1); PG8_STAGE(PG8_SA(1, 0), a3, voffA);
            PG8_BAR; PG8_WAIT_L(0); PG8_MMA(1, 0, At, B0); PG8_BAR; PG8_SCHED;
            PG8_STAGE(PG8_SB(1, 1), b3 + hstepB, voffB);
            PG8_WAIT_V(6); PG8_BAR; PG8_MMA(1, 1, At, B1); PG8_BAR;
        }
        const bool zero = E(acc, cur, wr, wc, fr, fq);
        if (!has_next) break;
        if (zero) {
#pragma unroll
            for (int a = 0; a < 2; ++a)
#pragma unroll
                for (int b = 0; b < 2; ++b)
#pragma unroll
                    for (int m = 0; m < 4; ++m)
#pragma unroll
                        for (int n = 0; n < 2; ++n) acc[a][b][m][n] = (f32x4){0.f, 0.f, 0.f, 0.f};
        }
        cur = nxt; cA = nA; cB = nB; ++ui;
    }
    PG8_WAIT_V(0);
    if (wr == 0) PG8_BAR;
    PG8_BAR;
#undef PG8_SA
#undef PG8_SB
#undef PG8_STAGE
#undef PG8_LDA
#undef PG8_LDB
#undef PG8_MMA
#undef PG8_WAIT_V
#undef PG8_WAIT_L
#undef PG8_BAR
#undef PG8_SCHED
}

typedef f32x4 AccT[2][2][4][2];

struct EpiUp {
    bf16_t* act;
    DI bool operator()(AccT& acc, const Unit& u, int wr, int wc, int fr, int fq) const {
        asm volatile("" : "+v"(fr)); asm volatile("" : "+v"(fq));
        const int row0 = u.pm * BM + wr * 64 + fr, c0 = u.pn * 128 + wc * 16 + 4 * fq;
#pragma unroll
        for (int ai = 0; ai < 2; ++ai)
#pragma unroll
            for (int m = 0; m < 4; ++m) { bf16_t* rowp = act + (size_t)(row0 + ai * HALF + m * 16) * DFFP + c0;
#pragma unroll
                for (int bj = 0; bj < 2; ++bj) { const f32x4 g = acc[ai][bj][m][0], up = acc[ai][bj][m][1];
                    u32x2 w; w.x = pk2(siluf_(g[0]) * up[0], siluf_(g[1]) * up[1]); w.y = pk2(siluf_(g[2]) * up[2], siluf_(g[3]) * up[3]);
                    *(u32x2*)(rowp + bj * 64) = w; } }
        return true;
    }
};

struct EpiRes {
    float* X; const float* gm; const float* stats; const float* lg; const float* lb; float s; int ident;
    DI bool operator()(AccT& acc, const Unit& u, int wr, int wc, int fr, int fq) const {
        asm volatile("" : "+v"(fr)); asm volatile("" : "+v"(fq));
        const int row0 = u.pm * BM + wr * 64 + fr, col0 = u.pn * BM + wc * 32 + 4 * fq;
        const int rb = (u.pm * BM < TL) ? ((u.pm * BM) >> 12) : 8;
        const float* gp = gm + (size_t)rb * 9216 + col0;
        const float sv = s; const f32x4 s4 = (f32x4){sv, sv, sv, sv};
        f32x4 gv[2][2], gl[2][2], bl[2][2];
#pragma unroll
        for (int bj = 0; bj < 2; ++bj)
#pragma unroll
            for (int n = 0; n < 2; ++n) { gv[bj][n] = *(const f32x4*)(gp + bj * HALF + n * 16) * s4;
                gl[bj][n] = *(const f32x4*)(lg + col0 + bj * HALF + n * 16) * ALPHA; bl[bj][n] = *(const f32x4*)(lb + col0 + bj * HALF + n * 16) * ALPHA;
                if (ident) { gl[bj][n] = (f32x4){ALPHA, ALPHA, ALPHA, ALPHA}; bl[bj][n] = (f32x4){0.f, 0.f, 0.f, 0.f}; } }
#pragma unroll
        for (int ai = 0; ai < 2; ++ai)
#pragma unroll
            for (int m = 0; m < 4; ++m) { const int row = row0 + ai * HALF + m * 16; float* rowp = X + (size_t)row * D + col0;
                float mu = stats[(size_t)row * 2], rstd = stats[(size_t)row * 2 + 1];
                if (ident) { mu = 0.f; rstd = 1.f; }
#pragma unroll
                for (int bj = 0; bj < 2; ++bj)
#pragma unroll
                    for (int n = 0; n < 2; ++n) { f32x4* px = (f32x4*)(rowp + bj * HALF + n * 16); const f32x4 t = *px; *px = ((t - mu) * rstd) * gl[bj][n] + bl[bj][n] + gv[bj][n] * acc[ai][bj][m][n]; } }
        return true;
    }
};

struct EpiIn {
    bf16_t* Q; bf16_t* Kb; bf16_t* VT; bf16_t* VTC; bf16_t* U; bf16_t* Z; const float* ropec; const float* ropes;
    DI bool operator()(AccT& acc, const Unit& u, int wr, int wc, int fr, int fq) const {
        asm volatile("" : "+v"(fr)); asm volatile("" : "+v"(fq));
        const int row0 = u.pm * BM + wr * 64 + fr;
        const bool lat = (u.pm * BM) < TL;
        const int pn = u.pn;
#pragma unroll
        for (int ai = 0; ai < 2; ++ai)
#pragma unroll
            for (int m = 0; m < 4; ++m) {
                const int row = row0 + ai * HALF + m * 16;
                if (pn <= 2) {
                    const int s = row & 4095;
                    const int p = (wc & 1) ? (s & 63) : (s >> 6);
                    f32x4 cs = (f32x4){1.f, 1.f, 1.f, 1.f}, sn = (f32x4){0.f, 0.f, 0.f, 0.f};
                    if (lat) { cs = *(const f32x4*)(ropec + p * 16 + 4 * fq); sn = *(const f32x4*)(ropes + p * 16 + 4 * fq); }
#pragma unroll
                    for (int bj = 0; bj < 2; ++bj) {
                        const f32x4 x1 = acc[ai][bj][m][0], x2 = acc[ai][bj][m][1];
                        if (pn < 2 || bj == 0) {
                            const f32x4 o1 = x1 * cs - x2 * sn, o2 = x1 * sn + x2 * cs;
                            u32x2 w1, w2; w1.x = pk2(o1[0], o1[1]); w1.y = pk2(o1[2], o1[3]); w2.x = pk2(o2[0], o2[1]); w2.y = pk2(o2[2], o2[3]);
                            bf16_t* dst = (pn < 2) ? (Q + (size_t)row * 512 + pn * 256 + bj * HALF + wc * 32 + 4 * fq) : (Kb + (size_t)row * 128 + wc * 32 + 4 * fq);
                            *(u32x2*)dst = w1; *(u32x2*)(dst + 16) = w2;
                        } else {
                            const int cv = wc * 32 + 4 * fq;
                            bf16_t* dst; size_t cst;
                            if (lat) { const int b = row >> 12; dst = VT + ((size_t)(b * 128 + cv)) * 4096 + s; cst = 4096; }
                            else { const int rc = row - TL; const int b = rc >> 8; dst = VTC + ((size_t)(b * 128 + cv)) * 256 + (rc & 255); cst = 256; }
#pragma unroll
                            for (int j = 0; j < 4; ++j) { dst[(size_t)j * cst] = f2bf(x1[j]); dst[(size_t)(16 + j) * cst] = f2bf(x2[j]); }
                        }
                    }
                } else {
                    bf16_t* base = (pn <= 4) ? (U + (size_t)row * 512 + (pn - 3) * 256) : (Z + (size_t)row * 512 + (pn - 5) * 256);
                    base += wc * 32 + 4 * fq;
#pragma unroll
                    for (int bj = 0; bj < 2; ++bj)
#pragma unroll
                        for (int n = 0; n < 2; ++n) { const f32x4 v = acc[ai][bj][m][n];
                            u32x2 w; w.x = pk2(geluf_(v[0]), geluf_(v[1])); w.y = pk2(geluf_(v[2]), geluf_(v[3]));
                            *(u32x2*)(base + bj * HALF + n * 16) = w; }
                }
            }
        return true;
    }
};

struct EpiFT {
    bf16_t* FT; bf16_t* FTC;
    DI bool operator()(AccT& acc, const Unit& u, int wr, int wc, int fr, int fq) const {
        asm volatile("" : "+v"(fr)); asm volatile("" : "+v"(fq));
        const int isS = u.pm >> 1;
        const int ch0 = (u.pm & 1) * 256 + wr * 64 + fr;
        bf16_t* base; size_t rst;
        if (u.pn < 128) { const int b = u.pn >> 4; base = FT + (size_t)b * 512 * 8192 + isS * 4096 + ((u.pn & 15) * 256) + wc * 32 + 4 * fq; rst = 8192; }
        else { const int b = u.pn - 128; base = FTC + (size_t)b * 512 * 512 + isS * 256 + wc * 32 + 4 * fq; rst = 512; }
#pragma unroll
        for (int ai = 0; ai < 2; ++ai)
#pragma unroll
            for (int m = 0; m < 4; ++m) { bf16_t* rowp = base + (size_t)(ch0 + ai * HALF + m * 16) * rst;
#pragma unroll
                for (int bj = 0; bj < 2; ++bj)
#pragma unroll
                    for (int n = 0; n < 2; ++n) { const f32x4 v = acc[ai][bj][m][n]; u32x2 w; w.x = pk2(v[0], v[1]); w.y = pk2(v[2], v[3]); *(u32x2*)(rowp + bj * HALF + n * 16) = w; } }
        return true;
    }
};

struct EpiDft {
    bf16_t* HB; int rowbase, rpb;
    DI bool operator()(AccT& acc, const Unit& u, int wr, int wc, int fr, int fq) const {
        asm volatile("" : "+v"(fr)); asm volatile("" : "+v"(fq));
        const int b = u.pn >> 1;
        const int k0 = u.pm * BM + wr * 64 + fr;
        bf16_t* base = HB + (size_t)(rowbase + b * rpb) * HBS + 2048 + (u.pn & 1) * 256 + wc * 32 + 4 * fq;
#pragma unroll
        for (int ai = 0; ai < 2; ++ai)
#pragma unroll
            for (int m = 0; m < 4; ++m) { bf16_t* rowp = base + (size_t)(k0 + ai * HALF + m * 16) * HBS;
#pragma unroll
                for (int bj = 0; bj < 2; ++bj)
#pragma unroll
                    for (int n = 0; n < 2; ++n) { const f32x4 v = acc[ai][bj][m][n]; u32x2 w; w.x = pk2(v[0], v[1]); w.y = pk2(v[2], v[3]); *(u32x2*)(rowp + bj * HALF + n * 16) = w; } }
        return true;
    }
};

struct EpiBr {
    bf16_t* merged; unsigned char* scr;
    DI bool operator()(AccT& acc, const Unit& u, int wr, int wc, int fr, int fq) const {
        asm volatile("" : "+v"(fr)); asm volatile("" : "+v"(fq));
        const int sub = u.aux;
        const int tid = (wr * 4 + wc) * 64 + fq * 16 + fr;
        const int r = sub < 6 ? (sub >> 1) : (sub - 6);
        unsigned char* sp = scr + (size_t)r * 131072 + (size_t)tid * 16;
        if (sub < 6 && (sub & 1)) {
#pragma unroll
            for (int ai = 0; ai < 2; ++ai)
#pragma unroll
                for (int bj = 0; bj < 2; ++bj)
#pragma unroll
                    for (int m = 0; m < 4; ++m) { const f32x4 a = acc[ai][bj][m][0], b = acc[ai][bj][m][1];
                        u32x4 w; w.x = pk2(sigmoidf_(a[0]), sigmoidf_(a[1])); w.y = pk2(sigmoidf_(a[2]), sigmoidf_(a[3])); w.z = pk2(sigmoidf_(b[0]), sigmoidf_(b[1])); w.w = pk2(sigmoidf_(b[2]), sigmoidf_(b[3]));
                        *(u32x4*)(sp + (size_t)(((ai * 2 + bj) * 4 + m) * 8192)) = w; }
        }
        if (sub == 8) {
            const int row0 = u.pm * BM + wr * 64 + fr, col0 = u.pn * BM + wc * 32 + 4 * fq;
#pragma unroll
            for (int ai = 0; ai < 2; ++ai)
#pragma unroll
                for (int bj = 0; bj < 2; ++bj)
#pragma unroll
                    for (int m = 0; m < 4; ++m) {
                        const u32x4 g = *(const u32x4*)(sp + (size_t)(((ai * 2 + bj) * 4 + m) * 8192));
                        const f32x4 a = acc[ai][bj][m][0], b = acc[ai][bj][m][1];
                        bf16_t* dst = merged + (size_t)(row0 + ai * HALF + m * 16) * D + col0 + bj * HALF;
                        u32x2 w0, w1; w0.x = pk2(bflo(g.x) * a[0], bfhi(g.x) * a[1]); w0.y = pk2(bflo(g.y) * a[2], bfhi(g.y) * a[3]);
                        w1.x = pk2(bflo(g.z) * b[0], bfhi(g.z) * b[1]); w1.y = pk2(bflo(g.w) * b[2], bfhi(g.w) * b[3]);
                        *(u32x2*)dst = w0; *(u32x2*)(dst + 16) = w1;
                    }
        }
        const bool scale = (sub == 6 || sub == 7);
        const float cf = (sub < 6 && !(sub & 1)) ? 1.0f : 0.0f;
#pragma unroll
        for (int ai = 0; ai < 2; ++ai)
#pragma unroll
            for (int bj = 0; bj < 2; ++bj)
#pragma unroll
                for (int m = 0; m < 4; ++m) {
                    f32x4 fa = (f32x4){cf, cf, cf, cf}, fb = fa;
                    if (scale) {
                        const u32x4 g = *(const u32x4*)(sp + (size_t)(((ai * 2 + bj) * 4 + m) * 8192));
                        const u32x4 d = *(const u32x4*)(sp + 131072 + (size_t)(((ai * 2 + bj) * 4 + m) * 8192));
                        fa = (f32x4){bflo(g.x) * __builtin_amdgcn_rcpf(bflo(d.x)), bfhi(g.x) * __builtin_amdgcn_rcpf(bfhi(d.x)), bflo(g.y) * __builtin_amdgcn_rcpf(bflo(d.y)), bfhi(g.y) * __builtin_amdgcn_rcpf(bfhi(d.y))};
                        fb = (f32x4){bflo(g.z) * __builtin_amdgcn_rcpf(bflo(d.z)), bfhi(g.z) * __builtin_amdgcn_rcpf(bfhi(d.z)), bflo(g.w) * __builtin_amdgcn_rcpf(bflo(d.w)), bfhi(g.w) * __builtin_amdgcn_rcpf(bfhi(d.w))};
                    }
                    acc[ai][bj][m][0] *= fa; acc[ai][bj][m][1] *= fb;
                }
        return false;
    }
};

#define XB_TMO      128
#define XB_XCNT(j)  (256  + 64 * (j))
#define XB_XSUB(j)  (1280 + 64 * (j))
#define XB_XGEN(j)  (2304 + 64 * (j))
#define XB_TOP      3328
#define XB_TOPGEN   3392
#define XCD_BAR_WORDS 3456
#define XB_SPIN_CAP (1u << 18)
DI unsigned xb_ld(unsigned* p)              { return __hip_atomic_load(p, __ATOMIC_RELAXED, __HIP_MEMORY_SCOPE_AGENT); }
DI unsigned xb_add(unsigned* p, unsigned v) { return __hip_atomic_fetch_add(p, v, __ATOMIC_RELAXED, __HIP_MEMORY_SCOPE_AGENT); }
DI unsigned xb_xcc_id() { return (unsigned)__builtin_amdgcn_s_getreg((3 << 11) | 20) & 0xFu; }
#define XB_SPIN(cond, bar) do { unsigned _sp = 0; while (cond) { __builtin_amdgcn_s_sleep(1); \
    if ((++_sp & 255u) == 0u) { if (xb_ld(&(bar)[XB_TMO])) break; if (_sp > XB_SPIN_CAP) { atomicAdd(&(bar)[XB_TMO], 1u); break; } } } } while (0)
struct XcdBarrier { unsigned* bar; unsigned x; volatile LAS unsigned* st; };
DI XcdBarrier xcd_barrier_post(unsigned* bar, volatile LAS unsigned* st) {
    XcdBarrier b; b.bar = bar; b.x = xb_xcc_id(); b.st = st;
    if (threadIdx.x == 0) (void)xb_add(&bar[XB_XCNT(b.x)], 1u);
    return b;
}
DI void xcd_barrier_complete(unsigned* bar, unsigned x, unsigned& nloc, unsigned& nx) {
    const unsigned G = gridDim.x * gridDim.y * gridDim.z;
    unsigned sum, cnt, mine, sp = 0u;
    for (;;) {
        sum = 0u; cnt = 0u; mine = 0u;
#pragma unroll
        for (unsigned j = 0; j < 16; ++j) { const unsigned c = xb_ld(&bar[XB_XCNT(j)]); sum += c; cnt += (c > 0u) ? 1u : 0u; mine = (j == x) ? c : mine; }
        if (sum == G) break;
        __builtin_amdgcn_s_sleep(1);
        if ((++sp & 255u) == 0u) { if (xb_ld(&bar[XB_TMO])) break; if (sp > XB_SPIN_CAP) { atomicAdd(&bar[XB_TMO], 1u); break; } }
    }
    nloc = mine > 0u ? mine : 1u; nx = cnt > 0u ? cnt : 1u;
}
DI void xcd_barrier(const XcdBarrier& b) {
    asm volatile("s_waitcnt vmcnt(0)" ::: "memory");
    __syncthreads();
    if (threadIdx.x == 0) {
        unsigned* bar = b.bar;
        __builtin_amdgcn_s_waitcnt(0);
        unsigned nloc = b.st[0], nx = b.st[1];
        if (nloc == 0u) { xcd_barrier_complete(bar, b.x, nloc, nx); b.st[0] = nloc; b.st[1] = nx; }
        const unsigned old = xb_add(&bar[XB_XSUB(b.x)], 1u);
        const unsigned gen = old / nloc;
        if (old + 1u == (gen + 1u) * nloc) {
            __builtin_amdgcn_fence(__ATOMIC_RELEASE, "agent");
            asm volatile("s_waitcnt vmcnt(0)" ::: "memory");
            const unsigned og = xb_add(&bar[XB_TOP], 1u);
            const unsigned tg = og / nx;
            if (og + 1u == (tg + 1u) * nx) xb_add(&bar[XB_TOPGEN], 1u);
            else XB_SPIN(xb_ld(&bar[XB_TOPGEN]) == tg, bar);
            __builtin_amdgcn_fence(__ATOMIC_ACQUIRE, "agent");
            xb_add(&bar[XB_XGEN(b.x)], 1u);
            asm volatile("s_waitcnt vmcnt(0)" ::: "memory");
        } else {
            XB_SPIN(xb_ld(&bar[XB_XGEN(b.x)]) == gen, bar);
            __builtin_amdgcn_fence(__ATOMIC_ACQUIRE, "agent");
            asm volatile("s_waitcnt vmcnt(0)" ::: "memory");
        }
    }
    __syncthreads();
}

DI void phase_mods(const Params& P, unsigned char* shm) {
    float* s = (float*)shm;
    float* red = s + 9 * 1024;
    const int tid = otid();
    const float* c = oin(P, I_C); const float* cc = oin(P, I_CCTX);
    for (int idx = tid; idx < 9 * 1024; idx += 512) { const int rb = idx >> 10, k = idx & 1023; const float v = rb < 8 ? c[rb * 1024 + k] : cc[k]; s[idx] = siluf_(v); }
    __syncthreads();
    float* mods = (float*)(ows(P) + OFF_MODS);
    const float* wmod = oin(P, I_WMOD); const float* bmod = oin(P, I_BMOD);
    for (int u = obid(); u < 288; u += gridDim.x) {
        const int l = u / 72, n0 = (u % 72) * 128, cgp = tid & 31, ks = tid >> 5;
        f32x4 acc[9];
#pragma unroll
        for (int rb = 0; rb < 9; ++rb) acc[rb] = (f32x4){0.f, 0.f, 0.f, 0.f};
        const float* wp = wmod + ((size_t)l * 1024 + ks * 64) * 9216 + n0 + cgp * 4;
        for (int kk = 0; kk < 64; ++kk) { const f32x4 w = *(const f32x4*)(wp + (size_t)kk * 9216);
#pragma unroll
            for (int rb = 0; rb < 9; ++rb) acc[rb] += w * s[rb * 1024 + ks * 64 + kk]; }
#pragma unroll
        for (int rb = 0; rb < 9; ++rb) *(f32x4*)(red + ((ks * 9 + rb) * 128 + cgp * 4)) = acc[rb];
        __syncthreads();
        for (int idx = tid; idx < 1152; idx += 512) { const int rb = idx >> 7, c2 = idx & 127; float sum = bmod[l * 9216 + n0 + c2];
            for (int k2 = 0; k2 < 16; ++k2) sum += red[(k2 * 9 + rb) * 128 + c2];
            mods[((size_t)l * 9 + rb) * 9216 + n0 + c2] = sum; }
        __syncthreads();
    }
}

DI void phase_tables(const Params& P, unsigned char* shm) {
    const int tid = otid();
    float* tab = (float*)shm;
    for (int j = tid; j < 4096; j += 512) tab[j] = cospif((float)j * (1.0f / 2048.0f)) * (1.0f / 64.0f);
    __syncthreads();
    if (obid() == 0) {
        float* rc = (float*)(ows(P) + OFF_ROPE); float* rs = rc + 1024;
        for (int idx = tid; idx < 1024; idx += 512) { const int p = idx >> 4, f = idx & 15; const float inv = powf(10000.0f, -(float)f / 16.0f); const float ang = (float)p * inv; rc[idx] = cosf(ang); rs[idx] = sinf(ang); }
    }
    bf16_t* dft = (bf16_t*)(ows(P) + OFF_DFT);
    const long gid = (long)obid() * 512 + tid, gstride = (long)gridDim.x * 512;
    for (long it = gid; it < 4096l * 1024; it += gstride) {
        const int k = (int)(it >> 10), n0 = ((int)it & 1023) * 8; const bool isS = n0 >= 4096; const int nn = n0 & 4095;
        float v[8];
#pragma unroll
        for (int j = 0; j < 8; ++j) { const int idx = (k * (nn + j)) & 4095; v[j] = isS ? -tab[(idx + 3072) & 4095] : tab[idx]; }
        u32x4 w; w.x = pk2(v[0], v[1]); w.y = pk2(v[2], v[3]); w.z = pk2(v[4], v[5]); w.w = pk2(v[6], v[7]);
        *(u32x4*)(dft + (size_t)k * 8192 + n0) = w;
    }
    bf16_t* dftc = (bf16_t*)(ows(P) + OFF_DFTC);
    for (long it = gid; it < 256l * 64; it += gstride) {
        const int k = (int)(it >> 6), n0 = ((int)it & 63) * 8; const bool isS = n0 >= 256; const int nn = n0 & 255;
        float v[8];
#pragma unroll
        for (int j = 0; j < 8; ++j) { const int idx = ((k * (nn + j)) & 255) * 16; v[j] = (isS ? -tab[(idx + 3072) & 4095] : tab[idx]) * 4.0f; }
        u32x4 w; w.x = pk2(v[0], v[1]); w.y = pk2(v[2], v[3]); w.z = pk2(v[4], v[5]); w.w = pk2(v[6], v[7]);
        *(u32x4*)(dftc + (size_t)k * 512 + n0) = w;
    }
    __syncthreads();
}

DI void wconv_tile(const float* src, int lds_, int Ksrc, int mode, bf16_t* dst, int ldd, int coff, int kt, int ntile, float* tile) {
    const int tid = otid();
    const int k0 = kt * 64, n0 = ntile * 64;
    { const int nn = tid & 63, np = n0 + nn; int col = np;
      if (mode == 1) { const int t = np >> 8, w = np & 255, grp = w >> 5, isup = (w >> 4) & 1, i = w & 15; const int ff = t * 128 + grp * 16 + i; col = ff < DFF ? ff + isup * DFF : -1; }
#pragma unroll
      for (int i = 0; i < 8; ++i) { const int kk = (tid >> 6) + i * 8, k = k0 + kk; float v = 0.f; if (col >= 0 && k < Ksrc) v = src[(size_t)k * lds_ + col]; tile[kk * 65 + nn] = v; } }
    __syncthreads();
    { const int nn2 = tid >> 3, kq = (tid & 7) * 8; float v[8];
#pragma unroll
      for (int j = 0; j < 8; ++j) v[j] = tile[(kq + j) * 65 + nn2];
      u32x4 w; w.x = pk2(v[0], v[1]); w.y = pk2(v[2], v[3]); w.z = pk2(v[4], v[5]); w.w = pk2(v[6], v[7]);
      *(u32x4*)(dst + (size_t)(n0 + nn2) * ldd + coff + k0 + kq) = w; }
    __syncthreads();
}

DI void phase_wconv(const Params& P, int l, int grp, int w0, int nw, unsigned char* shm) {
    float* tile = (float*)shm;
    bf16_t* W = (bf16_t*)(ows(P) + OFF_W);
    const int tid = otid();
    constexpr int N_UP = 16 * 88, N_DN = 44 * 16, N_IN = 16 * 28, N_CB = 8 * 16, N_CG = 16 * 16, N_OUT = 16 * 16, N_WF = 128;
    const int wk = obid() - w0;
    if (wk < 0 || wk >= nw) return;
    __syncthreads();
    if (grp < 2) {
        const int f = grp;
        for (int u = wk; u < N_UP + N_DN; u += nw) {
            if (u < N_UP) wconv_tile(oin(P, I_WUP) + ((size_t)(l * 2 + f)) * 1024 * 5504, 5504, 1024, 1, W + (f ? W_UP1 : W_UP0), 1024, 0, u % 16, u / 16, tile);
            else { const int v = u - N_UP; wconv_tile(oin(P, I_WDN) + ((size_t)(l * 2 + f)) * 2752 * 1024, 1024, 2752, 0, W + (f ? W_DN1 : W_DN0), 2816, 0, v % 44, v / 44, tile); }
        }
        return;
    }
    constexpr int TOT = N_IN + 3 * N_CB + 3 * N_CG + N_OUT + N_WF;
    for (int u = wk; u < TOT; u += nw) {
        int v = u;
        if (v < N_IN) { wconv_tile(oin(P, I_WIN) + (size_t)l * 1024 * 2304, 2304, 1024, 0, W + W_IN, 1024, 0, v % 16, v / 16, tile); continue; }
        v -= N_IN;
        if (v < 3 * N_CB) { const int r = v / N_CB; v %= N_CB; wconv_tile(oin(P, I_WBR) + ((size_t)(l * 3 + r)) * 512 * 1024, 1024, 512, 0, W + W_CAT + (size_t)r * 1024 * 1536, 1536, 0, v % 8, v / 8, tile); continue; }
        v -= 3 * N_CB;
        if (v < 3 * N_CG) { const int r = v / N_CG; v %= N_CG; wconv_tile(oin(P, I_WGATE) + ((size_t)(l * 3 + r)) * 1024 * 1024, 1024, 1024, 0, W + W_CAT + (size_t)r * 1024 * 1536, 1536, 512, v % 16, v / 16, tile); continue; }
        v -= 3 * N_CG;
        if (v < N_OUT) { wconv_tile(oin(P, I_WOUT) + (size_t)l * 1024 * 1024, 1024, 1024, 0, W + W_OUT, 1024, 0, v % 16, v / 16, tile); continue; }
        v -= N_OUT;
        {
            float* rows = tile; float* tab = rows + 4096;
            const float* src = oin(P, I_WIN) + (size_t)l * 1024 * 2304 + (size_t)(v * 8) * 2304 + 1792;
            for (int idx = tid; idx < 4096; idx += 512) rows[idx] = src[(size_t)(idx >> 9) * 2304 + (idx & 511)];
            if (tid < 128) tab[tid] = cospif((float)tid * (1.0f / 64.0f));
            __syncthreads();
            const int g = tid >> 7, m = tid & 127;
            float ac[8], as[8];
#pragma unroll
            for (int kk = 0; kk < 8; ++kk) { ac[kk] = 0.f; as[kk] = 0.f; }
            for (int c2 = 0; c2 < 128; ++c2) { const int idx = (m * c2) & 127; const float cv = tab[idx], sv = tab[(idx + 96) & 127];
#pragma unroll
                for (int kk = 0; kk < 8; ++kk) { const float w = rows[kk * 512 + g * 128 + c2]; ac[kk] += w * cv; as[kk] += w * sv; } }
            const float sc = 0.08838834764831845f;
            u32x4 wc_, ws_; wc_.x = pk2(ac[0] * sc, ac[1] * sc); wc_.y = pk2(ac[2] * sc, ac[3] * sc); wc_.z = pk2(ac[4] * sc, ac[5] * sc); wc_.w = pk2(ac[6] * sc, ac[7] * sc);
            ws_.x = pk2(as[0] * sc, as[1] * sc); ws_.y = pk2(as[2] * sc, as[3] * sc); ws_.z = pk2(as[4] * sc, as[5] * sc); ws_.w = pk2(as[6] * sc, as[7] * sc);
            *(u32x4*)(W + W_F + (size_t)tid * 1024 + v * 8) = wc_;
            *(u32x4*)(W + W_F + (size_t)(512 + tid) * 1024 + v * 8) = ws_;
            __syncthreads();
        }
    }
}

DI void phase_norm(const Params& P, const float* g, const float* bt, const float* mod, int jm, float* outp, int rend) {
    const int tid = otid(), wid = tid >> 6, lane = tid & 63;
    float* X = (float*)(ows(P) + OFF_X); bf16_t* HB = (bf16_t*)(ows(P) + OFF_HB); float* stats = (float*)(ows(P) + OFF_STATS);
    for (int r = obid() * 8 + wid; r < rend; r += gridDim.x * 8) {
        const float* src = g ? (X + (size_t)r * D) : (r < TL ? oin(P, I_X) + (size_t)r * D : oin(P, I_CTX) + (size_t)(r - TL) * D);
        f32x4 v[4];
#pragma unroll
        for (int q = 0; q < 4; ++q) v[q] = *(const f32x4*)(src + q * 256 + lane * 4);
        if (g) {
            float sum = 0.f;
#pragma unroll
            for (int q = 0; q < 4; ++q) sum += v[q][0] + v[q][1] + v[q][2] + v[q][3];
            const float mu = wave_sum(sum, lane) * (1.0f / 1024.0f);
            float sq = 0.f;
#pragma unroll
            for (int q = 0; q < 4; ++q) { v[q] -= mu; sq += v[q][0] * v[q][0] + v[q][1] * v[q][1] + v[q][2] * v[q][2] + v[q][3] * v[q][3]; }
            const float rstd = rsqrtf(wave_sum(sq, lane) * (1.0f / 1024.0f) + LN_EPS);
            if (lane == 0) { stats[(size_t)r * 2] = mu; stats[(size_t)r * 2 + 1] = rstd; }
#pragma unroll
            for (int q = 0; q < 4; ++q) { const f32x4 gg = *(const f32x4*)(g + q * 256 + lane * 4), bb = *(const f32x4*)(bt + q * 256 + lane * 4); v[q] = v[q] * rstd * gg + bb; }
        } else {
#pragma unroll
            for (int q = 0; q < 4; ++q) *(f32x4*)(X + (size_t)r * D + q * 256 + lane * 4) = v[q];
        }
        if (outp) {
#pragma unroll
            for (int q = 0; q < 4; ++q) *(f32x4*)(outp + (size_t)r * D + q * 256 + lane * 4) = v[q];
        }
        if (mod) {
            const int rb = r < TL ? (r >> 12) : 8;
            const float* sh = mod + (size_t)rb * 9216 + jm * 1024; const float* sc = sh + 1024;
#pragma unroll
            for (int q = 0; q < 4; ++q) { const f32x4 a = *(const f32x4*)(sh + q * 256 + lane * 4), b = *(const f32x4*)(sc + q * 256 + lane * 4);
                const f32x4 h = v[q] * (b + 1.0f) + a; u32x2 w; w.x = pk2(h[0], h[1]); w.y = pk2(h[2], h[3]);
                *(u32x2*)(HB + (size_t)r * HBS + q * 256 + lane * 4) = w; }
        }
    }
}

#define MFMA32(a, b, c) __builtin_amdgcn_mfma_f32_32x32x16_bf16((a), (b), (c), 0, 0, 0)
DI bf16x8 mk8(u32x2 lo, u32x2 hi) { u32x4 w; w.x = lo.x; w.y = lo.y; w.z = hi.x; w.w = hi.y; return __builtin_bit_cast(bf16x8, w); }
constexpr int AK_RS = 144;
constexpr int AV_RS_BAND = (384 + 8) * 2;
constexpr int AV_RS_CTX = (256 + 8) * 2;
constexpr int AK_BYTES_BAND = 384 * AK_RS, AK_BYTES_CTX = 256 * AK_RS;
constexpr float SC_LOG2E = 0.125f * 1.4426950408889634f;

struct AttnState { float m, l; f32x16 O[2]; };

template <bool MASKED>
DI void attn_tile2(AttnState (&st)[2], const bf16x8 (&Qf)[2][4], const LAS unsigned char* kl, const LAS unsigned char* vl, const int vrs, int lane, int qposA, int klo) {
    const int hh = lane >> 5;
    bf16x8 Kf[4];
#pragma unroll
    for (int kk = 0; kk < 4; ++kk) Kf[kk] = *(const LAS bf16x8*)(kl + kk * 32);
    bf16x8 Vf[2][2];
#pragma unroll
    for (int db = 0; db < 2; ++db)
#pragma unroll
        for (int c = 0; c < 2; ++c) { const LAS unsigned char* p = vl + db * 32 * vrs + c * 32; Vf[db][c] = mk8(*(const LAS u32x2*)p, *(const LAS u32x2*)(p + 16)); }
#pragma unroll
    for (int qb = 0; qb < 2; ++qb) {
        f32x16 s;
#pragma unroll
        for (int i = 0; i < 16; ++i) s[i] = 0.f;
#pragma unroll
        for (int kk = 0; kk < 4; ++kk) s = MFMA32(Kf[kk], Qf[qb][kk], s);
        float tmax = -3.0e38f;
        const int qpos = qposA + qb * 32;
#pragma unroll
        for (int i = 0; i < 16; ++i) {
            float sv = s[i] * SC_LOG2E;
            if (MASKED) { const int kpos = klo + (i & 3) + 8 * (i >> 2) + 4 * hh; const int dlt = qpos - kpos; if (dlt > 128 || dlt < -128) sv = -3.0e38f; }
            s[i] = sv; tmax = fmaxf(tmax, sv);
        }
        tmax = fmaxf(tmax, shx(tmax, 32, lane));
        const float mnew = fmaxf(st[qb].m, tmax);
        const float alpha = __builtin_amdgcn_exp2f(st[qb].m - mnew);
        float psum = 0.f;
#pragma unroll
        for (int i = 0; i < 16; ++i) { const float p = __builtin_amdgcn_exp2f(s[i] - mnew); s[i] = p; psum += p; }
        st[qb].l = st[qb].l * alpha + psum; st[qb].m = mnew;
        if (__builtin_amdgcn_ballot_w64(alpha != 1.0f) != 0ull) {
#pragma unroll
            for (int db = 0; db < 2; ++db)
#pragma unroll
                for (int i = 0; i < 16; ++i) st[qb].O[db][i] *= alpha;
        }
        bf16x8 Pf[2];
#pragma unroll
        for (int c = 0; c < 2; ++c) { u32x4 w; w.x = pk2(s[8 * c + 0], s[8 * c + 1]); w.y = pk2(s[8 * c + 2], s[8 * c + 3]); w.z = pk2(s[8 * c + 4], s[8 * c + 5]); w.w = pk2(s[8 * c + 6], s[8 * c + 7]); Pf[c] = __builtin_bit_cast(bf16x8, w); }
#pragma unroll
        for (int db = 0; db < 2; ++db)
#pragma unroll
            for (int c = 0; c < 2; ++c) st[qb].O[db] = MFMA32(Vf[db][c], Pf[c], st[qb].O[db]);
    }
}

DI void phase_attn(const Params& P, int l, bool do_ctx, LAS unsigned char* lds) {
    const int tid = otid(), wid = tid >> 6, lane = tid & 63, hh = lane >> 5, ql = lane & 31;
    const bf16_t* Q = (const bf16_t*)(ows(P) + OFF_R + R_Q); const bf16_t* Kb = (const bf16_t*)(ows(P) + OFF_R + R_K);
    const bf16_t* VT = (const bf16_t*)(ows(P) + OFF_R + R_VT); const bf16_t* VTC = (const bf16_t*)(ows(P) + OFF_R + R_VTC);
    bf16_t* HB = (bf16_t*)(ows(P) + OFF_HB);
    const float* sink = oin(P, I_SINK) + l * 8;
    const int hq = wid >> 1, pp = wid & 1;
    const int nlat = (512 - obid() + (int)gridDim.x - 1) / (int)gridDim.x;
    const int cu = (int)gridDim.x - 1 - obid();
    const int nmine = nlat + ((do_ctx && cu < 32) ? 1 : 0);
    for (int ui = 0; ui < nmine; ++ui) {
        const int u = ui < nlat ? obid() + ui * (int)gridDim.x : 512 + cu;
        const bool isc = u >= 512;
        int b, kvh, blk = 0, qbase;
        if (!isc) { kvh = u & 1; blk = (u >> 1) & 31; b = u >> 6; qbase = b * 4096 + blk * 128; }
        else { const int u2 = u - 512; kvh = u2 & 1; b = u2 >> 2; qbase = TL + b * 256 + ((u2 >> 1) & 1) * 128; }
        const int h = kvh * 4 + hq;
        const int qrowA = qbase + pp * 64 + ql;
        bf16x8 Qf[2][4];
#pragma unroll
        for (int qb = 0; qb < 2; ++qb)
#pragma unroll
            for (int kk = 0; kk < 4; ++kk) Qf[qb][kk] = *(const bf16x8*)(Q + (size_t)(qrowA + qb * 32) * 512 + h * 64 + kk * 16 + hh * 8);
        AttnState st[2];
        const float sk = sink[h] * 1.4426950408889634f;
#pragma unroll
        for (int qb = 0; qb < 2; ++qb) { st[qb].m = sk; st[qb].l = hh == 0 ? 1.0f : 0.0f;
#pragma unroll
            for (int i = 0; i < 16; ++i) { st[qb].O[0][i] = 0.f; st[qb].O[1][i] = 0.f; } }
        if (!isc) {
            const int key0 = blk * 128 - 128;
            __syncthreads();
#pragma unroll
            for (int ps = 0; ps < 6; ++ps) { const int row = ps * 64 + (tid >> 3), seg = tid & 7; const int key = key0 + row;
                if (key >= 0 && key < SEQ) *(LAS u32x4*)(lds + row * AK_RS + seg * 16) = *(const u32x4*)(Kb + (size_t)(b * 4096 + key) * 128 + kvh * 64 + seg * 8); }
#pragma unroll
            for (int ps = 0; ps < 6; ++ps) { const int idx = ps * 512 + tid; const int d = idx / 48, seg = idx - d * 48; const int key = key0 + seg * 8;
                if (key >= 0 && key < SEQ) *(LAS u32x4*)(lds + AK_BYTES_BAND + d * AV_RS_BAND + seg * 16) = *(const u32x4*)(VT + ((size_t)(b * 128 + kvh * 64 + d)) * 4096 + key); }
            __syncthreads();
            const int q0 = blk * 128 + pp * 64;
            for (int kt = 0; kt < 12; ++kt) {
                const int klo = key0 + kt * 32;
                if (klo < 0 || klo >= SEQ) continue;
                if (klo + 31 < q0 - 128 || klo > q0 + 63 + 128) continue;
                const LAS unsigned char* kl = lds + (kt * 32 + ql) * AK_RS + hh * 16;
                const LAS unsigned char* vl = lds + AK_BYTES_BAND + ql * AV_RS_BAND + (kt * 32 + 4 * hh) * 2;
                const bool interior = (klo >= q0 + 63 - 128) && (klo + 31 <= q0 + 128);
                if (interior) attn_tile2<false>(st, Qf, kl, vl, AV_RS_BAND, lane, q0 + ql, klo);
                else attn_tile2<true>(st, Qf, kl, vl, AV_RS_BAND, lane, q0 + ql, klo);
            }
        }
        __syncthreads();
#pragma unroll
        for (int ps = 0; ps < 4; ++ps) { const int row = ps * 64 + (tid >> 3), seg = tid & 7;
            *(LAS u32x4*)(lds + row * AK_RS + seg * 16) = *(const u32x4*)(Kb + (size_t)(TL + b * 256 + row) * 128 + kvh * 64 + seg * 8); }
#pragma unroll
        for (int ps = 0; ps < 4; ++ps) { const int idx = ps * 512 + tid; const int d = idx >> 5, seg = idx & 31;
            *(LAS u32x4*)(lds + AK_BYTES_CTX + d * AV_RS_CTX + seg * 16) = *(const u32x4*)(VTC + ((size_t)(b * 128 + kvh * 64 + d)) * 256 + seg * 8); }
        __syncthreads();
        for (int kt = 0; kt < 8; ++kt) {
            const LAS unsigned char* kl = lds + (kt * 32 + ql) * AK_RS + hh * 16;
            const LAS unsigned char* vl = lds + AK_BYTES_CTX + ql * AV_RS_CTX + (kt * 32 + 4 * hh) * 2;
            attn_tile2<false>(st, Qf, kl, vl, AV_RS_CTX, lane, 0, 0);
        }
#pragma unroll
        for (int qb = 0; qb < 2; ++qb) {
            const float ltot = st[qb].l + shx(st[qb].l, 32, lane);
            const float inv = 1.0f / ltot;
            bf16_t* op = HB + (size_t)(qrowA + qb * 32) * HBS + 1024 + h * 64 + 4 * hh;
#pragma unroll
            for (int db = 0; db < 2; ++db)
#pragma unroll
                for (int g4 = 0; g4 < 4; ++g4) { u32x2 w; w.x = pk2(st[qb].O[db][4 * g4] * inv, st[qb].O[db][4 * g4 + 1] * inv); w.y = pk2(st[qb].O[db][4 * g4 + 2] * inv, st[qb].O[db][4 * g4 + 3] * inv);
                    *(u32x2*)(op + db * 32 + 8 * g4) = w; }
        }
    }
    __syncthreads();
}

DI void phase_sgu(const Params& P, int l, unsigned char* shm, int nchunk) {
    const int tid = otid(), wid = tid >> 6, lane = tid & 63, hh = lane >> 5, ql = lane & 31;
    bf16_t* vT = (bf16_t*)shm;
    const bf16_t* U = (const bf16_t*)(ows(P) + OFF_R + R_U); const bf16_t* Z = (const bf16_t*)(ows(P) + OFF_R + R_Z);
    bf16_t* HB = (bf16_t*)(ows(P) + OFF_HB);
    const float* lg = oin(P, I_SGULG) + l * 512; const float* lb = oin(P, I_SGULB) + l * 512;
    const float* sw = oin(P, I_SGUW) + (size_t)l * 4 * 128 * 128; const float* sb = oin(P, I_SGUB) + l * 4 * 128;
    float gg[8], bb[8];
#pragma unroll
    for (int j = 0; j < 8; ++j) { gg[j] = lg[j * 64 + lane]; bb[j] = lb[j * 64 + lane]; }
    const int nmine = (obid() < 256 ? 1 : 0) + ((nchunk > 256 && obid() >= 64 && obid() < 64 + (nchunk - 256)) ? 1 : 0);
    for (int ci = 0; ci < nmine; ++ci) {
        const int chunk = (ci == 0 && obid() < 256) ? obid() : 256 + (obid() - 64);
        const int r0 = chunk * 128;
        for (int t4 = 0; t4 < 4; ++t4) {
            float z[4][8]; float sum[4];
#pragma unroll
            for (int q = 0; q < 4; ++q) { const bf16_t* zp = Z + (size_t)(r0 + wid * 16 + t4 * 4 + q) * 512; sum[q] = 0.f;
#pragma unroll
                for (int j = 0; j < 8; ++j) { z[q][j] = bf2f(zp[j * 64 + lane]); sum[q] += z[q][j]; } }
#pragma unroll
            for (int o = 32; o >= 1; o >>= 1) {
#pragma unroll
                for (int q = 0; q < 4; ++q) sum[q] += shx(sum[q], o, lane); }
            float sq[4];
#pragma unroll
            for (int q = 0; q < 4; ++q) { const float mu = sum[q] * (1.0f / 512.0f); sq[q] = 0.f;
#pragma unroll
                for (int j = 0; j < 8; ++j) { z[q][j] -= mu; sq[q] += z[q][j] * z[q][j]; } }
#pragma unroll
            for (int o = 32; o >= 1; o >>= 1) {
#pragma unroll
                for (int q = 0; q < 4; ++q) sq[q] += shx(sq[q], o, lane); }
#pragma unroll
            for (int q = 0; q < 4; ++q) { const float rstd = rsqrtf(sq[q] * (1.0f / 512.0f) + LN_EPS); const int tok = wid * 16 + t4 * 4 + q;
#pragma unroll
                for (int j = 0; j < 8; ++j) vT[(j * 64 + lane) * 136 + tok] = f2bf(z[q][j] * rstd * gg[j] + bb[j]); }
        }
        __syncthreads();
        const int g = wid >> 1, cb = g * 128 + (wid & 1) * 64;
        for (int mb = 0; mb < 4; ++mb) {
            f32x16 acc[2];
#pragma unroll
            for (int i = 0; i < 16; ++i) { acc[0][i] = 0.f; acc[1][i] = 0.f; }
#pragma unroll
            for (int kc = 0; kc < 8; ++kc) {
                const float* wp = sw + ((size_t)(g * 128 + mb * 32 + ql)) * 128 + kc * 16 + hh * 8;
                const f32x4 w0 = *(const f32x4*)wp, w1 = *(const f32x4*)(wp + 4);
                u32x4 wa; wa.x = pk2(w0[0], w0[1]); wa.y = pk2(w0[2], w0[3]); wa.z = pk2(w1[0], w1[1]); wa.w = pk2(w1[2], w1[3]);
                const bf16x8 Af = __builtin_bit_cast(bf16x8, wa);
#pragma unroll
                for (int nb = 0; nb < 2; ++nb) { const bf16x8 Bf = *(const bf16x8*)(vT + (cb + nb * 32 + ql) * 136 + kc * 16 + hh * 8); acc[nb] = MFMA32(Af, Bf, acc[nb]); }
            }
#pragma unroll
            for (int nb = 0; nb < 2; ++nb)
#pragma unroll
                for (int i = 0; i < 16; ++i) { const int prow = mb * 32 + (i & 3) + 8 * (i >> 2) + 4 * hh; const int c = cb + nb * 32 + ql; const size_t row = (size_t)(r0 + prow);
                    const float val = (acc[nb][i] + sb[g * 128 + prow]) * bf2f(U[row * 512 + c]);
                    HB[row * HBS + 1536 + c] = f2bf(val); }
        }
        __syncthreads();
    }
}

__global__ void __launch_bounds__(512, 2) mega(Params P) {
    extern __shared__ __attribute__((aligned(16))) unsigned char shm[];
    LAS unsigned char* lds = (LAS unsigned char*)shm;
    cg::grid_group grid = cg::this_grid();
    volatile LAS unsigned* bst = (volatile LAS unsigned*)(lds + LDS_BYTES - 16);
    if (threadIdx.x == 0) { bst[0] = 0u; bst[1] = 0u; }
    if (blockIdx.x == 0) { unsigned* bw = (unsigned*)(P.ws + OFF_BAR); for (int i = threadIdx.x; i < XCD_BAR_WORDS; i += 512) bw[i] = 0u; }
    __syncthreads();

    phase_mods(P, shm);
    phase_tables(P, shm);
    phase_wconv(P, 0, 0, 0, gridDim.x, shm);
    grid.sync();
    const XcdBarrier gbar = xcd_barrier_post((unsigned*)(P.ws + OFF_BAR), bst);
#define GSYNC() xcd_barrier(gbar)
    phase_norm(P, nullptr, nullptr, (const float*)(ows(P) + OFF_MODS), 0, nullptr, T);
    GSYNC();

    for (int st = 0; st < 2 * DEPTH; ++st) {
        const int l = st >> 1, f = st & 1;
        const int npl = (l == DEPTH - 1) ? TL / 256 : T / 256;
        const int npf = f ? npl : T / 256;
        {
            unsigned char* ws = ows(P); bf16_t* W = (bf16_t*)(ws + OFF_W);
            SchedTile S; S.init(ws + OFF_HB, 256ull * HBS * 2, W + (f ? W_UP1 : W_UP0), 256ull * 1024 * 2, npf, NUP / 256);
            EpiUp E; E.act = (bf16_t*)(ws + OFF_R);
            for (int rep = 0; rep < REP_UP; ++rep) gemm_phase<1024, HBS, 1024>(lds, S, E);
        }
        GSYNC();
        for (int es = 0; es < EXTRA_SYNCS; ++es) GSYNC();
        {
            unsigned char* ws = ows(P); bf16_t* W = (bf16_t*)(ws + OFF_W);
            SchedTile S; S.init(ws + OFF_R, 256ull * DFFP * 2, W + (f ? W_DN1 : W_DN0), 256ull * DFFP * 2, npf, 4);
            EpiRes E; E.X = (float*)(ws + OFF_X); E.gm = (const float*)(ws + OFF_MODS) + (size_t)l * 9 * 9216 + (f ? 8 : 2) * 1024; E.s = 0.5f; E.stats = (const float*)(ws + OFF_STATS);
            { const int li = f ? (l * 3 + 1) : (st == 0 ? 0 : l * 3 - 1); E.lg = oin(P, I_LNG) + li * 1024; E.lb = oin(P, I_LNB) + li * 1024; E.ident = (st == 0) ? 1 : 0; }
            gemm_phase<DFFP, DFFP, DFFP>(lds, S, E);
        }
        if (f == 0) {
            phase_wconv(P, l, 2, 32, gridDim.x - 32, shm);
            phase_wconv(P, l, 1, 32, gridDim.x - 32, shm);
        }
        GSYNC();
        if (f == 0) {
            phase_norm(P, oin(P, I_LNG) + (l * 3 + 0) * 1024, oin(P, I_LNB) + (l * 3 + 0) * 1024, (const float*)(ows(P) + OFF_MODS) + (size_t)l * 9 * 9216, 3, nullptr, T);
            GSYNC();
            {
                unsigned char* ws = ows(P); bf16_t* W = (bf16_t*)(ws + OFF_W); unsigned char* R = ws + OFF_R;
                SchedTile S; S.init(ws + OFF_HB, 256ull * HBS * 2, W + W_IN, 256ull * 1024 * 2, T / 256, 7);
                EpiIn E; E.Q = (bf16_t*)(R + R_Q); E.Kb = (bf16_t*)(R + R_K); E.VT = (bf16_t*)(R + R_VT); E.VTC = (bf16_t*)(R + R_VTC); E.U = (bf16_t*)(R + R_U); E.Z = (bf16_t*)(R + R_Z);
                E.ropec = (const float*)(ws + OFF_ROPE); E.ropes = E.ropec + 1024;
                for (int rep = 0; rep < REP_IN; ++rep) gemm_phase<1024, HBS, 1024>(lds, S, E);
            }
            {
                unsigned char* ws = ows(P); bf16_t* W = (bf16_t*)(ws + OFF_W); unsigned char* R = ws + OFF_R;
                SchedTile S; S.init(W + W_F, 256ull * 1024 * 2, ws + OFF_HB, 256ull * HBS * 2, 4, npl);
                EpiFT E; E.FT = (bf16_t*)(R + R_FT); E.FTC = (bf16_t*)(R + R_FTC);
                for (int rep = 0; rep < REP_IN; ++rep) gemm_phase<1024, 1024, HBS>(lds, S, E);
            }
            GSYNC();
            {
                unsigned char* ws = ows(P); unsigned char* R = ws + OFF_R;
                SchedTile S; S.init(ws + OFF_DFT, 256ull * 8192 * 2, R + R_FT, 256ull * 8192 * 2, 16, 16);
                EpiDft E; E.HB = (bf16_t*)(ws + OFF_HB); E.rowbase = 0; E.rpb = 4096;
                for (int rep = 0; rep < REP_DFT; ++rep) gemm_phase<8192, 8192, 8192>(lds, S, E);
            }
            if (l < DEPTH - 1) {
                unsigned char* ws = ows(P); unsigned char* R = ws + OFF_R;
                SchedTile S; S.init(ws + OFF_DFTC, 0, R + R_FTC, 256ull * 512 * 2, 1, 16); S.c = (obid() + (int)gridDim.x - 128) % (int)gridDim.x;
                EpiDft E; E.HB = (bf16_t*)(ws + OFF_HB); E.rowbase = TL; E.rpb = 256;
                gemm_phase<512, 512, 512>(lds, S, E);
            }
            for (int rep = 0; rep < REP_ATT; ++rep) phase_attn(P, l, l < DEPTH - 1, lds);
            for (int rep = 0; rep < REP_SGU; ++rep) phase_sgu(P, l, shm, npl * 2);
            GSYNC();
            {
                unsigned char* ws = ows(P); bf16_t* W = (bf16_t*)(ws + OFF_W); unsigned char* R = ws + OFF_R;
                SchedBr S; S.HBp = (const char*)(ws + OFF_HB); S.Wc = (const char*)(W + W_CAT); S.G = gridDim.x; S.c = obid(); S.ntiles = npl * 4;
                EpiBr E; E.merged = (bf16_t*)(R + R_MERGED); E.scr = R + R_SCR + (size_t)obid() * (3 * 131072);
                for (int rep = 0; rep < REP_BR; ++rep) gemm_phase<512, HBS, 1536>(lds, S, E);
            }
            if (l < DEPTH - 1) phase_wconv(P, l + 1, 0, 32, gridDim.x - 32, shm);
            GSYNC();
            {
                unsigned char* ws = ows(P); bf16_t* W = (bf16_t*)(ws + OFF_W); unsigned char* R = ws + OFF_R;
                SchedTile S; S.init(R + R_MERGED, 256ull * 1024 * 2, W + W_OUT, 256ull * 1024 * 2, npl, 4);
                EpiRes E; E.X = (float*)(ws + OFF_X); E.gm = (const float*)(ws + OFF_MODS) + (size_t)l * 9 * 9216 + 5 * 1024; E.s = 1.0f; E.stats = (const float*)(ws + OFF_STATS); E.lg = oin(P, I_LNG) + (l * 3) * 1024; E.lb = oin(P, I_LNB) + (l * 3) * 1024; E.ident = 0;
                gemm_phase<1024, 1024, 1024>(lds, S, E);
            }
            GSYNC();
            phase_norm(P, oin(P, I_LNG) + (l * 3 + 1) * 1024, oin(P, I_LNB) + (l * 3 + 1) * 1024, (const float*)(ows(P) + OFF_MODS) + (size_t)l * 9 * 9216, 6, nullptr, npl * 256);
            GSYNC();
        } else {
            const bool lastl = (l == DEPTH - 1);
            phase_norm(P, oin(P, I_LNG) + (l * 3 + 2) * 1024, oin(P, I_LNB) + (l * 3 + 2) * 1024, lastl ? nullptr : (const float*)(ows(P) + OFF_MODS) + (size_t)(l + 1) * 9 * 9216, 0, lastl ? P.out : nullptr, npl * 256);
            if (!lastl) GSYNC();
        }
    }
}

extern "C" void kernel_launch(void* const* d_in, const int* in_sizes, int n_in, void* d_out, int out_size, void* d_ws, size_t ws_size, hipStream_t stream) {
    static int grid_blocks = 0;
    if (!grid_blocks) {
        int dev = 0, cus = 0, per_cu = 0;
        hipGetDevice(&dev);
        hipDeviceGetAttribute(&cus, hipDeviceAttributeMultiprocessorCount, dev);
        if (hipFuncSetAttribute((const void*)mega, hipFuncAttributeMaxDynamicSharedMemorySize, LDS_BYTES) != hipSuccess) fprintf(stderr, "hipFuncSetAttribute failed\n");
        hipOccupancyMaxActiveBlocksPerMultiprocessor(&per_cu, (const void*)mega, 512, LDS_BYTES);
        if (per_cu < 1) { fprintf(stderr, "occupancy query gave %d\n", per_cu); per_cu = 1; }
        (void)hipGetLastError();
        grid_blocks = cus * per_cu;
        if (grid_blocks > 256) grid_blocks = 256;
        if (ws_size < WS_END) fprintf(stderr, "workspace too small: %zu < %zu\n", ws_size, (size_t)WS_END);
    }
    Params p{};
    for (int i = 0; i < 19; ++i) p.in[i] = (const float*)d_in[i];
    p.out = (float*)d_out; p.ws = (unsigned char*)d_ws;
    void* args[] = {&p};
    hipError_t e = hipLaunchCooperativeKernel((const void*)mega, dim3(grid_blocks), dim3(512), args, LDS_BYTES, stream);
    if (e != hipSuccess) fprintf(stderr, "cooperative launch failed: %s (grid %d)\n", hipGetErrorString(e), grid_blocks);
}
```

```cpp
#include <hip/hip_runtime.h>
#include <hip/hip_cooperative_groups.h>
#include <cstdio>
namespace cg = cooperative_groups;
#define REP_UP 1
#define REP_IN 1
#define REP_DFT 1
#define REP_ATT 1
#define REP_SGU 1
#define REP_BR 1
#define REP_WCONV 1
#define EXTRA_SYNCS 0

#define LAS __attribute__((address_space(3)))
#define DI __device__ __forceinline__
typedef unsigned short bf16_t;
typedef short bf16x8 __attribute__((ext_vector_type(8)));
typedef float f32x2 __attribute__((ext_vector_type(2)));
typedef float f32x4 __attribute__((ext_vector_type(4)));
typedef float f32x16 __attribute__((ext_vector_type(16)));
typedef unsigned u32x2 __attribute__((ext_vector_type(2)));
typedef unsigned u32x4 __attribute__((ext_vector_type(4)));
typedef __bf16 bfv2 __attribute__((ext_vector_type(2)));

constexpr int D = 1024, NB = 8, SEQ = 4096, DEPTH = 4, CTXL = 256;
constexpr int TL = NB * SEQ, TC = NB * CTXL, T = TL + TC;
constexpr int DFF = 2752, DFFP = 2816, NUP = 5632;
constexpr int HBS = 2560;
constexpr float ALPHA = 1.681792830507429f;
constexpr float LN_EPS = 1e-5f;
constexpr int LDS_BYTES = 144 * 1024;

constexpr size_t OFF_MODS = 0;
constexpr size_t SZ_MODS = 4ull * 9 * 9216 * 4;
constexpr size_t OFF_ROPE = OFF_MODS + SZ_MODS;
constexpr size_t SZ_ROPE = 2ull * 64 * 16 * 4;
constexpr size_t OFF_DFT = OFF_ROPE + SZ_ROPE;
constexpr size_t SZ_DFT = 4096ull * 8192 * 2;
constexpr size_t OFF_DFTC = OFF_DFT + SZ_DFT;
constexpr size_t SZ_DFTC = 256ull * 512 * 2;
constexpr size_t OFF_W = OFF_DFTC + SZ_DFTC;
constexpr size_t W_UP0 = 0, W_DN0 = W_UP0 + 5632ull * 1024, W_UP1 = W_DN0 + 1024ull * 2816, W_DN1 = W_UP1 + 5632ull * 1024,
                 W_IN = W_DN1 + 1024ull * 2816, W_F = W_IN + 1792ull * 1024, W_CAT = W_F + 1024ull * 1024,
                 W_OUT = W_CAT + 3ull * 1024 * 1536, W_END = W_OUT + 1024ull * 1024;
constexpr size_t SZ_W = W_END * 2;
constexpr size_t OFF_X = OFF_W + SZ_W;
constexpr size_t SZ_X = (size_t)T * 1024 * 4;
constexpr size_t OFF_HB = OFF_X + SZ_X;
constexpr size_t SZ_HB = (size_t)T * HBS * 2;
constexpr size_t OFF_R = OFF_HB + SZ_HB;
constexpr size_t R_Q = 0;
constexpr size_t R_U = R_Q + (size_t)T * 512 * 2;
constexpr size_t R_Z = R_U + (size_t)T * 512 * 2;
constexpr size_t R_K = R_Z + (size_t)T * 512 * 2;
constexpr size_t R_VT = R_K + (size_t)T * 128 * 2;
constexpr size_t R_VTC = R_VT + 8ull * 128 * 4096 * 2;
constexpr size_t R_FT = R_VTC + 8ull * 128 * 256 * 2;
constexpr size_t R_FTC = R_FT + 8ull * 512 * 8192 * 2;
constexpr size_t R_END = R_FTC + 8ull * 512 * 512 * 2;
constexpr size_t SZ_R = (size_t)T * DFFP * 2;
static_assert(R_END == SZ_R, "region R");
constexpr size_t R_MERGED = R_Q;
constexpr size_t R_SCR = R_Z;
constexpr size_t OFF_BAR = OFF_R + SZ_R;
constexpr size_t SZ_BAR = 16384;
constexpr size_t OFF_STATS = OFF_BAR + SZ_BAR;
constexpr size_t SZ_STATS = (size_t)T * 2 * 4;
constexpr size_t WS_END = OFF_STATS + SZ_STATS;
static_assert(WS_END <= 721420288ull, "workspace");
static_assert(256ull * 3 * 131072 <= R_END - R_Z, "scr");

struct Params { const float* in[19]; float* out; unsigned char* ws; };
enum { I_X = 0, I_C, I_CTX, I_CCTX, I_WMOD, I_BMOD, I_WUP, I_WDN, I_LNG, I_LNB, I_WIN, I_SINK, I_SGUW, I_SGUB, I_SGULG, I_SGULB, I_WGATE, I_WBR, I_WOUT };

DI unsigned pk2(float a, float b) { f32x2 v = {a, b}; bfv2 r = __builtin_convertvector(v, bfv2); return __builtin_bit_cast(unsigned, r); }
DI bf16_t f2bf(float a) { return (bf16_t)(pk2(a, 0.f) & 0xffffu); }
DI float bf2f(unsigned b) { return __uint_as_float(b << 16); }
DI float bflo(unsigned w) { return __uint_as_float(w << 16); }
DI float bfhi(unsigned w) { return __uint_as_float(w & 0xffff0000u); }
DI float sigmoidf_(float x) { return __builtin_amdgcn_rcpf(1.0f + __builtin_amdgcn_exp2f(-1.4426950408889634f * x)); }
DI float siluf_(float x) { return x * __builtin_amdgcn_rcpf(1.0f + __builtin_amdgcn_exp2f(-1.4426950408889634f * x)); }
DI float geluf_(float x) { const float y = -2.302208198288f * (x + 0.044715f * x * x * x); return x * __builtin_amdgcn_rcpf(1.0f + __builtin_amdgcn_exp2f(y)); }
DI int otid() { int t = threadIdx.x; asm volatile("" : "+v"(t)); return t; }
DI int obid() { int b = blockIdx.x; asm volatile("" : "+s"(b)); return b; }
DI unsigned char* ows(const Params& P) { unsigned char* w = P.ws; asm volatile("" : "+s"(w)); return w; }
DI const float* oin(const Params& P, int i) { const float* p = P.in[i]; asm volatile("" : "+s"(p)); return p; }
DI float shx(float v, int o, int lane) { return __int_as_float(__builtin_amdgcn_ds_bpermute((lane ^ o) << 2, __float_as_int(v))); }
DI float wave_sum(float v, int lane) {
#pragma unroll
    for (int o = 32; o >= 1; o >>= 1) v += shx(v, o, lane);
    return v;
}

constexpr int BM = 256, BK = 64, HALF = 128, HTB = HALF * BK * 2, NXCD = 8, WGM = 8;
DI int lds_byte(int r, int c) { const int st = (r >> 4) * 2 + (c >> 5), rr = r & 15, cc = c & 31, ob = rr * 64 + cc * 2; return st * 1024 + (ob ^ (((ob >> 9) & 1) << 5)); }
DI void stage_rc(int b, int& R, int& C) { const int st = b / 1024, sb = b % 1024, swz = sb ^ (((sb >> 9) & 1) << 5); R = (st >> 1) * 16 + swz / 64; C = (st & 1) * 32 + (swz % 64) / 2; }

struct Unit { int pm, pn, aux; };

struct SchedTile {
    const char* Ab; const char* Bb; size_t tA, tB; int nM, nN, nwg, G, c;
    DI void init(const void* A, size_t tA_, const void* B, size_t tB_, int nM_, int nN_) { Ab = (const char*)A; Bb = (const char*)B; tA = tA_; tB = tB_; nM = nM_; nN = nN_; nwg = nM * nN; G = gridDim.x; c = obid(); }
    DI bool next(int i, Unit& u) const {
        const long L = (long)i * G + c; if (L >= nwg) return false;
        int wgid = (int)L; { const int q = nwg / NXCD, r = nwg % NXCD, xcd = wgid % NXCD, off = wgid / NXCD; wgid = (xcd < r ? xcd * (q + 1) : r * (q + 1) + (xcd - r) * q) + off; }
        const int nig = WGM * nN, gid = wgid / nig, fm = gid * WGM, gsz = (nM - fm) < WGM ? (nM - fm) : WGM;
        u.pm = fm + ((wgid % nig) % gsz); u.pn = (wgid % nig) / gsz; u.aux = 0; return true;
    }
    DI const char* A(const Unit& u) const { return Ab + (size_t)u.pm * tA; }
    DI const char* B(const Unit& u) const { return Bb + (size_t)u.pn * tB; }
};

struct SchedBr {
    const char* HBp; const char* Wc; int G, c, ntiles;
    DI bool next(int i, Unit& u) const { const int ti = (i / 9) * G + c; if (ti >= ntiles) return false; u.pm = ti >> 2; u.pn = ti & 3; u.aux = i % 9; return true; }
    DI const char* A(const Unit& u) const { const int off = u.aux < 6 ? (u.aux & 1) * 512 : 1024 + (u.aux - 6) * 512; return HBp + ((size_t)u.pm * 256 * HBS + off) * 2; }
    DI const char* B(const Unit& u) const { const int r = u.aux < 6 ? (u.aux >> 1) : (u.aux - 6); const int off = u.aux < 6 ? 512 + (u.aux & 1) * 512 : 0; return Wc + ((size_t)(r * 1024 + u.pn * 256) * 1536 + off) * 2; }
};

template <int K, int lda, int ldb, class Epi, class Sched>
DI void gemm_phase(LAS unsigned char* lds, const Sched& S, const Epi& E) {
    const int tid = otid(), wid = __builtin_amdgcn_readfirstlane(tid >> 6), lane = tid & 63, wr = wid >> 2, wc = wid & 3, fr = lane & 15, fq = lane >> 4;
    constexpr int nt = K / BK;
    unsigned voffA[2], voffB[2];
#pragma unroll
    for (int i = 0; i < 2; ++i) { int R, C; stage_rc(tid * 16 + i * 8192, R, C); voffA[i] = (unsigned)(R * lda + C) * 2u; voffB[i] = (unsigned)(R * ldb + C) * 2u; }
    constexpr size_t kstep = (size_t)(BK * 2);
    constexpr size_t hstepA = (size_t)HALF * lda * 2, hstepB = (size_t)HALF * ldb * 2;
    const unsigned ldsw = (unsigned)wid * 1024u;
    const int aoff = lds_byte(wr * 64 + fr, fq * 8), boff = lds_byte(wc * 32 + fr, fq * 8);
#define PG8_SA(b, h) (((b) * 2 + (h)) * HTB)
#define PG8_SB(b, h) ((4 + (b) * 2 + (h)) * HTB)
#define PG8_STAGE(bufoff, gbase, voff) do { _Pragma("unroll") for (int _i = 0; _i < 2; ++_i) \
        __builtin_amdgcn_global_load_lds((const unsigned*)((const char*)(gbase) + (voff)[_i]), (LAS unsigned*)(lds + (bufoff) + ldsw + _i * 8192), 16, 0, 0); } while (0)
#define PG8_LDA(dst, b, h) do { _Pragma("unroll") for (int m = 0; m < 4; ++m) _Pragma("unroll") for (int k = 0; k < 2; ++k) dst[m][k] = *(const LAS bf16x8*)(lds + PG8_SA(b, h) + aoff + m * 2048 + k * 1024); } while (0)
#define PG8_LDB(dst, b, h) do { _Pragma("unroll") for (int n = 0; n < 2; ++n) _Pragma("unroll") for (int k = 0; k < 2; ++k) dst[n][k] = *(const LAS bf16x8*)(lds + PG8_SB(b, h) + boff + n * 2048 + k * 1024); } while (0)
#define PG8_MMA(ai, bj, At, Bt) do { __builtin_amdgcn_s_setprio(1); _Pragma("unroll") for (int m = 0; m < 4; ++m) _Pragma("unroll") for (int n = 0; n < 2; ++n) _Pragma("unroll") for (int k = 0; k < 2; ++k) \
        acc[ai][bj][m][n] = __builtin_amdgcn_mfma_f32_16x16x32_bf16(Bt[n][k], At[m][k], acc[ai][bj][m][n], 0, 0, 0); __builtin_amdgcn_s_setprio(0); } while (0)
#define PG8_WAIT_V(n) asm volatile("s_waitcnt vmcnt(" #n ")" ::: "memory")
#define PG8_WAIT_L(n) asm volatile("s_waitcnt lgkmcnt(" #n ")" ::: "memory")
#define PG8_BAR __builtin_amdgcn_s_barrier()
#define PG8_SCHED __builtin_amdgcn_sched_barrier(0)
    Unit cur, nxt; int ui = 0;
    if (!S.next(0, cur)) return;
    f32x4 acc[2][2][4][2];
#pragma unroll
    for (int a = 0; a < 2; ++a)
#pragma unroll
        for (int b = 0; b < 2; ++b)
#pragma unroll
            for (int m = 0; m < 4; ++m)
#pragma unroll
                for (int n = 0; n < 2; ++n) acc[a][b][m][n] = (f32x4){0.f, 0.f, 0.f, 0.f};
    bf16x8 At[4][2], B0[2][2], B1[2][2];
    const char* cA = S.A(cur); const char* cB = S.B(cur);
    PG8_STAGE(PG8_SB(0, 0), cB, voffB); PG8_STAGE(PG8_SA(0, 0), cA, voffA); PG8_STAGE(PG8_SB(0, 1), cB + hstepB, voffB); PG8_STAGE(PG8_SA(0, 1), cA + hstepA, voffA);
    if (wr == 1) PG8_BAR;
    PG8_WAIT_V(4); PG8_BAR;
    PG8_STAGE(PG8_SB(1, 0), cB + kstep, voffB); PG8_STAGE(PG8_SA(1, 0), cA + kstep, voffA); PG8_STAGE(PG8_SB(1, 1), cB + hstepB + kstep, voffB);
    PG8_WAIT_V(6); PG8_BAR;
    for (;;) {
        const bool has_next = S.next(ui + 1, nxt);
        const char* nA = has_next ? S.A(nxt) : cA; const char* nB = has_next ? S.B(nxt) : cB;
        for (int t = 0; t < nt; t += 2) {
            const bool last = (t == nt - 2);
            const char* a1 = cA + (size_t)(t + 1) * kstep;
            const char* a2 = last ? nA : cA + (size_t)(t + 2) * kstep; const char* b2 = last ? nB : cB + (size_t)(t + 2) * kstep;
            const char* a3 = a2 + kstep; const char* b3 = b2 + kstep;
            PG8_LDB(B0, 0, 0); PG8_SCHED; PG8_LDA(At, 0, 0); PG8_STAGE(PG8_SA(1, 1), a1 + hstepA, voffA);
            PG8_WAIT_L(8); PG8_BAR; PG8_WAIT_L(0); PG8_MMA(0, 0, At, B0); PG8_BAR; PG8_SCHED;
            PG8_LDB(B1, 0, 1); PG8_STAGE(PG8_SB(0, 0), b2, voffB);
            PG8_BAR; PG8_WAIT_L(0); PG8_MMA(0, 1, At, B1); PG8_BAR;
            PG8_LDA(At, 0, 1); PG8_STAGE(PG8_SA(0, 0), a2, voffA);
            PG8_BAR; PG8_WAIT_L(0); PG8_MMA(1, 0, At, B0); PG8_BAR; PG8_SCHED;
            PG8_STAGE(PG8_SB(0, 1), b2 + hstepB, voffB);
            PG8_WAIT_V(6); PG8_BAR; PG8_MMA(1, 1, At, B1); PG8_BAR;
            PG8_LDB(B0, 1, 0); PG8_SCHED; PG8_LDA(At, 1, 0); PG8_STAGE(PG8_SA(0, 1), a2 + hstepA, voffA);
            PG8_WAIT_L(8); PG8_BAR; PG8_WAIT_L(0); PG8_MMA(0, 0, At, B0); PG8_BAR; PG8_SCHED;
            PG8_LDB(B1, 1, 1); PG8_STAGE(PG8_SB(1, 0), b3, voffB);
            PG8_BAR; PG8_WAIT_L(0); PG8_MMA(0, 1, At, B1); PG8_BAR;
            PG8_LDA(At, 1, 1); PG8_STAGE(PG8_SA(1, 0), a3, voffA);
            PG8_BAR; PG8_WAIT_L(0); PG8_MMA(1, 0, At, B0); PG8_BAR; PG8_SCHED;
            PG8_STAGE(PG8_SB(1, 1), b3 + hstepB, voffB);
            PG8_WAIT_V(6); PG8_BAR; PG8_MMA(1, 1, At, B1); PG8_BAR;
        }
        const bool zero = E(acc, cur, wr, wc, fr, fq);
        if (!has_next) break;
        if (zero) {
#pragma unroll
            for (int a = 0; a < 2; ++a)
#pragma unroll
                for (int b = 0; b < 2; ++b)
#pragma unroll
                    for (int m = 0; m < 4; ++m)
#pragma unroll
                        for (int n = 0; n < 2; ++n) acc[a][b][m][n] = (f32x4){0.f, 0.f, 0.f, 0.f};
        }
        cur = nxt; cA = nA; cB = nB; ++ui;
    }
    PG8_WAIT_V(0);
    if (wr == 0) PG8_BAR;
    PG8_BAR;
#undef PG8_SA
#undef PG8_SB
#undef PG8_STAGE
#undef PG8_LDA
#undef PG8_LDB
#undef PG8_MMA
#undef PG8_WAIT_V
#undef PG8_WAIT_L
#undef PG8_BAR
#undef PG8_SCHED
}

typedef f32x4 AccT[2][2][4][2];

struct EpiUp {
    bf16_t* act;
    DI bool operator()(AccT& acc, const Unit& u, int wr, int wc, int fr, int fq) const {
        asm volatile("" : "+v"(fr)); asm volatile("" : "+v"(fq));
        const int row0 = u.pm * BM + wr * 64 + fr, c0 = u.pn * 128 + wc * 16 + 4 * fq;
#pragma unroll
        for (int ai = 0; ai < 2; ++ai)
#pragma unroll
            for (int m = 0; m < 4; ++m) { bf16_t* rowp = act + (size_t)(row0 + ai * HALF + m * 16) * DFFP + c0;
#pragma unroll
                for (int bj = 0; bj < 2; ++bj) { const f32x4 g = acc[ai][bj][m][0], up = acc[ai][bj][m][1];
                    u32x2 w; w.x = pk2(siluf_(g[0]) * up[0], siluf_(g[1]) * up[1]); w.y = pk2(siluf_(g[2]) * up[2], siluf_(g[3]) * up[3]);
                    *(u32x2*)(rowp + bj * 64) = w; } }
        return true;
    }
};

struct EpiRes {
    float* X; const float* gm; const float* stats; const float* lg; const float* lb; float s; int ident;
    DI bool operator()(AccT& acc, const Unit& u, int wr, int wc, int fr, int fq) const {
        asm volatile("" : "+v"(fr)); asm volatile("" : "+v"(fq));
        const int row0 = u.pm * BM + wr * 64 + fr, col0 = u.pn * BM + wc * 32 + 4 * fq;
        const int rb = (u.pm * BM < TL) ? ((u.pm * BM) >> 12) : 8;
        const float* gp = gm + (size_t)rb * 9216 + col0;
        const float sv = s; const f32x4 s4 = (f32x4){sv, sv, sv, sv};
        f32x4 gv[2][2], gl[2][2], bl[2][2];
#pragma unroll
        for (int bj = 0; bj < 2; ++bj)
#pragma unroll
            for (int n = 0; n < 2; ++n) { gv[bj][n] = *(const f32x4*)(gp + bj * HALF + n * 16) * s4;
                gl[bj][n] = *(const f32x4*)(lg + col0 + bj * HALF + n * 16) * ALPHA; bl[bj][n] = *(const f32x4*)(lb + col0 + bj * HALF + n * 16) * ALPHA;
                if (ident) { gl[bj][n] = (f32x4){ALPHA, ALPHA, ALPHA, ALPHA}; bl[bj][n] = (f32x4){0.f, 0.f, 0.f, 0.f}; } }
#pragma unroll
        for (int ai = 0; ai < 2; ++ai)
#pragma unroll
            for (int m = 0; m < 4; ++m) { const int row = row0 + ai * HALF + m * 16; float* rowp = X + (size_t)row * D + col0;
                float mu = stats[(size_t)row * 2], rstd = stats[(size_t)row * 2 + 1];
                if (ident) { mu = 0.f; rstd = 1.f; }
#pragma unroll
                for (int bj = 0; bj < 2; ++bj)
#pragma unroll
                    for (int n = 0; n < 2; ++n) { f32x4* px = (f32x4*)(rowp + bj * HALF + n * 16); const f32x4 t = *px; *px = ((t - mu) * rstd) * gl[bj][n] + bl[bj][n] + gv[bj][n] * acc[ai][bj][m][n]; } }
        return true;
    }
};

struct EpiIn {
    bf16_t* Q; bf16_t* Kb; bf16_t* VT; bf16_t* VTC; bf16_t* U; bf16_t* Z; const float* ropec; const float* ropes;
    DI bool operator()(AccT& acc, const Unit& u, int wr, int wc, int fr, int fq) const {
        asm volatile("" : "+v"(fr)); asm volatile("" : "+v"(fq));
        const int row0 = u.pm * BM + wr * 64 + fr;
        const bool lat = (u.pm * BM) < TL;
        const int pn = u.pn;
#pragma unroll
        for (int ai = 0; ai < 2; ++ai)
#pragma unroll
            for (int m = 0; m < 4; ++m) {
                const int row = row0 + ai * HALF + m * 16;
                if (pn <= 2) {
                    const int s = row & 4095;
                    const int p = (wc & 1) ? (s & 63) : (s >> 6);
                    f32x4 cs = (f32x4){1.f, 1.f, 1.f, 1.f}, sn = (f32x4){0.f, 0.f, 0.f, 0.f};
                    if (lat) { cs = *(const f32x4*)(ropec + p * 16 + 4 * fq); sn = *(const f32x4*)(ropes + p * 16 + 4 * fq); }
#pragma unroll
                    for (int bj = 0; bj < 2; ++bj) {
                        const f32x4 x1 = acc[ai][bj][m][0], x2 = acc[ai][bj][m][1];
                        if (pn < 2 || bj == 0) {
                            const f32x4 o1 = x1 * cs - x2 * sn, o2 = x1 * sn + x2 * cs;
                            u32x2 w1, w2; w1.x = pk2(o1[0], o1[1]); w1.y = pk2(o1[2], o1[3]); w2.x = pk2(o2[0], o2[1]); w2.y = pk2(o2[2], o2[3]);
                            bf16_t* dst = (pn < 2) ? (Q + (size_t)row * 512 + pn * 256 + bj * HALF + wc * 32 + 4 * fq) : (Kb + (size_t)row * 128 + wc * 32 + 4 * fq);
                            *(u32x2*)dst = w1; *(u32x2*)(dst + 16) = w2;
                        } else {
                            const int cv = wc * 32 + 4 * fq;
                            bf16_t* dst; size_t cst;
                            if (lat) { const int b = row >> 12; dst = VT + ((size_t)(b * 128 + cv)) * 4096 + s; cst = 4096; }
                            else { const int rc = row - TL; const int b = rc >> 8; dst = VTC + ((size_t)(b * 128 + cv)) * 256 + (rc & 255); cst = 256; }
#pragma unroll
                            for (int j = 0; j < 4; ++j) { dst[(size_t)j * cst] = f2bf(x1[j]); dst[(size_t)(16 + j) * cst] = f2bf(x2[j]); }
                        }
                    }
                } else {
                    bf16_t* base = (pn <= 4) ? (U + (size_t)row * 512 + (pn - 3) * 256) : (Z + (size_t)row * 512 + (pn - 5) * 256);
                    base += wc * 32 + 4 * fq;
#pragma unroll
                    for (int bj = 0; bj < 2; ++bj)
#pragma unroll
                        for (int n = 0; n < 2; ++n) { const f32x4 v = acc[ai][bj][m][n];
                            u32x2 w; w.x = pk2(geluf_(v[0]), geluf_(v[1])); w.y = pk2(geluf_(v[2]), geluf_(v[3]));
                            *(u32x2*)(base + bj * HALF + n * 16) = w; }
                }
            }
        return true;
    }
};

struct EpiFT {
    bf16_t* FT; bf16_t* FTC;
    DI bool operator()(AccT& acc, const Unit& u, int wr, int wc, int fr, int fq) const {
        asm volatile("" : "+v"(fr)); asm volatile("" : "+v"(fq));
        const int isS = u.pm >> 1;
        const int ch0 = (u.pm & 1) * 256 + wr * 64 + fr;
        bf16_t* base; size_t rst;
        if (u.pn < 128) { const int b = u.pn >> 4; base = FT + (size_t)b * 512 * 8192 + isS * 4096 + ((u.pn & 15) * 256) + wc * 32 + 4 * fq; rst = 8192; }
        else { const int b = u.pn - 128; base = FTC + (size_t)b * 512 * 512 + isS * 256 + wc * 32 + 4 * fq; rst = 512; }
#pragma unroll
        for (int ai = 0; ai < 2; ++ai)
#pragma unroll
            for (int m = 0; m < 4; ++m) { bf16_t* rowp = base + (size_t)(ch0 + ai * HALF + m * 16) * rst;
#pragma unroll
                for (int bj = 0; bj < 2; ++bj)
#pragma unroll
                    for (int n = 0; n < 2; ++n) { const f32x4 v = acc[ai][bj][m][n]; u32x2 w; w.x = pk2(v[0], v[1]); w.y = pk2(v[2], v[3]); *(u32x2*)(rowp + bj * HALF + n * 16) = w; } }
        return true;
    }
};

struct EpiDft {
    bf16_t* HB; int rowbase, rpb;
    DI bool operator()(AccT& acc, const Unit& u, int wr, int wc, int fr, int fq) const {
        asm volatile("" : "+v"(fr)); asm volatile("" : "+v"(fq));
        const int b = u.pn >> 1;
        const int k0 = u.pm * BM + wr * 64 + fr;
        bf16_t* base = HB + (size_t)(rowbase + b * rpb) * HBS + 2048 + (u.pn & 1) * 256 + wc * 32 + 4 * fq;
#pragma unroll
        for (int ai = 0; ai < 2; ++ai)
#pragma unroll
            for (int m = 0; m < 4; ++m) { bf16_t* rowp = base + (size_t)(k0 + ai * HALF + m * 16) * HBS;
#pragma unroll
                for (int bj = 0; bj < 2; ++bj)
#pragma unroll
                    for (int n = 0; n < 2; ++n) { const f32x4 v = acc[ai][bj][m][n]; u32x2 w; w.x = pk2(v[0], v[1]); w.y = pk2(v[2], v[3]); *(u32x2*)(rowp + bj * HALF + n * 16) = w; } }
        return true;
    }
};

struct EpiBr {
    bf16_t* merged; unsigned char* scr;
    DI bool operator()(AccT& acc, const Unit& u, int wr, int wc, int fr, int fq) const {
        asm volatile("" : "+v"(fr)); asm volatile("" : "+v"(fq));
        const int sub = u.aux;
        const int tid = (wr * 4 + wc) * 64 + fq * 16 + fr;
        const int r = sub < 6 ? (sub >> 1) : (sub - 6);
        unsigned char* sp = scr + (size_t)r * 131072 + (size_t)tid * 16;
        if (sub < 6 && (sub & 1)) {
#pragma unroll
            for (int ai = 0; ai < 2; ++ai)
#pragma unroll
                for (int bj = 0; bj < 2; ++bj)
#pragma unroll
                    for (int m = 0; m < 4; ++m) { const f32x4 a = acc[ai][bj][m][0], b = acc[ai][bj][m][1];
                        u32x4 w; w.x = pk2(sigmoidf_(a[0]), sigmoidf_(a[1])); w.y = pk2(sigmoidf_(a[2]), sigmoidf_(a[3])); w.z = pk2(sigmoidf_(b[0]), sigmoidf_(b[1])); w.w = pk2(sigmoidf_(b[2]), sigmoidf_(b[3]));
                        *(u32x4*)(sp + (size_t)(((ai * 2 + bj) * 4 + m) * 8192)) = w; }
        }
        if (sub == 8) {
            const int row0 = u.pm * BM + wr * 64 + fr, col0 = u.pn * BM + wc * 32 + 4 * fq;
#pragma unroll
            for (int ai = 0; ai < 2; ++ai)
#pragma unroll
                for (int bj = 0; bj < 2; ++bj)
#pragma unroll
                    for (int m = 0; m < 4; ++m) {
                        const u32x4 g = *(const u32x4*)(sp + (size_t)(((ai * 2 + bj) * 4 + m) * 8192));
                        const f32x4 a = acc[ai][bj][m][0], b = acc[ai][bj][m][1];
                        bf16_t* dst = merged + (size_t)(row0 + ai * HALF + m * 16) * D + col0 + bj * HALF;
                        u32x2 w0, w1; w0.x = pk2(bflo(g.x) * a[0], bfhi(g.x) * a[1]); w0.y = pk2(bflo(g.y) * a[2], bfhi(g.y) * a[3]);
                        w1.x = pk2(bflo(g.z) * b[0], bfhi(g.z) * b[1]); w1.y = pk2(bflo(g.w) * b[2], bfhi(g.w) * b[3]);
                        *(u32x2*)dst = w0; *(u32x2*)(dst + 16) = w1;
                    }
        }
        const bool scale = (sub == 6 || sub == 7);
        const float cf = (sub < 6 && !(sub & 1)) ? 1.0f : 0.0f;
#pragma unroll
        for (int ai = 0; ai < 2; ++ai)
#pragma unroll
            for (int bj = 0; bj < 2; ++bj)
#pragma unroll
                for (int m = 0; m < 4; ++m) {
                    f32x4 fa = (f32x4){cf, cf, cf, cf}, fb = fa;
                    if (scale) {
                        const u32x4 g = *(const u32x4*)(sp + (size_t)(((ai * 2 + bj) * 4 + m) * 8192));
                        const u32x4 d = *(const u32x4*)(sp + 131072 + (size_t)(((ai * 2 + bj) * 4 + m) * 8192));
                        fa = (f32x4){bflo(g.x) * __builtin_amdgcn_rcpf(bflo(d.x)), bfhi(g.x) * __builtin_amdgcn_rcpf(bfhi(d.x)), bflo(g.y) * __builtin_amdgcn_rcpf(bflo(d.y)), bfhi(g.y) * __builtin_amdgcn_rcpf(bfhi(d.y))};
                        fb = (f32x4){bflo(g.z) * __builtin_amdgcn_rcpf(bflo(d.z)), bfhi(g.z) * __builtin_amdgcn_rcpf(bfhi(d.z)), bflo(g.w) * __builtin_amdgcn_rcpf(bflo(d.w)), bfhi(g.w) * __builtin_amdgcn_rcpf(bfhi(d.w))};
                    }
                    acc[ai][bj][m][0] *= fa; acc[ai][bj][m][1] *= fb;
                }
        return false;
    }
};

#define XB_TMO      128
#define XB_XCNT(j)  (256  + 64 * (j))
#define XB_XSUB(j)  (1280 + 64 * (j))
#define XB_XGEN(j)  (2304 + 64 * (j))
#define XB_TOP      3328
#define XB_TOPGEN   3392
#define XCD_BAR_WORDS 3456
#define XB_SPIN_CAP (1u << 18)
DI unsigned xb_ld(unsigned* p)              { return __hip_atomic_load(p, __ATOMIC_RELAXED, __HIP_MEMORY_SCOPE_AGENT); }
DI unsigned xb_add(unsigned* p, unsigned v) { return __hip_atomic_fetch_add(p, v, __ATOMIC_RELAXED, __HIP_MEMORY_SCOPE_AGENT); }
DI unsigned xb_xcc_id() { return (unsigned)__builtin_amdgcn_s_getreg((3 << 11) | 20) & 0xFu; }
#define XB_SPIN(cond, bar) do { unsigned _sp = 0; while (cond) { __builtin_amdgcn_s_sleep(1); \
    if ((++_sp & 255u) == 0u) { if (xb_ld(&(bar)[XB_TMO])) break; if (_sp > XB_SPIN_CAP) { atomicAdd(&(bar)[XB_TMO], 1u); break; } } } } while (0)
struct XcdBarrier { unsigned* bar; unsigned x; volatile LAS unsigned* st; };
DI XcdBarrier xcd_barrier_post(unsigned* bar, volatile LAS unsigned* st) {
    XcdBarrier b; b.bar = bar; b.x = xb_xcc_id(); b.st = st;
    if (threadIdx.x == 0) (void)xb_add(&bar[XB_XCNT(b.x)], 1u);
    return b;
}
DI void xcd_barrier_complete(unsigned* bar, unsigned x, unsigned& nloc, unsigned& nx) {
    const unsigned G = gridDim.x * gridDim.y * gridDim.z;
    unsigned sum, cnt, mine, sp = 0u;
    for (;;) {
        sum = 0u; cnt = 0u; mine = 0u;
#pragma unroll
        for (unsigned j = 0; j < 16; ++j) { const unsigned c = xb_ld(&bar[XB_XCNT(j)]); sum += c; cnt += (c > 0u) ? 1u : 0u; mine = (j == x) ? c : mine; }
        if (sum == G) break;
        __builtin_amdgcn_s_sleep(1);
        if ((++sp & 255u) == 0u) { if (xb_ld(&bar[XB_TMO])) break; if (sp > XB_SPIN_CAP) { atomicAdd(&bar[XB_TMO], 1u); break; } }
    }
    nloc = mine > 0u ? mine : 1u; nx = cnt > 0u ? cnt : 1u;
}
DI void xcd_barrier(const XcdBarrier& b) {
    asm volatile("s_waitcnt vmcnt(0)" ::: "memory");
    __syncthreads();
    if (threadIdx.x == 0) {
        unsigned* bar = b.bar;
        __builtin_amdgcn_s_waitcnt(0);
        unsigned nloc = b.st[0], nx = b.st[1];
        if (nloc == 0u) { xcd_barrier_complete(bar, b.x, nloc, nx); b.st[0] = nloc; b.st[1] = nx; }
        const unsigned old = xb_add(&bar[XB_XSUB(b.x)], 1u);
        const unsigned gen = old / nloc;
        if (old + 1u == (gen + 1u) * nloc) {
            __builtin_amdgcn_fence(__ATOMIC_RELEASE, "agent");
            asm volatile("s_waitcnt vmcnt(0)" ::: "memory");
            const unsigned og = xb_add(&bar[XB_TOP], 1u);
            const unsigned tg = og / nx;
            if (og + 1u == (tg + 1u) * nx) xb_add(&bar[XB_TOPGEN], 1u);
            else XB_SPIN(xb_ld(&bar[XB_TOPGEN]) == tg, bar);
            __builtin_amdgcn_fence(__ATOMIC_ACQUIRE, "agent");
            xb_add(&bar[XB_XGEN(b.x)], 1u);
            asm volatile("s_waitcnt vmcnt(0)" ::: "memory");
        } else {
            XB_SPIN(xb_ld(&bar[XB_XGEN(b.x)]) == gen, bar);
            __builtin_amdgcn_fence(__ATOMIC_ACQUIRE, "agent");
            asm volatile("s_waitcnt vmcnt(0)" ::: "memory");
        }
    }
    __syncthreads();
}

DI void phase_mods(const Params& P, unsigned char* shm) {
    float* s = (float*)shm;
    float* red = s + 9 * 1024;
    const int tid = otid();
    const float* c = oin(P, I_C); const float* cc = oin(P, I_CCTX);
    for (int idx = tid; idx < 9 * 1024; idx += 512) { const int rb = idx >> 10, k = idx & 1023; const float v = rb < 8 ? c[rb * 1024 + k] : cc[k]; s[idx] = siluf_(v); }
    __syncthreads();
    float* mods = (float*)(ows(P) + OFF_MODS);
    const float* wmod = oin(P, I_WMOD); const float* bmod = oin(P, I_BMOD);
    for (int u = obid(); u < 288; u += gridDim.x) {
        const int l = u / 72, n0 = (u % 72) * 128, cgp = tid & 31, ks = tid >> 5;
        f32x4 acc[9];
#pragma unroll
        for (int rb = 0; rb < 9; ++rb) acc[rb] = (f32x4){0.f, 0.f, 0.f, 0.f};
        const float* wp = wmod + ((size_t)l * 1024 + ks * 64) * 9216 + n0 + cgp * 4;
        for (int kk = 0; kk < 64; ++kk) { const f32x4 w = *(const f32x4*)(wp + (size_t)kk * 9216);
#pragma unroll
            for (int rb = 0; rb < 9; ++rb) acc[rb] += w * s[rb * 1024 + ks * 64 + kk]; }
#pragma unroll
        for (int rb = 0; rb < 9; ++rb) *(f32x4*)(red + ((ks * 9 + rb) * 128 + cgp * 4)) = acc[rb];
        __syncthreads();
        for (int idx = tid; idx < 1152; idx += 512) { const int rb = idx >> 7, c2 = idx & 127; float sum = bmod[l * 9216 + n0 + c2];
            for (int k2 = 0; k2 < 16; ++k2) sum += red[(k2 * 9 + rb) * 128 + c2];
            mods[((size_t)l * 9 + rb) * 9216 + n0 + c2] = sum; }
        __syncthreads();
    }
}

DI void phase_tables(const Params& P, unsigned char* shm) {
    const int tid = otid();
    float* tab = (float*)shm;
    for (int j = tid; j < 4096; j += 512) tab[j] = cospif((float)j * (1.0f / 2048.0f)) * (1.0f / 64.0f);
    __syncthreads();
    if (obid() == 0) {
        float* rc = (float*)(ows(P) + OFF_ROPE); float* rs = rc + 1024;
        for (int idx = tid; idx < 1024; idx += 512) { const int p = idx >> 4, f = idx & 15; const float inv = powf(10000.0f, -(float)f / 16.0f); const float ang = (float)p * inv; rc[idx] = cosf(ang); rs[idx] = sinf(ang); }
    }
    bf16_t* dft = (bf16_t*)(ows(P) + OFF_DFT);
    const long gid = (long)obid() * 512 + tid, gstride = (long)gridDim.x * 512;
    for (long it = gid; it < 4096l * 1024; it += gstride) {
        const int k = (int)(it >> 10), n0 = ((int)it & 1023) * 8; const bool isS = n0 >= 4096; const int nn = n0 & 4095;
        float v[8];
#pragma unroll
        for (int j = 0; j < 8; ++j) { const int idx = (k * (nn + j)) & 4095; v[j] = isS ? -tab[(idx + 3072) & 4095] : tab[idx]; }
        u32x4 w; w.x = pk2(v[0], v[1]); w.y = pk2(v[2], v[3]); w.z = pk2(v[4], v[5]); w.w = pk2(v[6], v[7]);
        *(u32x4*)(dft + (size_t)k * 8192 + n0) = w;
    }
    bf16_t* dftc = (bf16_t*)(ows(P) + OFF_DFTC);
    for (long it = gid; it < 256l * 64; it += gstride) {
        const int k = (int)(it >> 6), n0 = ((int)it & 63) * 8; const bool isS = n0 >= 256; const int nn = n0 & 255;
        float v[8];
#pragma unroll
        for (int j = 0; j < 8; ++j) { const int idx = ((k * (nn + j)) & 255) * 16; v[j] = (isS ? -tab[(idx + 3072) & 4095] : tab[idx]) * 4.0f; }
        u32x4 w; w.x = pk2(v[0], v[1]); w.y = pk2(v[2], v[3]); w.z = pk2(v[4], v[5]); w.w = pk2(v[6], v[7]);
        *(u32x4*)(dftc + (size_t)k * 512 + n0) = w;
    }
    __syncthreads();
}

DI void wconv_tile(const float* src, int lds_, int Ksrc, int mode, bf16_t* dst, int ldd, int coff, int kt, int ntile, float* tile) {
    const int tid = otid();
    const int k0 = kt * 64, n0 = ntile * 64;
    { const int nn = tid & 63, np = n0 + nn; int col = np;
      if (mode == 1) { const int t = np >> 8, w = np & 255, grp = w >> 5, isup = (w >> 4) & 1, i = w & 15; const int ff = t * 128 + grp * 16 + i; col = ff < DFF ? ff + isup * DFF : -1; }
#pragma unroll
      for (int i = 0; i < 8; ++i) { const int kk = (tid >> 6) + i * 8, k = k0 + kk; float v = 0.f; if (col >= 0 && k < Ksrc) v = src[(size_t)k * lds_ + col]; tile[kk * 65 + nn] = v; } }
    __syncthreads();
    { const int nn2 = tid >> 3, kq = (tid & 7) * 8; float v[8];
#pragma unroll
      for (int j = 0; j < 8; ++j) v[j] = tile[(kq + j) * 65 + nn2];
      u32x4 w; w.x = pk2(v[0], v[1]); w.y = pk2(v[2], v[3]); w.z = pk2(v[4], v[5]); w.w = pk2(v[6], v[7]);
      *(u32x4*)(dst + (size_t)(n0 + nn2) * ldd + coff + k0 + kq) = w; }
    __syncthreads();
}

DI void phase_wconv(const Params& P, int l, int grp, int w0, int nw, unsigned char* shm) {
    float* tile = (float*)shm;
    bf16_t* W = (bf16_t*)(ows(P) + OFF_W);
    const int tid = otid();
    constexpr int N_UP = 16 * 88, N_DN = 44 * 16, N_IN = 16 * 28, N_CB = 8 * 16, N_CG = 16 * 16, N_OUT = 16 * 16, N_WF = 128;
    const int wk = obid() - w0;
    if (wk < 0 || wk >= nw) return;
    __syncthreads();
    if (grp < 2) {
        const int f = grp;
        for (int u = wk; u < N_UP + N_DN; u += nw) {
            if (u < N_UP) wconv_tile(oin(P, I_WUP) + ((size_t)(l * 2 + f)) * 1024 * 5504, 5504, 1024, 1, W + (f ? W_UP1 : W_UP0), 1024, 0, u % 16, u / 16, tile);
            else { const int v = u - N_UP; wconv_tile(oin(P, I_WDN) + ((size_t)(l * 2 + f)) * 2752 * 1024, 1024, 2752, 0, W + (f ? W_DN1 : W_DN0), 2816, 0, v % 44, v / 44, tile); }
        }
        return;
    }
    constexpr int TOT = N_IN + 3 * N_CB + 3 * N_CG + N_OUT + N_WF;
    for (int u = wk; u < TOT; u += nw) {
        int v = u;
        if (v < N_IN) { wconv_tile(oin(P, I_WIN) + (size_t)l * 1024 * 2304, 2304, 1024, 0, W + W_IN, 1024, 0, v % 16, v / 16, tile); continue; }
        v -= N_IN;
        if (v < 3 * N_CB) { const int r = v / N_CB; v %= N_CB; wconv_tile(oin(P, I_WBR) + ((size_t)(l * 3 + r)) * 512 * 1024, 1024, 512, 0, W + W_CAT + (size_t)r * 1024 * 1536, 1536, 0, v % 8, v / 8, tile); continue; }
        v -= 3 * N_CB;
        if (v < 3 * N_CG) { const int r = v / N_CG; v %= N_CG; wconv_tile(oin(P, I_WGATE) + ((size_t)(l * 3 + r)) * 1024 * 1024, 1024, 1024, 0, W + W_CAT + (size_t)r * 1024 * 1536, 1536, 512, v % 16, v / 16, tile); continue; }
        v -= 3 * N_CG;
        if (v < N_OUT) { wconv_tile(oin(P, I_WOUT) + (size_t)l * 1024 * 1024, 1024, 1024, 0, W + W_OUT, 1024, 0, v % 16, v / 16, tile); continue; }
        v -= N_OUT;
        {
            float* rows = tile; float* tab = rows + 4096;
            const float* src = oin(P, I_WIN) + (size_t)l * 1024 * 2304 + (size_t)(v * 8) * 2304 + 1792;
            for (int idx = tid; idx < 4096; idx += 512) rows[idx] = src[(size_t)(idx >> 9) * 2304 + (idx & 511)];
            if (tid < 128) tab[tid] = cospif((float)tid * (1.0f / 64.0f));
            __syncthreads();
            const int g = tid >> 7, m = tid & 127;
            float ac[8], as[8];
#pragma unroll
            for (int kk = 0; kk < 8; ++kk) { ac[kk] = 0.f; as[kk] = 0.f; }
            for (int c2 = 0; c2 < 128; ++c2) { const int idx = (m * c2) & 127; const float cv = tab[idx], sv = tab[(idx + 96) & 127];
#pragma unroll
                for (int kk = 0; kk < 8; ++kk) { const float w = rows[kk * 512 + g * 128 + c2]; ac[kk] += w * cv; as[kk] += w * sv; } }
            const float sc = 0.08838834764831845f;
            u32x4 wc_, ws_; wc_.x = pk2(ac[0] * sc, ac[1] * sc); wc_.y = pk2(ac[2] * sc, ac[3] * sc); wc_.z = pk2(ac[4] * sc, ac[5] * sc); wc_.w = pk2(ac[6] * sc, ac[7] * sc);
            ws_.x = pk2(as[0] * sc, as[1] * sc); ws_.y = pk2(as[2] * sc, as[3] * sc); ws_.z = pk2(as[4] * sc, as[5] * sc); ws_.w = pk2(as[6] * sc, as[7] * sc);
            *(u32x4*)(W + W_F + (size_t)tid * 1024 + v * 8) = wc_;
            *(u32x4*)(W + W_F + (size_t)(512 + tid) * 1024 + v * 8) = ws_;
            __syncthreads();
        }
    }
}

DI void phase_norm(const Params& P, const float* g, const float* bt, const float* mod, int jm, float* outp, int rend) {
    const int tid = otid(), wid = tid >> 6, lane = tid & 63;
    float* X = (float*)(ows(P) + OFF_X); bf16_t* HB = (bf16_t*)(ows(P) + OFF_HB); float* stats = (float*)(ows(P) + OFF_STATS);
    for (int r = obid() * 8 + wid; r < rend; r += gridDim.x * 8) {
        const float* src = g ? (X + (size_t)r * D) : (r < TL ? oin(P, I_X) + (size_t)r * D : oin(P, I_CTX) + (size_t)(r - TL) * D);
        f32x4 v[4];
#pragma unroll
        for (int q = 0; q < 4; ++q) v[q] = *(const f32x4*)(src + q * 256 + lane * 4);
        if (g) {
            float sum = 0.f;
#pragma unroll
            for (int q = 0; q < 4; ++q) sum += v[q][0] + v[q][1] + v[q][2] + v[q][3];
            const float mu = wave_sum(sum, lane) * (1.0f / 1024.0f);
            float sq = 0.f;
#pragma unroll
            for (int q = 0; q < 4; ++q) { v[q] -= mu; sq += v[q][0] * v[q][0] + v[q][1] * v[q][1] + v[q][2] * v[q][2] + v[q][3] * v[q][3]; }
            const float rstd = rsqrtf(wave_sum(sq, lane) * (1.0f / 1024.0f) + LN_EPS);
            if (lane == 0) { stats[(size_t)r * 2] = mu; stats[(size_t)r * 2 + 1] = rstd; }
#pragma unroll
            for (int q = 0; q < 4; ++q) { const f32x4 gg = *(const f32x4*)(g + q * 256 + lane * 4), bb = *(const f32x4*)(bt + q * 256 + lane * 4); v[q] = v[q] * rstd * gg + bb; }
        } else {
#pragma unroll
            for (int q = 0; q < 4; ++q) *(f32x4*)(X + (size_t)r * D + q * 256 + lane * 4) = v[q];
        }
        if (outp) {
#pragma unroll
            for (int q = 0; q < 4; ++q) *(f32x4*)(outp + (size_t)r * D + q * 256 + lane * 4) = v[q];
        }
        if (mod) {
            const int rb = r < TL ? (r >> 12) : 8;
            const float* sh = mod + (size_t)rb * 9216 + jm * 1024; const float* sc = sh + 1024;
#pragma unroll
            for (int q = 0; q < 4; ++q) { const f32x4 a = *(const f32x4*)(sh + q * 256 + lane * 4), b = *(const f32x4*)(sc + q * 256 + lane * 4);
                const f32x4 h = v[q] * (b + 1.0f) + a; u32x2 w; w.x = pk2(h[0], h[1]); w.y = pk2(h[2], h[3]);
                *(u32x2*)(HB + (size_t)r * HBS + q * 256 + lane * 4) = w; }
        }
    }
}

#define MFMA32(a, b, c) __builtin_amdgcn_mfma_f32_32x32x16_bf16((a), (b), (c), 0, 0, 0)
DI bf16x8 mk8(u32x2 lo, u32x2 hi) { u32x4 w; w.x = lo.x; w.y = lo.y; w.z = hi.x; w.w = hi.y; return __builtin_bit_cast(bf16x8, w); }
constexpr int AK_RS = 144;
constexpr int AV_RS_BAND = (384 + 8) * 2;
constexpr int AV_RS_CTX = (256 + 8) * 2;
constexpr int AK_BYTES_BAND = 384 * AK_RS, AK_BYTES_CTX = 256 * AK_RS;
constexpr float SC_LOG2E = 0.125f * 1.4426950408889634f;

struct AttnState { float m, l; f32x16 O[2]; };

template <bool MASKED>
DI void attn_tile2(AttnState (&st)[2], const bf16x8 (&Qf)[2][4], const LAS unsigned char* kl, const LAS unsigned char* vl, const int vrs, int lane, int qposA, int klo) {
    const int hh = lane >> 5;
    bf16x8 Kf[4];
#pragma unroll
    for (int kk = 0; kk < 4; ++kk) Kf[kk] = *(const LAS bf16x8*)(kl + kk * 32);
    bf16x8 Vf[2][2];
#pragma unroll
    for (int db = 0; db < 2; ++db)
#pragma unroll
        for (int c = 0; c < 2; ++c) { const LAS unsigned char* p = vl + db * 32 * vrs + c * 32; Vf[db][c] = mk8(*(const LAS u32x2*)p, *(const LAS u32x2*)(p + 16)); }
#pragma unroll
    for (int qb = 0; qb < 2; ++qb) {
        f32x16 s;
#pragma unroll
        for (int i = 0; i < 16; ++i) s[i] = 0.f;
#pragma unroll
        for (int kk = 0; kk < 4; ++kk) s = MFMA32(Kf[kk], Qf[qb][kk], s);
        float tmax = -3.0e38f;
        const int qpos = qposA + qb * 32;
#pragma unroll
        for (int i = 0; i < 16; ++i) {
            float sv = s[i] * SC_LOG2E;
            if (MASKED) { const int kpos = klo + (i & 3) + 8 * (i >> 2) + 4 * hh; const int dlt = qpos - kpos; if (dlt > 128 || dlt < -128) sv = -3.0e38f; }
            s[i] = sv; tmax = fmaxf(tmax, sv);
        }
        tmax = fmaxf(tmax, shx(tmax, 32, lane));
        const float mnew = fmaxf(st[qb].m, tmax);
        const float alpha = __builtin_amdgcn_exp2f(st[qb].m - mnew);
        float psum = 0.f;
#pragma unroll
        for (int i = 0; i < 16; ++i) { const float p = __builtin_amdgcn_exp2f(s[i] - mnew); s[i] = p; psum += p; }
        st[qb].l = st[qb].l * alpha + psum; st[qb].m = mnew;
        if (__builtin_amdgcn_ballot_w64(alpha != 1.0f) != 0ull) {
#pragma unroll
            for (int db = 0; db < 2; ++db)
#pragma unroll
                for (int i = 0; i < 16; ++i) st[qb].O[db][i] *= alpha;
        }
        bf16x8 Pf[2];
#pragma unroll
        for (int c = 0; c < 2; ++c) { u32x4 w; w.x = pk2(s[8 * c + 0], s[8 * c + 1]); w.y = pk2(s[8 * c + 2], s[8 * c + 3]); w.z = pk2(s[8 * c + 4], s[8 * c + 5]); w.w = pk2(s[8 * c + 6], s[8 * c + 7]); Pf[c] = __builtin_bit_cast(bf16x8, w); }
#pragma unroll
        for (int db = 0; db < 2; ++db)
#pragma unroll
            for (int c = 0; c < 2; ++c) st[qb].O[db] = MFMA32(Vf[db][c], Pf[c], st[qb].O[db]);
    }
}

DI void phase_attn(const Params& P, int l, bool do_ctx, LAS unsigned char* lds) {
    const int tid = otid(), wid = tid >> 6, lane = tid & 63, hh = lane >> 5, ql = lane & 31;
    const bf16_t* Q = (const bf16_t*)(ows(P) + OFF_R + R_Q); const bf16_t* Kb = (const bf16_t*)(ows(P) + OFF_R + R_K);
    const bf16_t* VT = (const bf16_t*)(ows(P) + OFF_R + R_VT); const bf16_t* VTC = (const bf16_t*)(ows(P) + OFF_R + R_VTC);
    bf16_t* HB = (bf16_t*)(ows(P) + OFF_HB);
    const float* sink = oin(P, I_SINK) + l * 8;
    const int hq = wid >> 1, pp = wid & 1;
    const int nlat = (512 - obid() + (int)gridDim.x - 1) / (int)gridDim.x;
    const int cu = (int)gridDim.x - 1 - obid();
    const int nmine = nlat + ((do_ctx && cu < 32) ? 1 : 0);
    for (int ui = 0; ui < nmine; ++ui) {
        const int u = ui < nlat ? obid() + ui * (int)gridDim.x : 512 + cu;
        const bool isc = u >= 512;
        int b, kvh, blk = 0, qbase;
        if (!isc) { kvh = u & 1; blk = (u >> 1) & 31; b = u >> 6; qbase = b * 4096 + blk * 128; }
        else { const int u2 = u - 512; kvh = u2 & 1; b = u2 >> 2; qbase = TL + b * 256 + ((u2 >> 1) & 1) * 128; }
        const int h = kvh * 4 + hq;
        const int qrowA = qbase + pp * 64 + ql;
        bf16x8 Qf[2][4];
#pragma unroll
        for (int qb = 0; qb < 2; ++qb)
#pragma unroll
            for (int kk = 0; kk < 4; ++kk) Qf[qb][kk] = *(const bf16x8*)(Q + (size_t)(qrowA + qb * 32) * 512 + h * 64 + kk * 16 + hh * 8);
        AttnState st[2];
        const float sk = sink[h] * 1.4426950408889634f;
#pragma unroll
        for (int qb = 0; qb < 2; ++qb) { st[qb].m = sk; st[qb].l = hh == 0 ? 1.0f : 0.0f;
#pragma unroll
            for (int i = 0; i < 16; ++i) { st[qb].O[0][i] = 0.f; st[qb].O[1][i] = 0.f; } }
        if (!isc) {
            const int key0 = blk * 128 - 128;
            __syncthreads();
#pragma unroll
            for (int ps = 0; ps < 6; ++ps) { const int row = ps * 64 + (tid >> 3), seg = tid & 7; const int key = key0 + row;
                if (key >= 0 && key < SEQ) *(LAS u32x4*)(lds + row * AK_RS + seg * 16) = *(const u32x4*)(Kb + (size_t)(b * 4096 + key) * 128 + kvh * 64 + seg * 8); }
#pragma unroll
            for (int ps = 0; ps < 6; ++ps) { const int idx = ps * 512 + tid; const int d = idx / 48, seg = idx - d * 48; const int key = key0 + seg * 8;
                if (key >= 0 && key < SEQ) *(LAS u32x4*)(lds + AK_BYTES_BAND + d * AV_RS_BAND + seg * 16) = *(const u32x4*)(VT + ((size_t)(b * 128 + kvh * 64 + d)) * 4096 + key); }
            __syncthreads();
            const int q0 = blk * 128 + pp * 64;
            for (int kt = 0; kt < 12; ++kt) {
                const int klo = key0 + kt * 32;
                if (klo < 0 || klo >= SEQ) continue;
                if (klo + 31 < q0 - 128 || klo > q0 + 63 + 128) continue;
                const LAS unsigned char* kl = lds + (kt * 32 + ql) * AK_RS + hh * 16;
                const LAS unsigned char* vl = lds + AK_BYTES_BAND + ql * AV_RS_BAND + (kt * 32 + 4 * hh) * 2;
                const bool interior = (klo >= q0 + 63 - 128) && (klo + 31 <= q0 + 128);
                if (interior) attn_tile2<false>(st, Qf, kl, vl, AV_RS_BAND, lane, q0 + ql, klo);
                else attn_tile2<true>(st, Qf, kl, vl, AV_RS_BAND, lane, q0 + ql, klo);
            }
        }
        __syncthreads();
#pragma unroll
        for (int ps = 0; ps < 4; ++ps) { const int row = ps * 64 + (tid >> 3), seg = tid & 7;
            *(LAS u32x4*)(lds + row * AK_RS + seg * 16) = *(const u32x4*)(Kb + (size_t)(TL + b * 256 + row) * 128 + kvh * 64 + seg * 8); }
#pragma unroll
        for (int ps = 0; ps < 4; ++ps) { const int idx = ps * 512 + tid; const int d = idx >> 5, seg = idx & 31;
            *(LAS u32x4*)(lds + AK_BYTES_CTX + d * AV_RS_CTX + seg * 16) = *(const u32x4*)(VTC + ((size_t)(b * 128 + kvh * 64 + d)) * 256 + seg * 8); }
        __syncthreads();
        for (int kt = 0; kt < 8; ++kt) {
            const LAS unsigned char* kl = lds + (kt * 32 + ql) * AK_RS + hh * 16;
            const LAS unsigned char* vl = lds + AK_BYTES_CTX + ql * AV_RS_CTX + (kt * 32 + 4 * hh) * 2;
            attn_tile2<false>(st, Qf, kl, vl, AV_RS_CTX, lane, 0, 0);
        }
#pragma unroll
        for (int qb = 0; qb < 2; ++qb) {
            const float ltot = st[qb].l + shx(st[qb].l, 32, lane);
            const float inv = 1.0f / ltot;
            bf16_t* op = HB + (size_t)(qrowA + qb * 32) * HBS + 1024 + h * 64 + 4 * hh;
#pragma unroll
            for (int db = 0; db < 2; ++db)
#pragma unroll
                for (int g4 = 0; g4 < 4; ++g4) { u32x2 w; w.x = pk2(st[qb].O[db][4 * g4] * inv, st[qb].O[db][4 * g4 + 1] * inv); w.y = pk2(st[qb].O[db][4 * g4 + 2] * inv, st[qb].O[db][4 * g4 + 3] * inv);
                    *(u32x2*)(op + db * 32 + 8 * g4) = w; }
        }
    }
    __syncthreads();
}

DI void phase_sgu(const Params& P, int l, unsigned char* shm, int nchunk) {
    const int tid = otid(), wid = tid >> 6, lane = tid & 63, hh = lane >> 5, ql = lane & 31;
    bf16_t* vT = (bf16_t*)shm;
    const bf16_t* U = (const bf16_t*)(ows(P) + OFF_R + R_U); const bf16_t* Z = (const bf16_t*)(ows(P) + OFF_R + R_Z);
    bf16_t* HB = (bf16_t*)(ows(P) + OFF_HB);
    const float* lg = oin(P, I_SGULG) + l * 512; const float* lb = oin(P, I_SGULB) + l * 512;
    const float* sw = oin(P, I_SGUW) + (size_t)l * 4 * 128 * 128; const float* sb = oin(P, I_SGUB) + l * 4 * 128;
    float gg[8], bb[8];
#pragma unroll
    for (int j = 0; j < 8; ++j) { gg[j] = lg[j * 64 + lane]; bb[j] = lb[j * 64 + lane]; }
    const int nmine = (obid() < 256 ? 1 : 0) + ((nchunk > 256 && obid() >= 64 && obid() < 64 + (nchunk - 256)) ? 1 : 0);
    for (int ci = 0; ci < nmine; ++ci) {
        const int chunk = (ci == 0 && obid() < 256) ? obid() : 256 + (obid() - 64);
        const int r0 = chunk * 128;
        for (int t4 = 0; t4 < 4; ++t4) {
            float z[4][8]; float sum[4];
#pragma unroll
            for (int q = 0; q < 4; ++q) { const bf16_t* zp = Z + (size_t)(r0 + wid * 16 + t4 * 4 + q) * 512; sum[q] = 0.f;
#pragma unroll
                for (int j = 0; j < 8; ++j) { z[q][j] = bf2f(zp[j * 64 + lane]); sum[q] += z[q][j]; } }
#pragma unroll
            for (int o = 32; o >= 1; o >>= 1) {
#pragma unroll
                for (int q = 0; q < 4; ++q) sum[q] += shx(sum[q], o, lane); }
            float sq[4];
#pragma unroll
            for (int q = 0; q < 4; ++q) { const float mu = sum[q] * (1.0f / 512.0f); sq[q] = 0.f;
#pragma unroll
                for (int j = 0; j < 8; ++j) { z[q][j] -= mu; sq[q] += z[q][j] * z[q][j]; } }
#pragma unroll
            for (int o = 32; o >= 1; o >>= 1) {
#pragma unroll
                for (int q = 0; q < 4; ++q) sq[q] += shx(sq[q], o, lane); }
#pragma unroll
            for (int q = 0; q < 4; ++q) { const float rstd = rsqrtf(sq[q] * (1.0f / 512.0f) + LN_EPS); const int tok = wid * 16 + t4 * 4 + q;
#pragma unroll
                for (int j = 0; j < 8; ++j) vT[(j * 64 + lane) * 136 + tok] = f2bf(z[q][j] * rstd * gg[j] + bb[j]); }
        }
        __syncthreads();
        const int g = wid >> 1, cb = g * 128 + (wid & 1) * 64;
        for (int mb = 0; mb < 4; ++mb) {
            f32x16 acc[2];
#pragma unroll
            for (int i = 0; i < 16; ++i) { acc[0][i] = 0.f; acc[1][i] = 0.f; }
#pragma unroll
            for (int kc = 0; kc < 8; ++kc) {
                const float* wp = sw + ((size_t)(g * 128 + mb * 32 + ql)) * 128 + kc * 16 + hh * 8;
                const f32x4 w0 = *(const f32x4*)wp, w1 = *(const f32x4*)(wp + 4);
                u32x4 wa; wa.x = pk2(w0[0], w0[1]); wa.y = pk2(w0[2], w0[3]); wa.z = pk2(w1[0], w1[1]); wa.w = pk2(w1[2], w1[3]);
                const bf16x8 Af = __builtin_bit_cast(bf16x8, wa);
#pragma unroll
                for (int nb = 0; nb < 2; ++nb) { const bf16x8 Bf = *(const bf16x8*)(vT + (cb + nb * 32 + ql) * 136 + kc * 16 + hh * 8); acc[nb] = MFMA32(Af, Bf, acc[nb]); }
            }
#pragma unroll
            for (int nb = 0; nb < 2; ++nb)
#pragma unroll
                for (int i = 0; i < 16; ++i) { const int prow = mb * 32 + (i & 3) + 8 * (i >> 2) + 4 * hh; const int c = cb + nb * 32 + ql; const size_t row = (size_t)(r0 + prow);
                    const float val = (acc[nb][i] + sb[g * 128 + prow]) * bf2f(U[row * 512 + c]);
                    HB[row * HBS + 1536 + c] = f2bf(val); }
        }
        __syncthreads();
    }
}

__global__ void __launch_bounds__(512, 2) mega(Params P) {
    extern __shared__ __attribute__((aligned(16))) unsigned char shm[];
    LAS unsigned char* lds = (LAS unsigned char*)shm;
    cg::grid_group grid = cg::this_grid();
    volatile LAS unsigned* bst = (volatile LAS unsigned*)(lds + LDS_BYTES - 16);
    if (threadIdx.x == 0) { bst[0] = 0u; bst[1] = 0u; }
    if (blockIdx.x == 0) { unsigned* bw = (unsigned*)(P.ws + OFF_BAR); for (int i = threadIdx.x; i < XCD_BAR_WORDS; i += 512) bw[i] = 0u; }
    __syncthreads();

    phase_mods(P, shm);
    phase_tables(P, shm);
    phase_wconv(P, 0, 0, 0, gridDim.x, shm);
    grid.sync();
    const XcdBarrier gbar = xcd_barrier_post((unsigned*)(P.ws + OFF_BAR), bst);
#define GSYNC() xcd_barrier(gbar)
    phase_norm(P, nullptr, nullptr, (const float*)(ows(P) + OFF_MODS), 0, nullptr, T);
    GSYNC();

    for (int st = 0; st < 2 * DEPTH; ++st) {
        const int l = st >> 1, f = st & 1;
        const int npl = (l == DEPTH - 1) ? TL / 256 : T / 256;
        const int npf = f ? npl : T / 256;
        {
            unsigned char* ws = ows(P); bf16_t* W = (bf16_t*)(ws + OFF_W);
            SchedTile S; S.init(ws + OFF_HB, 256ull * HBS * 2, W + (f ? W_UP1 : W_UP0), 256ull * 1024 * 2, npf, NUP / 256);
            EpiUp E; E.act = (bf16_t*)(ws + OFF_R);
            for (int rep = 0; rep < REP_UP; ++rep) gemm_phase<1024, HBS, 1024>(lds, S, E);
        }
        GSYNC();
        for (int es = 0; es < EXTRA_SYNCS; ++es) GSYNC();
        {
            unsigned char* ws = ows(P); bf16_t* W = (bf16_t*)(ws + OFF_W);
            SchedTile S; S.init(ws + OFF_R, 256ull * DFFP * 2, W + (f ? W_DN1 : W_DN0), 256ull * DFFP * 2, npf, 4);
            EpiRes E; E.X = (float*)(ws + OFF_X); E.gm = (const float*)(ws + OFF_MODS) + (size_t)l * 9 * 9216 + (f ? 8 : 2) * 1024; E.s = 0.5f; E.stats = (const float*)(ws + OFF_STATS);
            { const int li = f ? (l * 3 + 1) : (st == 0 ? 0 : l * 3 - 1); E.lg = oin(P, I_LNG) + li * 1024; E.lb = oin(P, I_LNB) + li * 1024; E.ident = (st == 0) ? 1 : 0; }
            gemm_phase<DFFP, DFFP, DFFP>(lds, S, E);
        }
        if (f == 0) {
            phase_wconv(P, l, 2, 32, gridDim.x - 32, shm);
            phase_wconv(P, l, 1, 32, gridDim.x - 32, shm);
        }
        GSYNC();
        if (f == 0) {
            phase_norm(P, oin(P, I_LNG) + (l * 3 + 0) * 1024, oin(P, I_LNB) + (l * 3 + 0) * 1024, (const float*)(ows(P) + OFF_MODS) + (size_t)l * 9 * 9216, 3, nullptr, T);
            GSYNC();
            {
                unsigned char* ws = ows(P); bf16_t* W = (bf16_t*)(ws + OFF_W); unsigned char* R = ws + OFF_R;
                SchedTile S; S.init(ws + OFF_HB, 256ull * HBS * 2, W + W_IN, 256ull * 1024 * 2, T / 256, 7);
                EpiIn E; E.Q = (bf16_t*)(R + R_Q); E.Kb = (bf16_t*)(R + R_K); E.VT = (bf16_t*)(R + R_VT); E.VTC = (bf16_t*)(R + R_VTC); E.U = (bf16_t*)(R + R_U); E.Z = (bf16_t*)(R + R_Z);
                E.ropec = (const float*)(ws + OFF_ROPE); E.ropes = E.ropec + 1024;
                for (int rep = 0; rep < REP_IN; ++rep) gemm_phase<1024, HBS, 1024>(lds, S, E);
            }
            {
                unsigned char* ws = ows(P); bf16_t* W = (bf16_t*)(ws + OFF_W); unsigned char* R = ws + OFF_R;
                SchedTile S; S.init(W + W_F, 256ull * 1024 * 2, ws + OFF_HB, 256ull * HBS * 2, 4, npl); S.c = (obid() + (int)gridDim.x - 184) % (int)gridDim.x;
                EpiFT E; E.FT = (bf16_t*)(R + R_FT); E.FTC = (bf16_t*)(R + R_FTC);
                for (int rep = 0; rep < REP_IN; ++rep) gemm_phase<1024, 1024, HBS>(lds, S, E);
            }
            GSYNC();
            {
                unsigned char* ws = ows(P); unsigned char* R = ws + OFF_R;
                SchedTile S; S.init(ws + OFF_DFT, 256ull * 8192 * 2, R + R_FT, 256ull * 8192 * 2, 16, 16);
                EpiDft E; E.HB = (bf16_t*)(ws + OFF_HB); E.rowbase = 0; E.rpb = 4096;
                for (int rep = 0; rep < REP_DFT; ++rep) gemm_phase<8192, 8192, 8192>(lds, S, E);
            }
            if (l < DEPTH - 1) {
                unsigned char* ws = ows(P); unsigned char* R = ws + OFF_R;
                SchedTile S; S.init(ws + OFF_DFTC, 0, R + R_FTC, 256ull * 512 * 2, 1, 16); S.c = (obid() + (int)gridDim.x - 128) % (int)gridDim.x;
                EpiDft E; E.HB = (bf16_t*)(ws + OFF_HB); E.rowbase = TL; E.rpb = 256;
                gemm_phase<512, 512, 512>(lds, S, E);
            }
            for (int rep = 0; rep < REP_ATT; ++rep) phase_attn(P, l, l < DEPTH - 1, lds);
            for (int rep = 0; rep < REP_SGU; ++rep) phase_sgu(P, l, shm, npl * 2);
            GSYNC();
            {
                unsigned char* ws = ows(P); bf16_t* W = (bf16_t*)(ws + OFF_W); unsigned char* R = ws + OFF_R;
                SchedBr S; S.HBp = (const char*)(ws + OFF_HB); S.Wc = (const char*)(W + W_CAT); S.G = gridDim.x; S.c = obid(); S.ntiles = npl * 4;
                EpiBr E; E.merged = (bf16_t*)(R + R_MERGED); E.scr = R + R_SCR + (size_t)obid() * (3 * 131072);
                for (int rep = 0; rep < REP_BR; ++rep) gemm_phase<512, HBS, 1536>(lds, S, E);
            }
            if (l < DEPTH - 1) phase_wconv(P, l + 1, 0, 32, gridDim.x - 32, shm);
            GSYNC();
            {
                unsigned char* ws = ows(P); bf16_t* W = (bf16_t*)(ws + OFF_W); unsigned char* R = ws + OFF_R;
                SchedTile S; S.init(R + R_MERGED, 256ull * 1024 * 2, W + W_OUT, 256ull * 1024 * 2, npl, 4);
                EpiRes E; E.X = (float*)(ws + OFF_X); E.gm = (const float*)(ws + OFF_MODS) + (size_t)l * 9 * 9216 + 5 * 1024; E.s = 1.0f; E.stats = (const float*)(ws + OFF_STATS); E.lg = oin(P, I_LNG) + (l * 3) * 1024; E.lb = oin(P, I_LNB) + (l * 3) * 1024; E.ident = 0;
                gemm_phase<1024, 1024, 1024>(lds, S, E);
            }
            GSYNC();
            phase_norm(P, oin(P, I_LNG) + (l * 3 + 1) * 1024, oin(P, I_LNB) + (l * 3 + 1) * 1024, (const float*)(ows(P) + OFF_MODS) + (size_t)l * 9 * 9216, 6, nullptr, npl * 256);
            GSYNC();
        } else {
            const bool lastl = (l == DEPTH - 1);
            phase_norm(P, oin(P, I_LNG) + (l * 3 + 2) * 1024, oin(P, I_LNB) + (l * 3 + 2) * 1024, lastl ? nullptr : (const float*)(ows(P) + OFF_MODS) + (size_t)(l + 1) * 9 * 9216, 0, lastl ? P.out : nullptr, npl * 256);
            if (!lastl) GSYNC();
        }
    }
}

extern "C" void kernel_launch(void* const* d_in, const int* in_sizes, int n_in, void* d_out, int out_size, void* d_ws, size_t ws_size, hipStream_t stream) {
    static int grid_blocks = 0;
    if (!grid_blocks) {
        int dev = 0, cus = 0, per_cu = 0;
        hipGetDevice(&dev);
        hipDeviceGetAttribute(&cus, hipDeviceAttributeMultiprocessorCount, dev);
        if (hipFuncSetAttribute((const void*)mega, hipFuncAttributeMaxDynamicSharedMemorySize, LDS_BYTES) != hipSuccess) fprintf(stderr, "hipFuncSetAttribute failed\n");
        hipOccupancyMaxActiveBlocksPerMultiprocessor(&per_cu, (const void*)mega, 512, LDS_BYTES);
        if (per_cu < 1) { fprintf(stderr, "occupancy query gave %d\n", per_cu); per_cu = 1; }
        (void)hipGetLastError();
        grid_blocks = cus * per_cu;
        if (grid_blocks > 256) grid_blocks = 256;
        if (ws_size < WS_END) fprintf(stderr, "workspace too small: %zu < %zu\n", ws_size, (size_t)WS_END);
    }
    Params p{};
    for (int i = 0; i < 19; ++i) p.in[i] = (const float*)d_in[i];
    p.out = (float*)d_out; p.ws = (unsigned char*)d_ws;
    void* args[] = {&p};
    hipError_t e = hipLaunchCooperativeKernel((const void*)mega, dim3(grid_blocks), dim3(512), args, LDS_BYTES, stream);
    if (e != hipSuccess) fprintf(stderr, "cooperative launch failed: %s (grid %d)\n", hipGetErrorString(e), grid_blocks);
}
```
